# Optimizing an MI355X kernel written in HIP

```python
import math
import jax, jax.numpy as jnp
from jax import lax
import numpy as np

D_MODEL = 1024
BATCH = 2
SEQ = 8192
DEPTH = 1
DEC_BATCH = 32
DEC_SEQ = 4
PAST_LEN = 8192
PAGE_SIZE = 128

FOX_HEADS = 8
FOX_HEAD_DIM = 64
FOX_WIDTH = FOX_HEADS * FOX_HEAD_DIM
FORGET_BIAS_CENTER = 3.0
Q_BLOCK = 128
GDN_HEADS = 4
GDN_KEY_DIM = 128
GDN_VAL_DIM = 128
GDN_QK_WIDTH = GDN_HEADS * GDN_KEY_DIM
GDN_V_WIDTH = GDN_HEADS * GDN_VAL_DIM
GDN_CONV_WIDTH = 4
GDN_CONV_CH = 2 * GDN_QK_WIDTH + GDN_V_WIDTH
GDN_CHUNK = 64
D_FF = 4 * D_MODEL
PLE_DIM = 256
NORM_EPS = 1e-6
IN_SPLITS = (FOX_WIDTH, FOX_WIDTH, FOX_WIDTH, FOX_HEADS, GDN_CONV_CH, GDN_HEADS, GDN_HEADS, GDN_V_WIDTH, 2 * D_MODEL)
D_IN = 3 * FOX_WIDTH + FOX_HEADS + GDN_CONV_CH + 2 * GDN_HEADS + GDN_V_WIDTH + 2 * D_MODEL

kernel_name = "fox_gdn_parallel_hybrid_step"


def rmsnorm(x, g):
    xf = x.astype(jnp.float32)
    y = xf * lax.rsqrt(jnp.mean(xf * xf, axis=-1, keepdims=True) + NORM_EPS)
    return (y * g.astype(jnp.float32)).astype(x.dtype)


def l2norm(x):
    xf = x.astype(jnp.float32)
    return xf * lax.rsqrt(jnp.sum(xf * xf, axis=-1, keepdims=True) + NORM_EPS)


def split_columns(proj):
    outs = []
    start = 0
    for width in IN_SPLITS:
        outs.append(proj[..., start:start + width])
        start += width
    return outs


def fox_prompt_attend(q, k, v, logf):
    b, seq_len, h, dh = q.shape
    n_blocks = seq_len // Q_BLOCK
    cum = jnp.cumsum(logf, axis=1).transpose(0, 2, 1)
    q_blocks = jnp.moveaxis(q.reshape(b, n_blocks, Q_BLOCK, h, dh), 1, 0)
    cum_blocks = jnp.moveaxis(cum.reshape(b, h, n_blocks, Q_BLOCK), 2, 0)
    key_pos = jnp.arange(seq_len)
    scale = dh ** -0.5

    def one_block(args):
        blk, q_i, cum_i = args
        s = jnp.einsum('bqhd,bkhd->bhqk', q_i, k).astype(jnp.float32) * scale
        s = s + cum_i[..., :, None] - cum[:, :, None, :]
        q_pos = blk * Q_BLOCK + jnp.arange(Q_BLOCK)
        s = jnp.where(q_pos[:, None] >= key_pos[None, :], s, -jnp.inf)
        p = jax.nn.softmax(s, axis=-1).astype(v.dtype)
        return jnp.einsum('bhqk,bkhd->bqhd', p, v)

    out = lax.map(one_block, (jnp.arange(n_blocks), q_blocks, cum_blocks))
    return jnp.moveaxis(out, 0, 1).reshape(b, seq_len, h, dh)


def fox_sample_attend(q, k, v, logf, k_pool, v_pool, logf_pool, page_table):
    b, s_new, h, dh = q.shape
    n_pages = page_table.shape[1]
    past = n_pages * k_pool.shape[1]
    k_past = k_pool[page_table].reshape(b, past, h, dh)
    v_past = v_pool[page_table].reshape(b, past, h, dh)
    lf_past = logf_pool[page_table].reshape(b, past, h)
    k_all = jnp.concatenate([k_past.astype(k.dtype), k], axis=1)
    v_all = jnp.concatenate([v_past.astype(v.dtype), v], axis=1)
    cum = jnp.cumsum(jnp.concatenate([lf_past.astype(jnp.float32), logf], axis=1), axis=1).transpose(0, 2, 1)
    s = jnp.einsum('bqhd,bkhd->bhqk', q, k_all).astype(jnp.float32) * (dh ** -0.5)
    s = s + cum[:, :, past:, None] - cum[:, :, None, :]
    q_pos = past + jnp.arange(s_new)
    key_pos = jnp.arange(past + s_new)
    s = jnp.where(q_pos[:, None] >= key_pos[None, :], s, -jnp.inf)
    p = jax.nn.softmax(s, axis=-1).astype(v.dtype)
    return jnp.einsum('bhqk,bkhd->bqhd', p, v_all)


def causal_short_conv(x, buf, w):
    seq_len = x.shape[1]
    xp = jnp.concatenate([buf.astype(x.dtype), x], axis=1)
    y = w[0] * xp[:, 0:seq_len]
    for i in range(1, GDN_CONV_WIDTH):
        y = y + w[i] * xp[:, i:i + seq_len]
    return jax.nn.silu(y), xp[:, seq_len:]


def gated_delta_chunked(q, k, v, g, beta, s0):
    b, seq_len, h, dk = q.shape
    dv = v.shape[-1]
    c = math.gcd(seq_len, GDN_CHUNK)
    n = seq_len // c

    def to_chunks(a):
        a = a.reshape((b, n, c, h) + a.shape[3:])
        return jnp.moveaxis(a, 3, 1)

    qc, kc, vc, gc, bc = (to_chunks(a) for a in (q, k, v, g, beta))
    cum = jnp.cumsum(gc, axis=-1)
    idx = jnp.arange(c)
    causal = idx[:, None] >= idx[None, :]
    strict = idx[:, None] > idx[None, :]
    decay = jnp.exp(jnp.where(causal, cum[..., :, None] - cum[..., None, :], -jnp.inf))
    k_beta = kc * bc[..., None]
    amat = jnp.where(strict, jnp.einsum('bhnid,bhnjd->bhnij', k_beta, kc) * decay, 0.0)
    eye = jnp.eye(c, dtype=amat.dtype)
    tmat = lax.linalg.triangular_solve(amat + eye, jnp.broadcast_to(eye, amat.shape), left_side=True, lower=True)
    u = tmat @ (vc * bc[..., None])
    w = tmat @ (k_beta * jnp.exp(cum)[..., None])
    qk = jnp.einsum('bhnid,bhnjd->bhnij', qc, kc) * decay
    q_dec = qc * jnp.exp(cum)[..., None]
    k_dec = kc * jnp.exp(cum[..., -1:] - cum)[..., None]
    chunk_decay = jnp.exp(cum[..., -1])

    def step(state, xs):
        u_n, w_n, qk_n, q_n, k_n, d_n = xs
        v_new = u_n - w_n @ state
        o_n = q_n @ state + qk_n @ v_new
        state = state * d_n[..., None, None] + jnp.einsum('bhck,bhcv->bhkv', k_n, v_new)
        return state, o_n

    xs = tuple(jnp.moveaxis(a, 2, 0) for a in (u, w, qk, q_dec, k_dec, chunk_decay))
    s_final, o = lax.scan(step, s0, xs)
    o = jnp.moveaxis(jnp.moveaxis(o, 0, 2), 1, 3).reshape(b, seq_len, h, dv)
    return o, s_final


def hybrid_layer(x, ple, lw, attend_fn, conv_buf, ssm_state):
    b, seq_len, _ = x.shape
    f32 = jnp.float32
    xn = rmsnorm(x, lw['norm_mix_g'])
    proj = xn @ lw['w_in']
    fq, fk, fv, ff, gqkv, ga, gb, gz, gates = split_columns(proj)
    fq = rmsnorm(fq.reshape(b, seq_len, FOX_HEADS, FOX_HEAD_DIM), lw['fox_q_norm_g'])
    fk = rmsnorm(fk.reshape(b, seq_len, FOX_HEADS, FOX_HEAD_DIM), lw['fox_k_norm_g'])
    fv = fv.reshape(b, seq_len, FOX_HEADS, FOX_HEAD_DIM)
    logf = jax.nn.log_sigmoid((ff + lw['fox_f_bias']).astype(f32))
    o_a = attend_fn(fq, fk, fv, logf).reshape(b, seq_len, FOX_WIDTH)
    conv_out, conv_new = causal_short_conv(gqkv, conv_buf, lw['gdn_conv_w'])
    gq = conv_out[..., :GDN_QK_WIDTH].reshape(b, seq_len, GDN_HEADS, GDN_KEY_DIM)
    gk = conv_out[..., GDN_QK_WIDTH:2 * GDN_QK_WIDTH].reshape(b, seq_len, GDN_HEADS, GDN_KEY_DIM)
    gv = conv_out[..., 2 * GDN_QK_WIDTH:].reshape(b, seq_len, GDN_HEADS, GDN_VAL_DIM).astype(f32)
    gq = l2norm(gq) * (GDN_KEY_DIM ** -0.5)
    gk = l2norm(gk)
    log_decay = -jnp.exp(lw['gdn_a_log'].astype(f32)) * jax.nn.softplus(ga.astype(f32) + lw['gdn_dt_bias'].astype(f32))
    beta = jax.nn.sigmoid(gb.astype(f32))
    o_b, ssm_new = gated_delta_chunked(gq, gk, gv, log_decay, beta, ssm_state.astype(f32))
    o_b = rmsnorm(o_b, lw['gdn_out_norm_g']) * jax.nn.silu(gz.reshape(b, seq_len, GDN_HEADS, GDN_VAL_DIM).astype(f32))
    o_b = o_b.reshape(b, seq_len, GDN_V_WIDTH).astype(x.dtype)
    gate_a, gate_b = jnp.split(jax.nn.sigmoid(gates), 2, axis=-1)
    merged = gate_a * (o_a @ lw['w_branch_a']) + gate_b * (o_b @ lw['w_branch_b'])
    x = x + merged @ lw['w_out']
    h = rmsnorm(x, lw['norm_mlp_g'])
    x = x + jnp.square(jax.nn.relu(h @ lw['w_up'])) @ lw['w_down']
    ple_gate = jax.nn.sigmoid(rmsnorm(x, lw['norm_ple_g']) @ lw['w_ple_gate'])
    x = x + ple_gate * (ple @ lw['w_ple'])
    return x, (fk, fv, logf, conv_new, ssm_new)


def setup_inputs(seed: int = 0) -> dict:
    key = jax.random.key(seed)
    ks = jax.random.split(key, 32)
    f32 = jnp.float32
    n_pages = PAST_LEN // PAGE_SIZE
    n_used = DEC_BATCH * n_pages
    n_pool = n_used + (n_used + 3) // 4

    def nrm(k, shape, scale):
        return jax.random.normal(k, shape, f32) * scale

    dt = jnp.exp(jax.random.uniform(ks[16], (DEPTH, GDN_HEADS), f32, math.log(1e-3), math.log(1e-1)))
    return {
        'x_prompt': nrm(ks[0], (BATCH, SEQ, D_MODEL), 1.0),
        'x_sample': nrm(ks[1], (DEC_BATCH, DEC_SEQ, D_MODEL), 1.0),
        'p_prompt': nrm(ks[2], (DEPTH, BATCH, SEQ, PLE_DIM), 1.0),
        'p_sample': nrm(ks[3], (DEPTH, DEC_BATCH, DEC_SEQ, PLE_DIM), 1.0),
        'cache_k': nrm(ks[4], (DEPTH, n_pool, PAGE_SIZE, FOX_HEADS, FOX_HEAD_DIM), 1.0),
        'cache_v': nrm(ks[5], (DEPTH, n_pool, PAGE_SIZE, FOX_HEADS, FOX_HEAD_DIM), 1.0),
        'cache_logf': jax.nn.log_sigmoid(FORGET_BIAS_CENTER + nrm(ks[6], (DEPTH, n_pool, PAGE_SIZE, FOX_HEADS), 1.0)),
        'state_conv': nrm(ks[7], (DEPTH, DEC_BATCH, GDN_CONV_WIDTH - 1, GDN_CONV_CH), 1.0),
        'state_ssm': nrm(ks[8], (DEPTH, DEC_BATCH, GDN_HEADS, GDN_KEY_DIM, GDN_VAL_DIM), 0.3),
        'page_table': jax.random.permutation(ks[9], n_pool)[:n_used].reshape(DEC_BATCH, n_pages).astype(jnp.int32),
        'norm_mix_g': 1.0 + nrm(ks[10], (DEPTH, D_MODEL), 0.02),
        'w_in': nrm(ks[11], (DEPTH, D_MODEL, D_IN), D_MODEL ** -0.5),
        'fox_f_bias': FORGET_BIAS_CENTER + nrm(ks[12], (DEPTH, FOX_HEADS), 0.5),
        'fox_q_norm_g': 1.0 + nrm(ks[13], (DEPTH, FOX_HEAD_DIM), 0.02),
        'fox_k_norm_g': 1.0 + nrm(ks[14], (DEPTH, FOX_HEAD_DIM), 0.02),
        'gdn_conv_w': nrm(ks[15], (DEPTH, GDN_CONV_WIDTH, GDN_CONV_CH), GDN_CONV_WIDTH ** -0.5),
        'gdn_a_log': jnp.log(jax.random.uniform(ks[17], (DEPTH, GDN_HEADS), f32, 1.0, 16.0)),
        'gdn_dt_bias': dt + jnp.log(-jnp.expm1(-dt)),
        'gdn_out_norm_g': 1.0 + nrm(ks[18], (DEPTH, GDN_VAL_DIM), 0.02),
        'w_branch_a': nrm(ks[19], (DEPTH, FOX_WIDTH, D_MODEL), FOX_WIDTH ** -0.5),
        'w_branch_b': nrm(ks[20], (DEPTH, GDN_V_WIDTH, D_MODEL), GDN_V_WIDTH ** -0.5),
        'w_out': nrm(ks[21], (DEPTH, D_MODEL, D_MODEL), D_MODEL ** -0.5),
        'norm_mlp_g': 1.0 + nrm(ks[22], (DEPTH, D_MODEL), 0.02),
        'w_up': nrm(ks[23], (DEPTH, D_MODEL, D_FF), D_MODEL ** -0.5),
        'w_down': nrm(ks[24], (DEPTH, D_FF, D_MODEL), D_FF ** -0.5),
        'norm_ple_g': 1.0 + nrm(ks[25], (DEPTH, D_MODEL), 0.02),
        'w_ple_gate': nrm(ks[26], (DEPTH, D_MODEL, D_MODEL), D_MODEL ** -0.5),
        'w_ple': nrm(ks[27], (DEPTH, PLE_DIM, D_MODEL), PLE_DIM ** -0.5),
    }


def reference(x_prompt, x_sample, p_prompt, p_sample, cache_k, cache_v, cache_logf, state_conv, state_ssm, page_table,
              norm_mix_g, w_in, fox_f_bias, fox_q_norm_g, fox_k_norm_g, gdn_conv_w, gdn_a_log, gdn_dt_bias,
              gdn_out_norm_g, w_branch_a, w_branch_b, w_out, norm_mlp_g, w_up, w_down, norm_ple_g, w_ple_gate, w_ple):
    y_prompt = x_prompt
    y_sample = x_sample
    prompt_states = []
    sample_states = []
    b_prompt = x_prompt.shape[0]
    for l in range(DEPTH):
        lw = dict(norm_mix_g=norm_mix_g[l], w_in=w_in[l], fox_f_bias=fox_f_bias[l], fox_q_norm_g=fox_q_norm_g[l],
                  fox_k_norm_g=fox_k_norm_g[l], gdn_conv_w=gdn_conv_w[l], gdn_a_log=gdn_a_log[l],
                  gdn_dt_bias=gdn_dt_bias[l], gdn_out_norm_g=gdn_out_norm_g[l], w_branch_a=w_branch_a[l],
                  w_branch_b=w_branch_b[l], w_out=w_out[l], norm_mlp_g=norm_mlp_g[l], w_up=w_up[l],
                  w_down=w_down[l], norm_ple_g=norm_ple_g[l], w_ple_gate=w_ple_gate[l], w_ple=w_ple[l])
        conv0 = jnp.zeros((b_prompt, GDN_CONV_WIDTH - 1, GDN_CONV_CH), x_prompt.dtype)
        ssm0 = jnp.zeros((b_prompt, GDN_HEADS, GDN_KEY_DIM, GDN_VAL_DIM), jnp.float32)
        y_prompt, st_p = hybrid_layer(y_prompt, p_prompt[l], lw, fox_prompt_attend, conv0, ssm0)

        def sample_attend(q, k, v, logf, l=l):
            return fox_sample_attend(q, k, v, logf, cache_k[l], cache_v[l], cache_logf[l], page_table)

        y_sample, st_s = hybrid_layer(y_sample, p_sample[l], lw, sample_attend, state_conv[l], state_ssm[l])
        prompt_states.append(st_p)
        sample_states.append(st_s)
    k_prompt = jnp.stack([s[0] for s in prompt_states])
    v_prompt = jnp.stack([s[1] for s in prompt_states])
    logf_prompt = jnp.stack([s[2] for s in prompt_states])
    conv_prompt = jnp.stack([s[3] for s in prompt_states])
    ssm_prompt = jnp.stack([s[4] for s in prompt_states])
    k_sample = jnp.stack([s[0] for s in sample_states])
    v_sample = jnp.stack([s[1] for s in sample_states])
    logf_sample = jnp.stack([s[2] for s in sample_states])
    conv_sample = jnp.stack([s[3] for s in sample_states])
    ssm_sample = jnp.stack([s[4] for s in sample_states])
    return (y_prompt, y_sample, k_prompt, v_prompt, logf_prompt, conv_prompt, ssm_prompt,
            k_sample, v_sample, logf_sample, conv_sample, ssm_sample)
```

```cpp
#include <hip/hip_runtime.h>
#include <cstdio>
#include <cstdint>
#include <cmath>

constexpr int D = 1024, SEQ = 8192, NB = 2, MP = NB * SEQ;
constexpr int DB = 32, DS = 4, MS = DB * DS;
constexpr int MT = MP + MS, MPAD = 16640;
constexpr int FH = 8, FD = 64, FW = 512;
constexpr int GH = 4, GK = 128, GV = 128, CCH = 1536, CW = 4;
constexpr int DFF = 4096, PLE = 256, DIN = 5648;
constexpr int PAST = 8192, PAGE = 128, NPAGES = 64;
constexpr int NIN = 5888;
constexpr float EPS = 1e-6f;
constexpr float C2 = 0.125f * 1.4426950408889634f;
constexpr float LOG2E = 1.4426950408889634f;

constexpr size_t OFF_YP = 0, OFF_YS = 16777216, OFF_KP = 16908288, OFF_VP = 25296896, OFF_LFP = 33685504, OFF_CVP = 33816576,
                 OFF_SSP = 33825792, OFF_KS = 33956864, OFF_VS = 34022400, OFF_LFS = 34087936, OFF_CVS = 34088960, OFF_SSS = 34236416, OUT_TOTAL = 36333568;

constexpr size_t MiB = 1u << 20;
constexpr size_t WS_CTL = 0, CTL_ZERO_BYTES = 1 * MiB;
constexpr size_t WS_WIN = 2 * MiB, WS_WAB = 14 * MiB, WS_WOUT = 16 * MiB, WS_WUP = 18 * MiB, WS_WDN = 26 * MiB, WS_WGT = 34 * MiB, WS_WPL = 36 * MiB;
constexpr size_t WS_XN = 40 * MiB, WS_QB = 74 * MiB, WS_KB = 91 * MiB, WS_VB = 108 * MiB, WS_GQ = 126 * MiB, WS_GZ = 176 * MiB, WS_GT = 194 * MiB;
constexpr size_t WS_GAB = 260 * MiB, WS_LGF = 261 * MiB, WS_CUM = 262 * MiB, WS_OAB = 264 * MiB, WS_MRG = 298 * MiB, WS_X1 = 332 * MiB, WS_X1B = 398 * MiB;
constexpr size_t WS_HB = 432 * MiB, WS_X2 = 563 * MiB, WS_X2B = 629 * MiB, WS_PL = 663 * MiB, WS_GDN = 700 * MiB, WS_OG = 790 * MiB, WS_SFX = 824 * MiB, WS_DPART = 834 * MiB;
constexpr size_t WS_PLB = 856 * MiB;
constexpr size_t WS_END = 880 * MiB;
constexpr int CW_TMO = 0, CW_CODE = 1;
constexpr int CW_BAR = 4096;
constexpr int CW_Q = 8192;
constexpr int CW_PROG = 12288;
constexpr int CW_SS1 = 65536, CW_SS2 = 65536 + 16640 + 64;
static_assert((CW_SS2 + 16640) * 4 <= (int)CTL_ZERO_BYTES, "ctl");

constexpr int RING_OFF = 0, RING_BYTES = 131072;
constexpr int LDSCTL_OFF = RING_BYTES, MISC_OFF = LDSCTL_OFF + 320;
constexpr int LDS_BYTES = 147456;
constexpr int NWAVES = 8;

#define GAS __attribute__((address_space(1)))
#define LAS __attribute__((address_space(3)))
typedef unsigned short bf16;
typedef unsigned v4u __attribute__((ext_vector_type(4)));
typedef unsigned v2u __attribute__((ext_vector_type(2)));
typedef float f32x4 __attribute__((ext_vector_type(4)));
typedef float f32x16 __attribute__((ext_vector_type(16)));
typedef float f32x4s __attribute__((ext_vector_type(4)));
typedef short bf16x8 __attribute__((ext_vector_type(8)));
typedef short s16x4 __attribute__((ext_vector_type(4)));
typedef GAS unsigned gu32;
#define RLX_AGENT __ATOMIC_RELAXED, __HIP_MEMORY_SCOPE_AGENT
#define LDS_WAIT() asm volatile("s_waitcnt lgkmcnt(0)" ::: "memory")
#define VM_WAIT() asm volatile("s_waitcnt vmcnt(0)" ::: "memory")
typedef float f32x2_t __attribute__((ext_vector_type(2))); typedef __bf16 bf16x2_t __attribute__((ext_vector_type(2)));
__device__ __forceinline__ unsigned pk2(float lo, float hi) { const f32x2_t v = {lo, hi}; return __builtin_bit_cast(unsigned, __builtin_convertvector(v, bf16x2_t)); }
__device__ __forceinline__ unsigned f2bf(float f) { return pk2(f, 0.f) & 0xffffu; }
__device__ __forceinline__ float bf2f(unsigned short b) { return __builtin_bit_cast(float, (unsigned)b << 16); }
__device__ __forceinline__ float bflo(unsigned w) { return __builtin_bit_cast(float, w << 16); }
__device__ __forceinline__ float bfhi(unsigned w) { return __builtin_bit_cast(float, w & 0xffff0000u); }
__device__ __forceinline__ float sigmoidf_(float x) { return 1.0f / (1.0f + __expf(-x)); }
__device__ __forceinline__ float siluf_(float x) { return x / (1.0f + __expf(-x)); }
__device__ __forceinline__ float log_sigmoidf_(float z) { return fminf(z, 0.f) - __logf(1.0f + __expf(-fabsf(z))); }
__device__ __forceinline__ float softplusf_(float z) { return fmaxf(z, 0.f) + __logf(1.0f + __expf(-fabsf(z))); }
__device__ __forceinline__ float wave_sum(float v) {
#pragma unroll
    for (int o = 1; o < 64; o <<= 1) v += __shfl_xor(v, o);
    return v;
}
namespace pg8 {
#define PG8_LAS __attribute__((address_space(3)))
typedef unsigned short bf16_t;
typedef short bf16x8 __attribute__((ext_vector_type(8)));
typedef float f32x4 __attribute__((ext_vector_type(4)));
typedef unsigned u32x4 __attribute__((ext_vector_type(4)));
constexpr int BM = 256, BK = 64, HALF = 128, HTB = HALF * BK * 2  , STAGE_BYTES = 8 * HTB, NXCD = 8, WGM = 8;

__host__ __device__ __forceinline__ int lds_byte(int r, int c) { const int st = (r >> 4) * 2 + (c >> 5), rr = r & 15, cc = c & 31, ob = rr * 64 + cc * 2; return st * 1024 + (ob ^ (((ob >> 9) & 1) << 5)); }
__host__ __device__ __forceinline__ void stage_rc(int b, int& R, int& C) { const int st = b / 1024, sb = b % 1024, swz = sb ^ (((sb >> 9) & 1) << 5); R = (st >> 1) * 16 + swz / 64; C = (st & 1) * 32 + (swz % 64) / 2; }
__host__ __device__ __forceinline__ int perm32(int rho) { const int n = rho >> 4, i = rho & 15; return 8 * (i >> 2) + 4 * n + (i & 3); }

struct Unit { int pm, pn; };
struct Gemm { const bf16_t* A; const bf16_t* Bt; int M, N, K; };

struct StaticOrder {
    int nM, nN, nwg, G, c;
    __host__ __device__ void init(int M, int N, int G_, int c_) { nM = M / BM; nN = N / BM; nwg = nM * nN; G = G_; c = c_; }
    __host__ __device__ bool next(int i, Unit& u) const {
        const long L = (long)i * G + c; if (L >= nwg) return false;
        int wgid = (int)L; { const int q = nwg / NXCD, r = nwg % NXCD, xcd = wgid % NXCD, off = wgid / NXCD; wgid = (xcd < r ? xcd * (q + 1) : r * (q + 1) + (xcd - r) * q) + off; }
        const int nig = WGM * nN, gid = wgid / nig, fm = gid * WGM, gsz = (nM - fm) < WGM ? (nM - fm) : WGM;
        u.pm = fm + ((wgid % nig) % gsz); u.pn = (wgid % nig) / gsz; return true;
    }
    __device__ __forceinline__ void prefetch(int) const {}
    __device__ __forceinline__ void a_ready(const Unit&) const {}
    __device__ __forceinline__ void done(const Unit&) const {}
};
struct QueueOrder {
    unsigned* head; volatile PG8_LAS unsigned* slot; int nM, nN, nwg;
    __device__ __forceinline__ void init(int M, int N, unsigned* h, volatile PG8_LAS unsigned* s) { nM = M / BM; nN = N / BM; nwg = nM * nN; head = h; slot = s; }
    __device__ __forceinline__ void prefetch(int i) const { if (threadIdx.x == 0) slot[i & 1] = __hip_atomic_fetch_add(head, 1u, __ATOMIC_RELAXED, __HIP_MEMORY_SCOPE_AGENT); }
    __device__ __forceinline__ bool next(int i, Unit& u) const {
        if (i == 0) { __syncthreads(); prefetch(0); __syncthreads(); }
        const int idx = (int)slot[i & 1]; if (idx >= nwg) return false;
        const int nig = WGM * nN, gid = idx / nig, fm = gid * WGM, gsz = (nM - fm) < WGM ? (nM - fm) : WGM;
        u.pm = fm + ((idx % nig) % gsz); u.pn = (idx % nig) / gsz; return true;
    }
    __device__ __forceinline__ void a_ready(const Unit&) const {}
    __device__ __forceinline__ void done(const Unit&) const {}
};

__device__ __forceinline__ unsigned cvt_pk_bf16(float lo, float hi) { unsigned r; asm volatile("v_cvt_pk_bf16_f32 %0, %1, %2" : "=v"(r) : "v"(lo), "v"(hi)); return r; }
#define EPI_GEOM int t_ = threadIdx.x; asm volatile("" : "+v"(t_)); const int wid_ = t_ >> 6, wr = wid_ >> 2, wc = wid_ & 3, fr = t_ & 15, fq = (t_ & 63) >> 4;
__device__ __forceinline__ u32x4 pack8(const f32x4 v0, const f32x4 v1) { u32x4 w; w.x = cvt_pk_bf16(v0[0], v0[1]); w.y = cvt_pk_bf16(v0[2], v0[3]); w.z = cvt_pk_bf16(v1[0], v1[1]); w.w = cvt_pk_bf16(v1[2], v1[3]); return w; }
__device__ __forceinline__ float* out_row(float* out, size_t offp, size_t offs, int row, int width) {
    if (row < MP) return out + offp + (size_t)row * width;
    if (row < MT) return out + offs + (size_t)(row - MP) * width;
    return nullptr;
}
struct EpiIn {
    static constexpr bool PERM = true, AFTER_DRAIN = false, MIDK = false;
    bf16_t *QB, *KB, *VB, *GQ, *GZ, *GT; float *GAB, *LGF; float* out;
    const PG8_LAS float* par;
    __device__ __forceinline__ void operator()(const f32x4 (&acc)[2][2][4][2], const Unit& u, int, int, int, int) const {
        EPI_GEOM
        const int pn = u.pn; const int row0 = u.pm * BM + wr * 64 + fr;
        if (pn < 4) {
            const bool isk = pn >= 2; const int head = 4 * (pn & 1) + wc; const PG8_LAS float* gv = par + (isk ? 64 : 0);
            f32x4 g[2][2];
#pragma unroll
            for (int bj = 0; bj < 2; ++bj)
#pragma unroll
                for (int n = 0; n < 2; ++n) g[bj][n] = *(const PG8_LAS f32x4*)(gv + 32 * bj + 8 * fq + 4 * n);
#pragma unroll
            for (int ai = 0; ai < 2; ++ai)
#pragma unroll
                for (int m = 0; m < 4; ++m) {
                    float ss = 0.f;
#pragma unroll
                    for (int bj = 0; bj < 2; ++bj)
#pragma unroll
                        for (int n = 0; n < 2; ++n) { const f32x4 x = acc[ai][bj][m][n]; ss += (x[0] * x[0] + x[1] * x[1]) + (x[2] * x[2] + x[3] * x[3]); }
                    ss += __shfl_xor(ss, 16); ss += __shfl_xor(ss, 32);
                    float rs = __builtin_amdgcn_rsqf(ss * (1.0f / 64.0f) + EPS); if (!isk) rs *= C2;
                    const int row = row0 + ai * HALF + m * 16;
                    float* orow = isk ? out_row(out, OFF_KP, OFF_KS, row, FW) : nullptr;
#pragma unroll
                    for (int bj = 0; bj < 2; ++bj) {
                        const f32x4 v0 = acc[ai][bj][m][0] * rs * g[bj][0], v1 = acc[ai][bj][m][1] * rs * g[bj][1];
                        const int col = head * 64 + 32 * bj + 8 * fq;
                        *(u32x4*)((isk ? KB : QB) + (size_t)row * FW + col) = pack8(v0, v1);
                        if (orow) { *(f32x4*)(orow + col) = v0; *(f32x4*)(orow + col + 4) = v1; }
                    }
                }
        } else if (pn < 6) {
#pragma unroll
            for (int ai = 0; ai < 2; ++ai)
#pragma unroll
                for (int m = 0; m < 4; ++m) { const int row = row0 + ai * HALF + m * 16; float* orow = out_row(out, OFF_VP, OFF_VS, row, FW);
#pragma unroll
                    for (int bj = 0; bj < 2; ++bj) { const int col = 256 * (pn - 4) + 128 * bj + 32 * wc + 8 * fq; const f32x4 v0 = acc[ai][bj][m][0], v1 = acc[ai][bj][m][1];
                        *(u32x4*)(VB + (size_t)row * FW + col) = pack8(v0, v1);
                        if (orow) { *(f32x4*)(orow + col) = v0; *(f32x4*)(orow + col + 4) = v1; } } }
        } else if (pn < 12) {
#pragma unroll
            for (int ai = 0; ai < 2; ++ai)
#pragma unroll
                for (int m = 0; m < 4; ++m) { const int row = row0 + ai * HALF + m * 16;
#pragma unroll
                    for (int bj = 0; bj < 2; ++bj) { const int col = 256 * (pn - 6) + 128 * bj + 32 * wc + 8 * fq;
                        *(u32x4*)(GQ + (size_t)row * CCH + col) = pack8(acc[ai][bj][m][0], acc[ai][bj][m][1]); } }
        } else if (pn < 14) {
#pragma unroll
            for (int ai = 0; ai < 2; ++ai)
#pragma unroll
                for (int m = 0; m < 4; ++m) { const int row = row0 + ai * HALF + m * 16;
#pragma unroll
                    for (int bj = 0; bj < 2; ++bj) { const int col = 256 * (pn - 12) + 128 * bj + 32 * wc + 8 * fq; f32x4 v0 = acc[ai][bj][m][0], v1 = acc[ai][bj][m][1];
#pragma unroll
                        for (int i = 0; i < 4; ++i) { v0[i] = v0[i] * __builtin_amdgcn_rcpf(1.0f + __expf(-v0[i])); v1[i] = v1[i] * __builtin_amdgcn_rcpf(1.0f + __expf(-v1[i])); }
                        *(u32x4*)(GZ + (size_t)row * 512 + col) = pack8(v0, v1); } }
        } else if (pn < 22) {
#pragma unroll
            for (int ai = 0; ai < 2; ++ai)
#pragma unroll
                for (int m = 0; m < 4; ++m) { const int row = row0 + ai * HALF + m * 16;
#pragma unroll
                    for (int bj = 0; bj < 2; ++bj) { const int col = 256 * (pn - 14) + 128 * bj + 32 * wc + 8 * fq; f32x4 v0 = acc[ai][bj][m][0], v1 = acc[ai][bj][m][1];
#pragma unroll
                        for (int i = 0; i < 4; ++i) { v0[i] = __builtin_amdgcn_rcpf(1.0f + __expf(-v0[i])); v1[i] = __builtin_amdgcn_rcpf(1.0f + __expf(-v1[i])); }
                        *(u32x4*)(GT + (size_t)row * 2048 + col) = pack8(v0, v1); } }
        } else {
            if (wc == 0 && fq < 2) {
#pragma unroll
                for (int ai = 0; ai < 2; ++ai)
#pragma unroll
                    for (int m = 0; m < 4; ++m) { const int row = row0 + ai * HALF + m * 16; const f32x4 a0 = acc[ai][0][m][0], a1 = acc[ai][0][m][1];
                        if (fq == 0) { f32x4 l0, l1;
#pragma unroll
                            for (int i = 0; i < 4; ++i) { l0[i] = log_sigmoidf_(a0[i] + par[128 + i]); l1[i] = log_sigmoidf_(a1[i] + par[132 + i]); }
                            *(f32x4*)(LGF + (size_t)row * 8) = l0; *(f32x4*)(LGF + (size_t)row * 8 + 4) = l1;
                            float* orow = out_row(out, OFF_LFP, OFF_LFS, row, 8); if (orow) { *(f32x4*)orow = l0; *(f32x4*)(orow + 4) = l1; }
                        } else { f32x4 ld, be;
#pragma unroll
                            for (int i = 0; i < 4; ++i) { ld[i] = par[136 + i] * softplusf_(a0[i] + par[140 + i]); be[i] = __builtin_amdgcn_rcpf(1.0f + __expf(-a1[i])); }
                            *(f32x4*)(GAB + (size_t)row * 8) = ld; *(f32x4*)(GAB + (size_t)row * 8 + 4) = be; } }
            }
        }
    }
};
template <int ACT> struct EpiBf {
    static constexpr bool PERM = true, AFTER_DRAIN = false, MIDK = false;
    bf16_t* O; int ldc; const float* ss;
    __device__ __forceinline__ void operator()(const f32x4 (&acc)[2][2][4][2], const Unit& u, int, int, int, int) const {
        EPI_GEOM
        const int row0 = u.pm * BM + wr * 64 + fr, col0 = u.pn * BM + wc * 32 + 8 * fq;
        float rsv[8];
        if (ACT == 1) {
#pragma unroll
            for (int g = 0; g < 8; ++g) rsv[g] = ss[row0 + (g >> 2) * HALF + (g & 3) * 16];
#pragma unroll
            for (int g = 0; g < 8; ++g) rsv[g] = __builtin_amdgcn_rsqf(rsv[g] * (1.0f / D) + EPS);
        }
#pragma unroll
        for (int ai = 0; ai < 2; ++ai)
#pragma unroll
            for (int m = 0; m < 4; ++m) { const int row = row0 + ai * HALF + m * 16; const float rs = (ACT == 1) ? rsv[ai * 4 + m] : 1.f;
#pragma unroll
                for (int bj = 0; bj < 2; ++bj) { f32x4 v0 = acc[ai][bj][m][0], v1 = acc[ai][bj][m][1];
                    if (ACT == 1 || ACT == 2) {
#pragma unroll
                        for (int i = 0; i < 4; ++i) { float a = fmaxf(v0[i] * rs, 0.f), b = fmaxf(v1[i] * rs, 0.f); v0[i] = a * a; v1[i] = b * b; } }
                    *(u32x4*)(O + (size_t)row * ldc + col0 + bj * HALF) = pack8(v0, v1); } }
    }
};
struct EpiMerge {
    static constexpr bool PERM = true, AFTER_DRAIN = false, MIDK = true;
    bf16_t* O; const bf16_t* GT;
    __device__ __forceinline__ void mid(f32x4 (&acc)[2][2][4][2], const Unit& u, int, int, int, int) const {
        int t_ = threadIdx.x; asm volatile("" : "+v"(t_));
        const int wid_ = t_ >> 6, wr = wid_ >> 2, wc = wid_ & 3, fr = t_ & 15, fq = (t_ & 63) >> 4;
        const int row0 = u.pm * BM + wr * 64 + fr, col0 = u.pn * BM + wc * 32 + 8 * fq;
        u32x4 ga[2], gb[2], na[2], nb[2];
        { const bf16_t* gp = GT + (size_t)row0 * 2048 + col0; ga[0] = *(const u32x4*)gp; ga[1] = *(const u32x4*)(gp + HALF); gb[0] = *(const u32x4*)(gp + 1024); gb[1] = *(const u32x4*)(gp + 1024 + HALF); }
#pragma unroll
        for (int g = 0; g < 8; ++g) { const int ai = g >> 2, m = g & 3;
            if (g < 7) { const bf16_t* gp = GT + (size_t)(row0 + ((g + 1) >> 2) * HALF + ((g + 1) & 3) * 16) * 2048 + col0; na[0] = *(const u32x4*)gp; na[1] = *(const u32x4*)(gp + HALF); nb[0] = *(const u32x4*)(gp + 1024); nb[1] = *(const u32x4*)(gp + 1024 + HALF); }
#pragma unroll
            for (int bj = 0; bj < 2; ++bj)
#pragma unroll
                for (int w = 0; w < 4; ++w) { const float a0 = bflo(ga[bj][w]), a1 = bfhi(ga[bj][w]), b0 = fmaxf(bflo(gb[bj][w]), 1e-30f), b1 = fmaxf(bfhi(gb[bj][w]), 1e-30f);
                    acc[ai][bj][m][w >> 1][(w & 1) * 2] *= a0 * __builtin_amdgcn_rcpf(b0); acc[ai][bj][m][w >> 1][(w & 1) * 2 + 1] *= a1 * __builtin_amdgcn_rcpf(b1); }
            asm volatile("" : "+v"(acc[ai][0][m][0]), "+v"(acc[ai][0][m][1]), "+v"(acc[ai][1][m][0]), "+v"(acc[ai][1][m][1]) :: "memory");
            ga[0] = na[0]; ga[1] = na[1]; gb[0] = nb[0]; gb[1] = nb[1]; }
    }
    __device__ __forceinline__ void operator()(const f32x4 (&acc)[2][2][4][2], const Unit& u, int, int, int, int) const {
        EPI_GEOM
        const int row0 = u.pm * BM + wr * 64 + fr, col0 = u.pn * BM + wc * 32 + 8 * fq;
        u32x4 gb[2], nb[2];
        { const bf16_t* gp = GT + (size_t)row0 * 2048 + 1024 + col0; gb[0] = *(const u32x4*)gp; gb[1] = *(const u32x4*)(gp + HALF); }
#pragma unroll
        for (int g = 0; g < 8; ++g) { const int ai = g >> 2, m = g & 3; const int row = row0 + ai * HALF + m * 16;
            if (g < 7) { const bf16_t* gp = GT + (size_t)(row0 + ((g + 1) >> 2) * HALF + ((g + 1) & 3) * 16) * 2048 + 1024 + col0; nb[0] = *(const u32x4*)gp; nb[1] = *(const u32x4*)(gp + HALF); }
#pragma unroll
            for (int bj = 0; bj < 2; ++bj) { f32x4 v0 = acc[ai][bj][m][0], v1 = acc[ai][bj][m][1]; const u32x4 q = gb[bj];
                v0[0] *= fmaxf(bflo(q[0]), 1e-30f); v0[1] *= fmaxf(bfhi(q[0]), 1e-30f); v0[2] *= fmaxf(bflo(q[1]), 1e-30f); v0[3] *= fmaxf(bfhi(q[1]), 1e-30f);
                v1[0] *= fmaxf(bflo(q[2]), 1e-30f); v1[1] *= fmaxf(bfhi(q[2]), 1e-30f); v1[2] *= fmaxf(bflo(q[3]), 1e-30f); v1[3] *= fmaxf(bfhi(q[3]), 1e-30f);
                *(u32x4*)(O + (size_t)row * D + col0 + bj * HALF) = pack8(v0, v1); }
            gb[0] = nb[0]; gb[1] = nb[1]; }
    }
};
template <bool BASE16, bool SCALE> struct EpiRes {
    static constexpr bool PERM = false, AFTER_DRAIN = false, MIDK = false;
    const void* base; bf16_t* XB; float* ss; const float* ss_in;
    __device__ __forceinline__ void operator()(const f32x4 (&acc)[2][2][4][2], const Unit& u, int, int, int, int) const {
        EPI_GEOM
        const int row0 = u.pm * BM + wr * 64 + fr, col0 = u.pn * BM + wc * 32 + 4 * fq;
        f32x4 cur[2][2], nxt[2][2];
        auto ld = [&](int g, f32x4 (&d)[2][2]) { const size_t o = (size_t)(row0 + (g >> 2) * HALF + (g & 3) * 16) * D + col0;
#pragma unroll
            for (int bj = 0; bj < 2; ++bj)
#pragma unroll
                for (int n = 0; n < 2; ++n) {
                    if constexpr (BASE16) { const v2u w = *(const v2u*)((const bf16_t*)base + o + bj * HALF + n * 16); d[bj][n] = (f32x4){bflo(w.x), bfhi(w.x), bflo(w.y), bfhi(w.y)}; }
                    else d[bj][n] = *(const f32x4*)((const float*)base + o + bj * HALF + n * 16); } };
        float r2[8];
        if constexpr (SCALE) {
#pragma unroll
            for (int g = 0; g < 8; ++g) r2[g] = ss_in[row0 + (g >> 2) * HALF + (g & 3) * 16];
        }
        ld(0, cur);
#pragma unroll
        for (int g = 0; g < 8; ++g) { const int ai = g >> 2, m = g & 3; const int row = row0 + ai * HALF + m * 16;
            if (g < 7) ld(g + 1, nxt);
            float sc = 1.f; if constexpr (SCALE) sc = __builtin_amdgcn_rcpf(r2[g] * (1.0f / D) + EPS);
            float s = 0.f;
#pragma unroll
            for (int bj = 0; bj < 2; ++bj)
#pragma unroll
                for (int n = 0; n < 2; ++n) { const int col = col0 + bj * HALF + n * 16; const f32x4 v = acc[ai][bj][m][n] * sc + cur[bj][n];
                    s += (v[0] * v[0] + v[1] * v[1]) + (v[2] * v[2] + v[3] * v[3]);
                    v2u w; w.x = cvt_pk_bf16(v[0], v[1]); w.y = cvt_pk_bf16(v[2], v[3]); *(v2u*)(XB + (size_t)row * D + col) = w; }
            s += __shfl_xor(s, 16); s += __shfl_xor(s, 32);
            if (fq == 0) atomicAdd(ss + row, s);
#pragma unroll
            for (int bj = 0; bj < 2; ++bj)
#pragma unroll
                for (int n = 0; n < 2; ++n) cur[bj][n] = nxt[bj][n]; }
    }
};
struct EpiFinal {
    static constexpr bool PERM = false, AFTER_DRAIN = false, MIDK = false;
    const bf16_t* X2B; const bf16_t* PL; const float* ss; float* out;
    __device__ __forceinline__ void operator()(const f32x4 (&acc)[2][2][4][2], const Unit& u, int, int, int, int) const {
        EPI_GEOM
        const int row0 = u.pm * BM + wr * 64 + fr, col0 = u.pn * BM + wc * 32 + 4 * fq;
        float rsv[8];
#pragma unroll
        for (int g = 0; g < 8; ++g) rsv[g] = ss[row0 + (g >> 2) * HALF + (g & 3) * 16];
        v2u cx[2][2], nx[2][2], cp[2][2], np[2][2];
        { const size_t o = (size_t)row0 * D + col0;
#pragma unroll
          for (int bj = 0; bj < 2; ++bj)
#pragma unroll
            for (int n = 0; n < 2; ++n) { cx[bj][n] = *(const v2u*)(X2B + o + bj * HALF + n * 16); cp[bj][n] = *(const v2u*)(PL + o + bj * HALF + n * 16); } }
#pragma unroll
        for (int g = 0; g < 8; ++g) { const int ai = g >> 2, m = g & 3; const int row = row0 + ai * HALF + m * 16;
            if (g < 7) { const size_t o = (size_t)(row0 + ((g + 1) >> 2) * HALF + ((g + 1) & 3) * 16) * D + col0;
#pragma unroll
                for (int bj = 0; bj < 2; ++bj)
#pragma unroll
                    for (int n = 0; n < 2; ++n) { nx[bj][n] = *(const v2u*)(X2B + o + bj * HALF + n * 16); np[bj][n] = *(const v2u*)(PL + o + bj * HALF + n * 16); } }
            const float rs = __builtin_amdgcn_rsqf(rsv[g] * (1.0f / D) + EPS);
#pragma unroll
            for (int bj = 0; bj < 2; ++bj)
#pragma unroll
                for (int n = 0; n < 2; ++n) { const int col = col0 + bj * HALF + n * 16; const f32x4 a = acc[ai][bj][m][n]; const v2u x = cx[bj][n]; const v2u p = cp[bj][n]; f32x4 y;
                    y[0] = bflo(x.x) + bflo(p.x) * __builtin_amdgcn_rcpf(1.0f + __expf(-a[0] * rs)); y[1] = bfhi(x.x) + bfhi(p.x) * __builtin_amdgcn_rcpf(1.0f + __expf(-a[1] * rs));
                    y[2] = bflo(x.y) + bflo(p.y) * __builtin_amdgcn_rcpf(1.0f + __expf(-a[2] * rs)); y[3] = bfhi(x.y) + bfhi(p.y) * __builtin_amdgcn_rcpf(1.0f + __expf(-a[3] * rs));
                    *(f32x4*)(out + (size_t)row * D + col) = y; }
#pragma unroll
            for (int bj = 0; bj < 2; ++bj)
#pragma unroll
                for (int n = 0; n < 2; ++n) { cx[bj][n] = nx[bj][n]; cp[bj][n] = np[bj][n]; } }
    }
};
template <class Epi, class Sched, bool ALIGN_EPI = false, bool SP2 = false>
__device__ __forceinline__ void gemm_phase(PG8_LAS unsigned char* lds, const Gemm g, const Sched& S, const Epi& E) {
    int tid_ = threadIdx.x; asm volatile("" : "+v"(tid_));
    const int tid = tid_, wid = __builtin_amdgcn_readfirstlane(tid >> 6), lane = tid & 63, wr = wid >> 2, wc = wid & 3, fr = lane & 15, fq = lane >> 4;
    const int K = g.K, nt = K / BK;
    unsigned voffA[2], voffB[2];
#pragma unroll
    for (int i = 0; i < 2; ++i) { int R, C; stage_rc(tid * 16 + i * 8192, R, C); const int Rb = Epi::PERM ? ((R & ~31) + perm32(R & 31)) : R;
        voffA[i] = (unsigned)(R * K + C) * 2u; voffB[i] = (unsigned)(Rb * K + C) * 2u; }
    const size_t kstep = (size_t)(BK * 2);
    const size_t hstep = (size_t)HALF * K * 2;
    const size_t tstep = 2 * hstep;
    const unsigned ldsw = (unsigned)wid * 1024u;
    const int aoff = lds_byte(wr * 64 + fr, fq * 8), boff = lds_byte(wc * 32 + fr, fq * 8);
#define PG8_SA(b, h) (((b) * 2 + (h)) * HTB)
#define PG8_SB(b, h) ((4 + (b) * 2 + (h)) * HTB)
#define PG8_STAGE(bufoff, gbase, voff) do { _Pragma("unroll") for (int _i = 0; _i < 2; ++_i) \
        __builtin_amdgcn_global_load_lds((const unsigned*)((const char*)(gbase) + (voff)[_i]), (PG8_LAS unsigned*)(lds + (bufoff) + ldsw + _i * 8192), 16, 0, 0); } while (0)
#define PG8_LDA(dst, b, h) do { _Pragma("unroll") for (int m = 0; m < 4; ++m) _Pragma("unroll") for (int k = 0; k < 2; ++k) dst[m][k] = *(const PG8_LAS bf16x8*)(lds + PG8_SA(b, h) + aoff + m * 2048 + k * 1024); } while (0)
#define PG8_LDB(dst, b, h) do { _Pragma("unroll") for (int n = 0; n < 2; ++n) _Pragma("unroll") for (int k = 0; k < 2; ++k) dst[n][k] = *(const PG8_LAS bf16x8*)(lds + PG8_SB(b, h) + boff + n * 2048 + k * 1024); } while (0)
#define PG8_MMA(ai, bj, At, Bt) do { __builtin_amdgcn_s_setprio(1); _Pragma("unroll") for (int m = 0; m < 4; ++m) _Pragma("unroll") for (int n = 0; n < 2; ++n) _Pragma("unroll") for (int k = 0; k < 2; ++k) \
        acc[ai][bj][m][n] = __builtin_amdgcn_mfma_f32_16x16x32_bf16(Bt[n][k], At[m][k], acc[ai][bj][m][n], 0, 0, 0); __builtin_amdgcn_s_setprio(0); } while (0)
#define PG8_WAIT_V(n) asm volatile("s_waitcnt vmcnt(" #n ")" ::: "memory")
#define PG8_WAIT_L(n) asm volatile("s_waitcnt lgkmcnt(" #n ")" ::: "memory")
#define PG8_BAR __builtin_amdgcn_s_barrier()
#define PG8_SCHED __builtin_amdgcn_sched_barrier(0)
    Unit cur, nxt; int ui = 0;
    if (!S.next(0, cur)) return;
    f32x4 acc[2][2][4][2];
#pragma unroll
    for (int a = 0; a < 2; ++a)
#pragma unroll
        for (int b = 0; b < 2; ++b)
#pragma unroll
            for (int m = 0; m < 4; ++m)
#pragma unroll
                for (int n = 0; n < 2; ++n) acc[a][b][m][n] = (f32x4){0.f, 0.f, 0.f, 0.f};
    bf16x8 At[4][2], B0[2][2], B1[2][2];
    const char* cA = (const char*)g.A + (size_t)cur.pm * tstep; const char* cB = (const char*)g.Bt + (size_t)cur.pn * tstep;
    S.a_ready(cur);
    if constexpr (SP2) {
        PG8_STAGE(PG8_SB(0, 0), cB, voffB); PG8_STAGE(PG8_SB(0, 1), cB + hstep, voffB); PG8_STAGE(PG8_SA(0, 0), cA, voffA); PG8_STAGE(PG8_SA(0, 1), cA + hstep, voffA);
        if (wr == 1) PG8_BAR;
        PG8_WAIT_V(2); PG8_BAR;
        PG8_STAGE(PG8_SB(1, 0), cB + kstep, voffB); PG8_STAGE(PG8_SA(1, 0), cA + kstep, voffA); PG8_STAGE(PG8_SB(1, 1), cB + hstep + kstep, voffB);
        PG8_WAIT_V(6); PG8_BAR;
    } else {
        PG8_STAGE(PG8_SB(0, 0), cB, voffB); PG8_STAGE(PG8_SA(0, 0), cA, voffA); PG8_STAGE(PG8_SB(0, 1), cB + hstep, voffB); PG8_STAGE(PG8_SA(0, 1), cA + hstep, voffA);
        if (wr == 1) PG8_BAR;
        PG8_WAIT_V(4); PG8_BAR;
        PG8_STAGE(PG8_SB(1, 0), cB + kstep, voffB); PG8_STAGE(PG8_SA(1, 0), cA + kstep, voffA); PG8_STAGE(PG8_SB(1, 1), cB + hstep + kstep, voffB);
        PG8_WAIT_V(6); PG8_BAR;
    }
    for (;;) {
        S.prefetch(ui + 1);
        bool has_next = false; const char* nA = cA; const char* nB = cB;
#pragma unroll 1
        for (int t = 0; t < nt; t += 2) {
            if constexpr (Epi::MIDK) { if (t == (nt >> 1)) E.mid(acc, cur, wr, wc, fr, fq); }
            const bool last = (t == nt - 2);
            if (last) { has_next = S.next(ui + 1, nxt); if (has_next) { nA = (const char*)g.A + (size_t)nxt.pm * tstep; nB = (const char*)g.Bt + (size_t)nxt.pn * tstep; } }
            const char* a1 = cA + (size_t)(t + 1) * kstep;
            const char* a2 = last ? nA : cA + (size_t)(t + 2) * kstep; const char* b2 = last ? nB : cB + (size_t)(t + 2) * kstep;
            const char* a3 = a2 + kstep; const char* b3 = b2 + kstep;
            if (last && has_next) S.a_ready(nxt);
            if constexpr (SP2) {
            PG8_LDB(B0, 0, 0); PG8_LDB(B1, 0, 1); PG8_SCHED; PG8_LDA(At, 0, 0); PG8_STAGE(PG8_SA(1, 1), a1 + hstep, voffA);
            PG8_WAIT_V(8); PG8_WAIT_L(0); PG8_BAR; PG8_MMA(0, 0, At, B0); PG8_MMA(0, 1, At, B1); PG8_BAR; PG8_SCHED;
            PG8_LDA(At, 0, 1); PG8_STAGE(PG8_SB(0, 0), b2, voffB); PG8_STAGE(PG8_SB(0, 1), b2 + hstep, voffB); PG8_STAGE(PG8_SA(0, 0), a2, voffA);
            PG8_WAIT_V(8); PG8_WAIT_L(0); PG8_BAR; PG8_MMA(1, 0, At, B0); PG8_MMA(1, 1, At, B1); PG8_BAR; PG8_SCHED;
            PG8_LDB(B0, 1, 0); PG8_LDB(B1, 1, 1); PG8_SCHED; PG8_LDA(At, 1, 0); PG8_STAGE(PG8_SA(0, 1), a2 + hstep, voffA);
            PG8_WAIT_V(8); PG8_WAIT_L(0); PG8_BAR; PG8_MMA(0, 0, At, B0); PG8_MMA(0, 1, At, B1); PG8_BAR; PG8_SCHED;
            PG8_LDA(At, 1, 1); PG8_STAGE(PG8_SB(1, 0), b3, voffB); PG8_STAGE(PG8_SB(1, 1), b3 + hstep, voffB); PG8_STAGE(PG8_SA(1, 0), a3, voffA);
            PG8_WAIT_V(8); PG8_WAIT_L(0); PG8_BAR; PG8_MMA(1, 0, At, B0); PG8_MMA(1, 1, At, B1); PG8_BAR; PG8_SCHED;
            } else {
            PG8_LDB(B0, 0, 0); PG8_SCHED; PG8_LDA(At, 0, 0); PG8_STAGE(PG8_SA(1, 1), a1 + hstep, voffA);
            PG8_WAIT_L(8); PG8_BAR; PG8_WAIT_L(0); PG8_MMA(0, 0, At, B0); PG8_BAR; PG8_SCHED;
            PG8_LDB(B1, 0, 1); PG8_STAGE(PG8_SB(0, 0), b2, voffB);
            PG8_BAR; PG8_WAIT_L(0); PG8_MMA(0, 1, At, B1); PG8_BAR;
            PG8_LDA(At, 0, 1); PG8_STAGE(PG8_SA(0, 0), a2, voffA);
            PG8_BAR; PG8_WAIT_L(0); PG8_MMA(1, 0, At, B0); PG8_BAR; PG8_SCHED;
            PG8_STAGE(PG8_SB(0, 1), b2 + hstep, voffB);
            PG8_WAIT_V(6); PG8_BAR; PG8_MMA(1, 1, At, B1); PG8_BAR;
            PG8_LDB(B0, 1, 0); PG8_SCHED; PG8_LDA(At, 1, 0); PG8_STAGE(PG8_SA(0, 1), a2 + hstep, voffA);
            PG8_WAIT_L(8); PG8_BAR; PG8_WAIT_L(0); PG8_MMA(0, 0, At, B0); PG8_BAR; PG8_SCHED;
            PG8_LDB(B1, 1, 1); PG8_STAGE(PG8_SB(1, 0), b3, voffB);
            PG8_BAR; PG8_WAIT_L(0); PG8_MMA(0, 1, At, B1); PG8_BAR;
            PG8_LDA(At, 1, 1); PG8_STAGE(PG8_SA(1, 0), a3, voffA);
            PG8_BAR; PG8_WAIT_L(0); PG8_MMA(1, 0, At, B0); PG8_BAR; PG8_SCHED;
            PG8_STAGE(PG8_SB(1, 1), b3 + hstep, voffB);
            PG8_WAIT_V(6); PG8_BAR; PG8_MMA(1, 1, At, B1); PG8_BAR;
            }
        }
        if constexpr (ALIGN_EPI) { if (wr == 0) PG8_BAR; }
        if constexpr (!Epi::AFTER_DRAIN) { E(acc, cur, wr, wc, fr, fq); S.done(cur); }
        if (!has_next) break;
#pragma unroll
        for (int a = 0; a < 2; ++a)
#pragma unroll
            for (int b = 0; b < 2; ++b)
#pragma unroll
                for (int m = 0; m < 4; ++m)
#pragma unroll
                    for (int n = 0; n < 2; ++n) acc[a][b][m][n] = (f32x4){0.f, 0.f, 0.f, 0.f};
        cur = nxt; cA = nA; cB = nB; ++ui;
        if constexpr (ALIGN_EPI) { if (wr == 1) PG8_BAR; }
    }
    PG8_WAIT_V(0);
    if constexpr (!ALIGN_EPI) { if (wr == 0) PG8_BAR; }
    PG8_BAR;
    if constexpr (Epi::AFTER_DRAIN) { E.fused(acc, cur, wr, wc, fr, fq, lds, wid, lane); S.done(cur); }
#undef PG8_SA
#undef PG8_SB
#undef PG8_STAGE
#undef PG8_LDA
#undef PG8_LDB
#undef PG8_MMA
#undef PG8_WAIT_V
#undef PG8_WAIT_L
#undef PG8_BAR
#undef PG8_SCHED
}
}
#define XB_TMO      128
#define XB_XCNT(j)  (256  + 64 * (j))
#define XB_XSUB(j)  (1280 + 64 * (j))
#define XB_XGEN(j)  (2304 + 64 * (j))
#define XB_TOP      3328
#define XB_TOPGEN   3392
#define XCD_BAR_WORDS 3456
#define XB_SPIN_CAP (1u << 18)

__device__ __forceinline__ unsigned xb_ld(unsigned* p)              { return __hip_atomic_load(p, __ATOMIC_RELAXED, __HIP_MEMORY_SCOPE_AGENT); }
__device__ __forceinline__ unsigned xb_add(unsigned* p, unsigned v) { return __hip_atomic_fetch_add(p, v, __ATOMIC_RELAXED, __HIP_MEMORY_SCOPE_AGENT); }
__device__ __forceinline__ unsigned xb_xcc_id() { return (unsigned)__builtin_amdgcn_s_getreg((3 << 11) | 20) & 0xFu; }
#define XB_SPIN(cond, bar) do { unsigned _sp = 0; while (cond) { __builtin_amdgcn_s_sleep(1); \
    if ((++_sp & 255u) == 0u) { if (xb_ld(&(bar)[XB_TMO])) break; if (_sp > XB_SPIN_CAP) { atomicAdd(&(bar)[XB_TMO], 1u); break; } } } } while (0)

struct XcdBarrier {
    unsigned* bar; unsigned x;
    volatile LAS unsigned* st;
};

__device__ __forceinline__ XcdBarrier xcd_barrier_post(unsigned* bar, volatile LAS unsigned* st) {
    XcdBarrier b; b.bar = bar; b.x = xb_xcc_id(); b.st = st;
    if (threadIdx.x == 0) (void)xb_add(&bar[XB_XCNT(b.x)], 1u);
    return b;
}
__device__ __forceinline__ void xcd_barrier_complete(unsigned* bar, unsigned x, unsigned& nloc, unsigned& nx) {
    const unsigned G = gridDim.x * gridDim.y * gridDim.z;
    unsigned sum, cnt, mine, sp = 0u;
    for (;;) {
        sum = 0u; cnt = 0u; mine = 0u;
#pragma unroll
        for (unsigned j = 0; j < 16; ++j) { const unsigned c = xb_ld(&bar[XB_XCNT(j)]); sum += c; cnt += (c > 0u) ? 1u : 0u; mine = (j == x) ? c : mine; }
        if (sum == G) break;
        __builtin_amdgcn_s_sleep(1);
        if ((++sp & 255u) == 0u) { if (xb_ld(&bar[XB_TMO])) break; if (sp > XB_SPIN_CAP) { atomicAdd(&bar[XB_TMO], 1u); break; } }
    }
    nloc = mine > 0u ? mine : 1u; nx = cnt > 0u ? cnt : 1u;
}

__device__ __forceinline__ void xcd_barrier(const XcdBarrier& b) {
    asm volatile("s_waitcnt vmcnt(0)" ::: "memory");
    __syncthreads();
    if (threadIdx.x == 0) {
        unsigned* bar = b.bar;
        __builtin_amdgcn_s_waitcnt(0);
        unsigned nloc = b.st[0], nx = b.st[1];
        if (nloc == 0u) { xcd_barrier_complete(bar, b.x, nloc, nx); b.st[0] = nloc; b.st[1] = nx; }
        const unsigned old = xb_add(&bar[XB_XSUB(b.x)], 1u);
        const unsigned gen = old / nloc;
        if (old + 1u == (gen + 1u) * nloc) {
            __builtin_amdgcn_fence(__ATOMIC_RELEASE, "agent");
            asm volatile("s_waitcnt vmcnt(0)" ::: "memory");
            const unsigned og = xb_add(&bar[XB_TOP], 1u);
            const unsigned tg = og / nx;
            if (og + 1u == (tg + 1u) * nx) xb_add(&bar[XB_TOPGEN], 1u);
            else XB_SPIN(xb_ld(&bar[XB_TOPGEN]) == tg, bar);
            __builtin_amdgcn_fence(__ATOMIC_ACQUIRE, "agent");
            xb_add(&bar[XB_XGEN(b.x)], 1u);
            asm volatile("s_waitcnt vmcnt(0)" ::: "memory");
        } else {
            XB_SPIN(xb_ld(&bar[XB_XGEN(b.x)]) == gen, bar);
            __builtin_amdgcn_fence(__ATOMIC_ACQUIRE, "agent");
            asm volatile("s_waitcnt vmcnt(0)" ::: "memory");
        }
    }
    __syncthreads();
}
struct Frame {
    LAS unsigned char* lds;
    volatile LAS unsigned* MISC;
    gu32* ctl;
    int tid, lane, wave;
    int vcu, G;
    unsigned char* ws; float* out;
    const float* in[28]; const int* page_table;
};
struct Args { const void* in[28]; float* out; unsigned char* ws; int ph_lo, ph_hi, li, pad; };

__device__ __forceinline__ int in_srccol(int n0) {
    if (n0 < 1024) { const int t = n0 >> 8, w = n0 & 255, bj = w >> 7, wc = (w & 127) >> 5; return 256 * t + 64 * wc + 32 * bj; }
    if (n0 < 1536) return n0;
    if (n0 < 3072) return n0 + 8;
    return n0 + 16;
}
__device__ __forceinline__ void p0_transpose_item(const float* W, int ldw, bf16* WT, int ldk, int koff, int k0, int n0dst, int n0src, const float* gain, LAS float* scr, int lane) {
    { float v[32];
#pragma unroll
      for (int i = 0; i < 32; ++i) v[i] = W[(size_t)(k0 + 2 * i + (lane >> 5)) * ldw + n0src + (lane & 31)];
      if (gain) {
#pragma unroll
          for (int i = 0; i < 32; ++i) v[i] *= gain[k0 + 2 * i + (lane >> 5)]; }
#pragma unroll
      for (int i = 0; i < 32; ++i) scr[(2 * i + (lane >> 5)) * 33 + (lane & 31)] = v[i]; }
    LDS_WAIT(); asm volatile("" ::: "memory");
    const int c = lane & 7;
#pragma unroll
    for (int j = 0; j < 4; ++j) { const int n = (lane >> 3) + 8 * j; const LAS float* s = scr + (8 * c) * 33 + n;
        v4u o; o.x = pk2(s[0 * 33], s[1 * 33]); o.y = pk2(s[2 * 33], s[3 * 33]); o.z = pk2(s[4 * 33], s[5 * 33]); o.w = pk2(s[6 * 33], s[7 * 33]);
        *(GAS v4u*)(WT + (size_t)(n0dst + n) * ldk + koff + k0 + 8 * c) = o; }
    LDS_WAIT(); asm volatile("" ::: "memory");
}
__device__ __forceinline__ void p0_prologue(Frame& F) {
    LAS float* scr = (LAS float*)(F.lds + RING_OFF + F.wave * 16384);
    const int gw = F.vcu * NWAVES + F.wave, NGW = F.G * NWAVES;
    bf16* WIN = (bf16*)(F.ws + WS_WIN); bf16* WAB = (bf16*)(F.ws + WS_WAB); bf16* WOUT = (bf16*)(F.ws + WS_WOUT); bf16* WUP = (bf16*)(F.ws + WS_WUP);
    bf16* WDN = (bf16*)(F.ws + WS_WDN); bf16* WGT = (bf16*)(F.ws + WS_WGT); bf16* WPL = (bf16*)(F.ws + WS_WPL);
    constexpr int I_IN = 16 * 176, I_A = 8 * 32, I_B = 8 * 32, I_O = 16 * 32, I_UP = 16 * 128, I_DN = 64 * 32, I_G = 16 * 32, I_P = 4 * 32;
    constexpr int NITEMS = I_IN + I_A + I_B + I_O + I_UP + I_DN + I_G + I_P;
    for (int it = gw; it < NITEMS; it += NGW) {
        int r = it;
        if (r < I_IN) { const int kb = r / 176, nb = r % 176; p0_transpose_item(F.in[11], DIN, WIN, D, 0, 64 * kb, 32 * nb, in_srccol(32 * nb), nullptr, scr, F.lane); continue; } r -= I_IN;
        if (r < I_A) { const int kb = r / 32, nb = r % 32; p0_transpose_item(F.in[19], D, WAB, D, 0, 64 * kb, 32 * nb, 32 * nb, nullptr, scr, F.lane); continue; } r -= I_A;
        if (r < I_B) { const int kb = r / 32, nb = r % 32; p0_transpose_item(F.in[20], D, WAB, D, 512, 64 * kb, 32 * nb, 32 * nb, nullptr, scr, F.lane); continue; } r -= I_B;
        if (r < I_O) { const int kb = r / 32, nb = r % 32; p0_transpose_item(F.in[21], D, WOUT, D, 0, 64 * kb, 32 * nb, 32 * nb, nullptr, scr, F.lane); continue; } r -= I_O;
        if (r < I_UP) { const int kb = r / 128, nb = r % 128; p0_transpose_item(F.in[23], DFF, WUP, D, 0, 64 * kb, 32 * nb, 32 * nb, F.in[22], scr, F.lane); continue; } r -= I_UP;
        if (r < I_DN) { const int kb = r / 32, nb = r % 32; p0_transpose_item(F.in[24], D, WDN, DFF, 0, 64 * kb, 32 * nb, 32 * nb, nullptr, scr, F.lane); continue; } r -= I_DN;
        if (r < I_G) { const int kb = r / 32, nb = r % 32; p0_transpose_item(F.in[26], D, WGT, D, 0, 64 * kb, 32 * nb, 32 * nb, F.in[25], scr, F.lane); continue; } r -= I_G;
        { const int kb = r / 32, nb = r % 32; p0_transpose_item(F.in[27], D, WPL, PLE, 0, 64 * kb, 32 * nb, 32 * nb, nullptr, scr, F.lane); }
    }
    { const int gt = F.vcu * (NWAVES * 64) + F.tid;
      if (gt < 16 * D) { const int r = gt / D, k = gt % D; const int col = r < 8 ? 1536 + r : (r < 12 ? 3080 + (r - 8) : 3084 + (r - 12));
          WIN[(size_t)(5632 + r) * D + k] = (bf16)f2bf(F.in[11][(size_t)k * DIN + col]); } }
    { bf16* XN = (bf16*)(F.ws + WS_XN); const GAS f32x4* gr = (const GAS f32x4*)F.in[10] + F.lane; f32x4 g[4];
#pragma unroll
      for (int j = 0; j < 4; ++j) g[j] = gr[64 * j];
      for (int m0 = gw; m0 < MT; m0 += 2 * NGW) {
          const int m1 = m0 + NGW; const bool two = m1 < MT;
          const float* x0 = m0 < MP ? F.in[0] + (size_t)m0 * D : F.in[1] + (size_t)(m0 - MP) * D;
          const float* x1 = !two ? x0 : (m1 < MP ? F.in[0] + (size_t)m1 * D : F.in[1] + (size_t)(m1 - MP) * D);
          const GAS f32x4* r0 = (const GAS f32x4*)x0 + F.lane; const GAS f32x4* r1 = (const GAS f32x4*)x1 + F.lane; f32x4 v0[4], v1[4]; float s0 = 0.f, s1 = 0.f;
#pragma unroll
          for (int j = 0; j < 4; ++j) { v0[j] = r0[64 * j]; v1[j] = r1[64 * j]; }
#pragma unroll
          for (int j = 0; j < 4; ++j) { s0 += (v0[j].x * v0[j].x + v0[j].y * v0[j].y) + (v0[j].z * v0[j].z + v0[j].w * v0[j].w); s1 += (v1[j].x * v1[j].x + v1[j].y * v1[j].y) + (v1[j].z * v1[j].z + v1[j].w * v1[j].w); }
          const float rs0 = __builtin_amdgcn_rsqf(wave_sum(s0) * (1.f / D) + EPS), rs1 = __builtin_amdgcn_rsqf(wave_sum(s1) * (1.f / D) + EPS);
          GAS unsigned long long* o0 = (GAS unsigned long long*)(XN + (size_t)m0 * D) + F.lane;
#pragma unroll
          for (int j = 0; j < 4; ++j) { const f32x4 y = v0[j] * rs0 * g[j]; o0[64 * j] = (unsigned long long)pk2(y.x, y.y) | ((unsigned long long)pk2(y.z, y.w) << 32); }
          if (two) { GAS unsigned long long* o1 = (GAS unsigned long long*)(XN + (size_t)m1 * D) + F.lane;
#pragma unroll
              for (int j = 0; j < 4; ++j) { const f32x4 y = v1[j] * rs1 * g[j]; o1[64 * j] = (unsigned long long)pk2(y.x, y.y) | ((unsigned long long)pk2(y.z, y.w) << 32); } }
      } }
    { bf16* PLB = (bf16*)(F.ws + WS_PLB);
      for (int m0 = gw; m0 < MT; m0 += 4 * NGW) { f32x4 v[4];
#pragma unroll
          for (int k = 0; k < 4; ++k) { const int m = m0 + k * NGW; if (m < MT) { const float* pr = m < MP ? F.in[2] + (size_t)m * PLE : F.in[3] + (size_t)(m - MP) * PLE; v[k] = *((const GAS f32x4*)pr + F.lane); } }
#pragma unroll
          for (int k = 0; k < 4; ++k) { const int m = m0 + k * NGW; if (m < MT) *((GAS unsigned long long*)(PLB + (size_t)m * PLE) + F.lane) = (unsigned long long)pk2(v[k].x, v[k].y) | ((unsigned long long)pk2(v[k].z, v[k].w) << 32); } } }
    { float* PT = (float*)(F.ws + WS_SFX);
      for (int u = gw; u < DB * NPAGES; u += NGW) { const int page = F.page_table[u]; const f32x4* src = (const f32x4*)(F.in[6] + (size_t)page * PAGE * FH) + F.lane * 4;
          const f32x4 a = src[0], b2 = src[1], c = src[2], d = src[3];
          f32x4 lo = a + c, hi = b2 + d;
#pragma unroll
          for (int o = 1; o < 64; o <<= 1) {
#pragma unroll
              for (int i = 0; i < 4; ++i) { lo[i] += __shfl_xor(lo[i], o); hi[i] += __shfl_xor(hi[i], o); } }
          if (F.lane == 0) { *(f32x4*)(PT + (size_t)u * FH) = lo; *(f32x4*)(PT + (size_t)u * FH + 4) = hi; } } }
}

constexpr float DC_T2 = 48.f;
constexpr int DP_STRIDE = 68;
#define DPPF(v, ctrl) __builtin_bit_cast(float, __builtin_amdgcn_update_dpp(0, __builtin_bit_cast(int, (v)), (ctrl), 0xf, 0xf, true))
__device__ __forceinline__ float red16(float v) { v += DPPF(v, 0xB1); v += DPPF(v, 0x4E); v += DPPF(v, 0x141); v += DPPF(v, 0x140); return v; }
__device__ __forceinline__ int wave_fetch(Frame& F, int qi, int lane) { unsigned v = 0; if (lane == 0) v = __hip_atomic_fetch_add((unsigned*)(F.ctl + CW_Q + 64 * qi), 1u, __ATOMIC_RELAXED, __HIP_MEMORY_SCOPE_AGENT); return (int)__builtin_amdgcn_readfirstlane(v); }
constexpr int DEC_XL_OFF = 110592, DEC_XL_WAVE = 640;
__device__ __forceinline__ void decode_unit(Frame& F, int unit, int h) {
    int tid_o = threadIdx.x; asm volatile("" : "+v"(tid_o));
    const int s = unit >> 6, pg = unit & 63, wv = __builtin_amdgcn_readfirstlane(tid_o >> 6), lane = tid_o & 63, dc = lane & 15, sub = lane >> 4;
    const bf16* QB = (const bf16*)(F.ws + WS_QB); const bf16* KB = (const bf16*)(F.ws + WS_KB); const float* LGF = (const float*)(F.ws + WS_LGF);
    const float* PT = (const float*)(F.ws + WS_SFX);
    const int page = F.page_table[s * NPAGES + pg];
    const float* kp = F.in[4] + (size_t)page * PAGE * FW + h * 64 + dc * 4; const float* vp = F.in[5] + (size_t)page * PAGE * FW + h * 64 + dc * 4;
    v2u qw[4], kw[4]; float lg[4];
#pragma unroll
    for (int j = 0; j < 4; ++j) { const size_t row = MP + s * 4 + j; qw[j] = *(const v2u*)(QB + row * FW + h * 64 + dc * 4); kw[j] = *(const v2u*)(KB + row * FW + h * 64 + dc * 4); lg[j] = LGF[row * 8 + h]; }
    const float pt = (lane > pg) ? PT[((size_t)s * NPAGES + lane) * FH + h] : 0.f;
    const float* lp = F.in[6] + (size_t)page * PAGE * FH + h; const float l0 = lp[(size_t)lane * FH], l1 = lp[(size_t)(64 + lane) * FH];
    f32x4 kx[32];
#pragma unroll
    for (int i = 0; i < 32; ++i) kx[i] = __builtin_nontemporal_load((const f32x4*)(kp + (size_t)(4 * i + sub) * FW));
    float q[4][4], xself[4], cnew[4];
    { float run = 0.f;
#pragma unroll
      for (int j = 0; j < 4; ++j) {
          q[j][0] = bflo(qw[j].x); q[j][1] = bfhi(qw[j].x); q[j][2] = bflo(qw[j].y); q[j][3] = bfhi(qw[j].y);
          xself[j] = red16(q[j][0] * bflo(kw[j].x) + q[j][1] * bfhi(kw[j].x) + q[j][2] * bflo(kw[j].y) + q[j][3] * bfhi(kw[j].y));
          run += lg[j]; cnew[j] = run * LOG2E; } }
    LAS float* xl = (LAS float*)(F.lds + DEC_XL_OFF) + wv * DEC_XL_WAVE; LAS float* sfl = xl + 512;
    float pm[4] = {-INFINITY, -INFINITY, -INFINITY, -INFINITY};
    { const float off = wave_sum(pt);
      float s0 = l0, s1 = l1;
#pragma unroll
      for (int o = 1; o < 64; o <<= 1) { const float t0 = __shfl_down(s0, o), t1 = __shfl_down(s1, o); if (lane + o < 64) { s0 += t0; s1 += t1; } }
      const float tot1 = __shfl(s1, 0);
      sfl[64 + lane] = (off + s1 - l1) * LOG2E; sfl[lane] = (off + tot1 + s0 - l0) * LOG2E; }
    LDS_WAIT();
#pragma unroll
    for (int i = 0; i < 32; ++i) { float d[4]; const float sf = sfl[4 * i + sub];
#pragma unroll
        for (int j = 0; j < 4; ++j) { d[j] = red16(q[j][0] * kx[i][0] + q[j][1] * kx[i][1] + q[j][2] * kx[i][2] + q[j][3] * kx[i][3]) + sf + cnew[j]; pm[j] = fmaxf(pm[j], d[j]); }
        if (dc == 0) *(LAS f32x4*)(xl + (4 * i + sub) * 4) = (f32x4){d[0], d[1], d[2], d[3]}; }
    bool need = false;
#pragma unroll
    for (int j = 0; j < 4; ++j) { pm[j] = fmaxf(pm[j], __shfl_xor(pm[j], 16)); pm[j] = fmaxf(pm[j], __shfl_xor(pm[j], 32)); need = need || (pm[j] >= xself[j] - DC_T2); }
    float* dp = (float*)(F.ws + WS_DPART) + ((size_t)((s * FH + h) * NPAGES + pg) * 4) * DP_STRIDE;
    if (!need) { if (lane < 4) { dp[lane * DP_STRIDE] = -INFINITY; dp[lane * DP_STRIDE + 1] = 0.f; } return; }
    float o[4][4] = {}, l[4] = {0.f, 0.f, 0.f, 0.f};
    LDS_WAIT();
#pragma unroll 1
    for (int qt = 0; qt < 4; ++qt) {
        f32x4 vx[8];
#pragma unroll
        for (int i = 0; i < 8; ++i) { const int pos = 4 * (8 * qt + i) + sub; vx[i] = __builtin_nontemporal_load((const f32x4*)(vp + (size_t)pos * FW)); }
#pragma unroll
        for (int i = 0; i < 8; ++i) { const f32x4 xv = *(const LAS f32x4*)(xl + (4 * (8 * qt + i) + sub) * 4);
#pragma unroll
            for (int j = 0; j < 4; ++j) { const float p = __builtin_amdgcn_exp2f(xv[j] - pm[j]); l[j] += p;
                o[j][0] += p * vx[i][0]; o[j][1] += p * vx[i][1]; o[j][2] += p * vx[i][2]; o[j][3] += p * vx[i][3]; } }
    }
#pragma unroll
    for (int j = 0; j < 4; ++j) { l[j] += __shfl_xor(l[j], 16); l[j] += __shfl_xor(l[j], 32);
#pragma unroll
        for (int d = 0; d < 4; ++d) { o[j][d] += __shfl_xor(o[j][d], 16); o[j][d] += __shfl_xor(o[j][d], 32); }
        if (sub == 0) *(f32x4*)(dp + j * DP_STRIDE + 4 + dc * 4) = (f32x4){o[j][0], o[j][1], o[j][2], o[j][3]};
        if (lane == 0) { dp[j * DP_STRIDE] = pm[j]; dp[j * DP_STRIDE + 1] = l[j]; } }
}
__device__ __forceinline__ void decode_combine_row(Frame& F, int rowid) {
    const int s = rowid >> 5, h = (rowid >> 2) & 7, j = rowid & 3, lane = F.lane;
    const bf16* QB = (const bf16*)(F.ws + WS_QB); const float* LGF = (const float*)(F.ws + WS_LGF);
    const float* dp = (const float*)(F.ws + WS_DPART) + ((size_t)((s * FH + h) * NPAGES) * 4 + j) * DP_STRIDE;
    const size_t row = MP + s * 4 + j;
    const float qd = bf2f(QB[row * FW + h * 64 + lane]);
    float xn[4], cum[4]; { float run = 0.f;
#pragma unroll
      for (int i = 0; i < 4; ++i) { run += LGF[(MP + s * 4 + i) * 8 + h]; cum[i] = run * LOG2E; } }
    float m = -INFINITY;
#pragma unroll
    for (int i = 0; i < 4; ++i) { const float kd = F.out[OFF_KS + (size_t)(s * 4 + i) * FW + h * 64 + lane]; float d = wave_sum(qd * kd) + cum[j] - cum[i]; xn[i] = (i <= j) ? d : -INFINITY; m = fmaxf(m, xn[i]); }
    const float pmv = dp[(size_t)lane * 4 * DP_STRIDE], plv = dp[(size_t)lane * 4 * DP_STRIDE + 1];
    float mm = (plv > 0.f) ? pmv : -INFINITY;
#pragma unroll
    for (int o = 1; o < 64; o <<= 1) mm = fmaxf(mm, __shfl_xor(mm, o));
    m = fmaxf(m, mm);
    float acc = 0.f, l = 0.f;
#pragma unroll
    for (int i = 0; i < 4; ++i) { const float p = __builtin_amdgcn_exp2f(xn[i] - m); l += p; acc += p * F.out[OFF_VS + (size_t)(s * 4 + i) * FW + h * 64 + lane]; }
    for (int pg = 0; pg < NPAGES; ++pg) { const float pl = __shfl(plv, pg); if (pl > 0.f) { const float f = __builtin_amdgcn_exp2f(__shfl(pmv, pg) - m); l += pl * f; acc += f * dp[(size_t)pg * 4 * DP_STRIDE + 4 + lane]; } }
    ((bf16*)(F.ws + WS_OAB))[row * D + h * 64 + lane] = (bf16)f2bf(acc / l);
}
constexpr size_t GU_WF = 0, GU_QD = 16384, GU_KDT = 32768, GU_QKM = 49152, GU_U = 57344, GU_DEC = 90112, GU_BYTES = 90368;
static_assert(WS_GDN + (size_t)1024 * GU_BYTES <= WS_OG, "gdn ws");
constexpr int G1_QS = 0, G1_KS = 17408, G1_KB = 34816, G1_VB = 55296, G1_A = 75776, G1_T = 93184, G1_QK = 102400, G1_SC = 110592, G1_TF = 111616  , G1_WST = 0  ;
constexpr int G1_PQ = 272, G1_PX = 320, G1_PA = 272, G1_PT = 144;

__device__ __forceinline__ f32x16 mfma32(bf16x8 a, bf16x8 b, f32x16 c) { return __builtin_amdgcn_mfma_f32_32x32x16_bf16(a, b, c, 0, 0, 0); }
__device__ __forceinline__ int crow(int r, int hi) { return (r & 3) + 8 * (r >> 2) + 4 * hi; }
__device__ __forceinline__ s16x4 tr_read(unsigned lds_addr) { s16x4 r; asm volatile("ds_read_b64_tr_b16 %0, %1\n\ts_waitcnt lgkmcnt(0)" : "=&v"(r) : "v"(lds_addr) : "memory"); return r; }

struct PrepIn { v4u xr[3][4][2]; float s0, s1, s2, s3; };
__device__ __forceinline__ void prep_load(Frame& F, PrepIn& in, int unit, int tid) {
    const int bh = unit >> 7, n = unit & 127, b = bh >> 2, h = bh & 3, lane = tid & 63;
    const bf16* GQ = (const bf16*)(F.ws + WS_GQ); const float* GAB = (const float*)(F.ws + WS_GAB); const size_t row0 = (size_t)b * SEQ + (size_t)n * 64;
    in.s0 = 0.f; in.s1 = 0.f; in.s2 = 0.f; in.s3 = 0.f;
    if (tid < 64) { in.s0 = GAB[(row0 + lane) * 8 + h]; in.s1 = GAB[(row0 + lane) * 8 + 4 + h]; }
    else if (tid < 64 + 384) { const int c = tid - 64, ch = (c >> 7) * 512 + h * 128 + (c & 127); const float* cw = F.in[15]; in.s0 = cw[ch]; in.s1 = cw[CCH + ch]; in.s2 = cw[2 * CCH + ch]; in.s3 = cw[3 * CCH + ch]; }
    const int i = tid >> 3, sg = tid & 7;
#pragma unroll
    for (int X = 0; X < 3; ++X)
#pragma unroll
        for (int d = 0; d < 4; ++d) { const int tok = n * 64 + i - 3 + d; const int cbase = X * 512 + h * 128 + sg * 16;
            if (tok >= 0) { in.xr[X][d][0] = *(const v4u*)(GQ + ((size_t)b * SEQ + tok) * CCH + cbase); in.xr[X][d][1] = *(const v4u*)(GQ + ((size_t)b * SEQ + tok) * CCH + cbase + 8); }
            else { in.xr[X][d][0] = (v4u){0u, 0u, 0u, 0u}; in.xr[X][d][1] = (v4u){0u, 0u, 0u, 0u}; } }
}
template <int VAR>
__device__ __forceinline__ void gdn_prep_unit(Frame& F, int unit, PrepIn& in, int next_unit) {
    const int bh = unit >> 7, n = unit & 127, b = bh >> 2, h = bh & 3;
    int tid_o = threadIdx.x; asm volatile("" : "+v"(tid_o));
    const int tid = tid_o, lane = tid & 63, wave = __builtin_amdgcn_readfirstlane(tid >> 6);
    LAS unsigned char* L = F.lds + RING_OFF;
    LAS float* sc = (LAS float*)(L + G1_SC);
    const bf16* GQ = (const bf16*)(F.ws + WS_GQ); const float* GAB = (const float*)(F.ws + WS_GAB);
    const size_t row0 = (size_t)b * SEQ + (size_t)n * 64;
    unsigned char* gu = F.ws + WS_GDN + (size_t)unit * GU_BYTES;
    __syncthreads();
    if (wave == 0) {
        const float g = in.s0, be = in.s1;
        float c = g;
#pragma unroll
        for (int o = 1; o < 64; o <<= 1) { const float t = __shfl_up(c, o); if (lane >= o) c += t; }
        const float cl = __shfl(c, 63);
        sc[lane] = c; sc[64 + lane] = be; sc[128 + lane] = __expf(c); sc[192 + lane] = __expf(cl - c);
        if (lane == 0) *(float*)(gu + GU_DEC) = __expf(cl);
    } else if (tid < 64 + 384) {
        const int c = tid - 64;
        *(LAS float*)(L + G1_TF + (0 * 384 + c) * 4) = in.s0; *(LAS float*)(L + G1_TF + (1 * 384 + c) * 4) = in.s1; *(LAS float*)(L + G1_TF + (2 * 384 + c) * 4) = in.s2; *(LAS float*)(L + G1_TF + (3 * 384 + c) * 4) = in.s3;
    }
    __syncthreads();
    {
        const int i = tid >> 3, sg = tid & 7;
        const float ecum = sc[128 + i], beta = sc[64 + i];
#pragma unroll
        for (int X = 0; X < 3; ++X) {
            float y[16];
#pragma unroll
            for (int c = 0; c < 16; ++c) y[c] = 0.f;
#pragma unroll
            for (int d = 0; d < 4; ++d) {
                const v4u x0 = in.xr[X][d][0], x1 = in.xr[X][d][1]; const LAS float* wl = (const LAS float*)(L + G1_TF) + d * 384 + X * 128 + sg * 16;
                const f32x4 w0 = *(const LAS f32x4*)(wl), w1 = *(const LAS f32x4*)(wl + 4), w2 = *(const LAS f32x4*)(wl + 8), w3 = *(const LAS f32x4*)(wl + 12);
                y[0] += w0[0] * bflo(x0.x); y[1] += w0[1] * bfhi(x0.x); y[2] += w0[2] * bflo(x0.y); y[3] += w0[3] * bfhi(x0.y);
                y[4] += w1[0] * bflo(x0.z); y[5] += w1[1] * bfhi(x0.z); y[6] += w1[2] * bflo(x0.w); y[7] += w1[3] * bfhi(x0.w);
                y[8] += w2[0] * bflo(x1.x); y[9] += w2[1] * bfhi(x1.x); y[10] += w2[2] * bflo(x1.y); y[11] += w2[3] * bfhi(x1.y);
                y[12] += w3[0] * bflo(x1.z); y[13] += w3[1] * bfhi(x1.z); y[14] += w3[2] * bflo(x1.w); y[15] += w3[3] * bfhi(x1.w);
            }
            float ss = 0.f;
#pragma unroll
            for (int c = 0; c < 16; ++c) { y[c] = y[c] * __builtin_amdgcn_rcpf(1.0f + __expf(-y[c])); ss += y[c] * y[c]; }
            if (X < 2) {
                ss += __shfl_xor(ss, 1); ss += __shfl_xor(ss, 2); ss += __shfl_xor(ss, 4);
                float rn = __builtin_amdgcn_rsqf(ss + EPS); if (X == 0) rn *= 0.08838834764831845f;
#pragma unroll
                for (int c = 0; c < 16; ++c) y[c] *= rn;
            }
            if (X == 0) {
                v4u a, c2; a.x = pk2(y[0], y[1]); a.y = pk2(y[2], y[3]); a.z = pk2(y[4], y[5]); a.w = pk2(y[6], y[7]); c2.x = pk2(y[8], y[9]); c2.y = pk2(y[10], y[11]); c2.z = pk2(y[12], y[13]); c2.w = pk2(y[14], y[15]);
                *(LAS v4u*)(L + G1_QS + i * G1_PQ + sg * 32) = a; *(LAS v4u*)(L + G1_QS + i * G1_PQ + sg * 32 + 16) = c2;
                v4u d0, d1; d0.x = pk2(y[0] * ecum, y[1] * ecum); d0.y = pk2(y[2] * ecum, y[3] * ecum); d0.z = pk2(y[4] * ecum, y[5] * ecum); d0.w = pk2(y[6] * ecum, y[7] * ecum);
                d1.x = pk2(y[8] * ecum, y[9] * ecum); d1.y = pk2(y[10] * ecum, y[11] * ecum); d1.z = pk2(y[12] * ecum, y[13] * ecum); d1.w = pk2(y[14] * ecum, y[15] * ecum);
                const int mt = i >> 4, fr = i & 15, s = sg >> 1, fq0 = (sg & 1) * 2;
                *(v4u*)(gu + GU_QD + ((size_t)((mt * 4 + s) * 64 + fq0 * 16 + fr)) * 16) = d0;
                *(v4u*)(gu + GU_QD + ((size_t)((mt * 4 + s) * 64 + (fq0 + 1) * 16 + fr)) * 16) = d1;
            } else if (X == 1) {
                v4u a, c2; a.x = pk2(y[0], y[1]); a.y = pk2(y[2], y[3]); a.z = pk2(y[4], y[5]); a.w = pk2(y[6], y[7]); c2.x = pk2(y[8], y[9]); c2.y = pk2(y[10], y[11]); c2.z = pk2(y[12], y[13]); c2.w = pk2(y[14], y[15]);
                *(LAS v4u*)(L + G1_KS + i * G1_PQ + sg * 32) = a; *(LAS v4u*)(L + G1_KS + i * G1_PQ + sg * 32 + 16) = c2;
                const float f = beta * ecum;
                a.x = pk2(y[0] * f, y[1] * f); a.y = pk2(y[2] * f, y[3] * f); a.z = pk2(y[4] * f, y[5] * f); a.w = pk2(y[6] * f, y[7] * f); c2.x = pk2(y[8] * f, y[9] * f); c2.y = pk2(y[10] * f, y[11] * f); c2.z = pk2(y[12] * f, y[13] * f); c2.w = pk2(y[14] * f, y[15] * f);
                *(LAS v4u*)(L + G1_KB + i * G1_PX + sg * 32) = a; *(LAS v4u*)(L + G1_KB + i * G1_PX + sg * 32 + 16) = c2;
            } else {
                v4u a, c2; a.x = pk2(y[0] * beta, y[1] * beta); a.y = pk2(y[2] * beta, y[3] * beta); a.z = pk2(y[4] * beta, y[5] * beta); a.w = pk2(y[6] * beta, y[7] * beta);
                c2.x = pk2(y[8] * beta, y[9] * beta); c2.y = pk2(y[10] * beta, y[11] * beta); c2.z = pk2(y[12] * beta, y[13] * beta); c2.w = pk2(y[14] * beta, y[15] * beta);
                *(LAS v4u*)(L + G1_VB + i * G1_PX + sg * 32) = a; *(LAS v4u*)(L + G1_VB + i * G1_PX + sg * 32 + 16) = c2;
            }
        }
    }
    if (next_unit >= 0) prep_load(F, in, next_unit, tid);
    __syncthreads();
    if (VAR == 2) return;
    {
        const int which = wave >> 2, ti = (wave >> 1) & 1, tj = wave & 1, r = lane & 31, hh = lane >> 5;
        const LAS unsigned char* Ap = L + (which ? G1_QS : G1_KS) + (32 * ti + r) * G1_PQ + hh * 16;
        const LAS unsigned char* Bp = L + G1_KS + (32 * tj + r) * G1_PQ + hh * 16;
        f32x16 acc = {};
#pragma unroll
        for (int s = 0; s < 8; ++s) acc = mfma32(*(const LAS bf16x8*)(Ap + s * 32), *(const LAS bf16x8*)(Bp + s * 32), acc);
        const int j = 32 * tj + r; const float cj = sc[j];
        if (which == 0) {
#pragma unroll
            for (int reg = 0; reg < 16; ++reg) { const int i = 32 * ti + crow(reg, hh); const float v = (i > j) ? sc[64 + i] * acc[reg] * __expf(sc[i] - cj) : 0.f;
                *(LAS float*)(L + G1_A + i * G1_PA + j * 4) = v; }
        } else {
#pragma unroll
            for (int reg = 0; reg < 16; ++reg) { const int i = 32 * ti + crow(reg, hh); const float v = (i >= j) ? acc[reg] * __expf(sc[i] - cj) : 0.f;
                *(LAS unsigned short*)(L + G1_QK + i * 128 + j * 2) = (unsigned short)f2bf(v); }
        }
    }
    __syncthreads();
    if (wave == 0 && VAR != 1) {
        const int bk = lane >> 4, c = lane & 15; float t[16];
#pragma unroll
        for (int i = 0; i < 16; ++i) {
            float a = (c == i) ? 1.f : 0.f;
#pragma unroll
            for (int j4 = 0; j4 < (i + 3) / 4; ++j4) { const f32x4 av = *(const LAS f32x4*)(L + G1_A + (16 * bk + i) * G1_PA + (16 * bk + 4 * j4) * 4);
#pragma unroll
                for (int q = 0; q < 4; ++q) { const int j = 4 * j4 + q; if (j < i) a -= av[q] * t[j]; } }
            t[i] = a;
            *(LAS float*)(L + G1_TF + (16 * bk + i) * G1_PA + (16 * bk + c) * 4) = a;
        }
    } else if (wave != 0) {
        const int t7 = tid - 64;
        for (int e = t7; e < 6 * 256; e += 448) { const int bq = e >> 8, w = e & 255; const int br = bq < 3 ? 0 : (bq < 5 ? 1 : 2), bc = bq < 3 ? bq + 1 : (bq < 5 ? bq - 1 : 3);
            *(LAS float*)(L + G1_TF + (16 * br + (w >> 4)) * G1_PA + (16 * bc + (w & 15)) * 4) = 0.f; }
        for (int e = t7; e < 512; e += 448) {
            const int i = e >> 3, j0 = (e & 7) * 8; const v4u v = *(const LAS v4u*)(L + G1_QK + i * 128 + j0 * 2);
            const int mt = i >> 4, fr = i & 15, s = j0 >> 5, fq = (j0 & 31) >> 3;
            *(v4u*)(gu + GU_QKM + (size_t)((mt * 2 + s) * 64 + fq * 16 + fr) * 16) = v; }
        for (int e = t7; e < 1024; e += 448) {
            const int dk = e & 127, i0 = (e >> 7) * 8; unsigned short v[8];
#pragma unroll
            for (int q = 0; q < 8; ++q) v[q] = (unsigned short)f2bf(bf2f(*(const LAS unsigned short*)(L + G1_KS + (i0 + q) * G1_PQ + dk * 2)) * sc[192 + i0 + q]);
            v4u o; o.x = v[0] | ((unsigned)v[1] << 16); o.y = v[2] | ((unsigned)v[3] << 16); o.z = v[4] | ((unsigned)v[5] << 16); o.w = v[6] | ((unsigned)v[7] << 16);
            const int mt = dk >> 4, fr = dk & 15, s = i0 >> 5, fq = (i0 & 31) >> 3;
            *(v4u*)(gu + GU_KDT + (size_t)((mt * 2 + s) * 64 + fq * 16 + fr) * 16) = o; }
    }
    __syncthreads();
    if (VAR != 1) {
        const int i16 = lane & 15, kk = lane >> 4;
        if (wave < 2) {
            const int r0 = 32 * wave; f32x4s x = {0.f, 0.f, 0.f, 0.f}, y = {0.f, 0.f, 0.f, 0.f};
#pragma unroll
            for (int s4 = 0; s4 < 4; ++s4) x = __builtin_amdgcn_mfma_f32_16x16x4f32(*(const LAS float*)(L + G1_A + (r0 + 16 + i16) * G1_PA + (r0 + 4 * s4 + kk) * 4),
                                                                                     *(const LAS float*)(L + G1_TF + (r0 + 4 * s4 + kk) * G1_PA + (r0 + i16) * 4), x, 0, 0, 0);
#pragma unroll
            for (int s4 = 0; s4 < 4; ++s4) y = __builtin_amdgcn_mfma_f32_16x16x4f32(*(const LAS float*)(L + G1_TF + (r0 + 16 + i16) * G1_PA + (r0 + 16 + 4 * kk + s4) * 4), x[s4], y, 0, 0, 0);
#pragma unroll
            for (int r = 0; r < 4; ++r) *(LAS float*)(L + G1_TF + (r0 + 16 + 4 * kk + r) * G1_PA + (r0 + i16) * 4) = -y[r];
        }
    }
    __syncthreads();
    if (VAR != 1) {
        const int i16 = lane & 15, kk = lane >> 4;
        if (wave < 4) {
            const int ti = wave >> 1, tj = wave & 1; f32x4s y0 = {0.f, 0.f, 0.f, 0.f}, y1 = {0.f, 0.f, 0.f, 0.f}, z = {0.f, 0.f, 0.f, 0.f};
#pragma unroll
            for (int s8 = 0; s8 < 8; ++s8) { const float bq = *(const LAS float*)(L + G1_TF + (4 * s8 + kk) * G1_PA + (16 * tj + i16) * 4);
                y0 = __builtin_amdgcn_mfma_f32_16x16x4f32(*(const LAS float*)(L + G1_A + (32 + i16) * G1_PA + (4 * s8 + kk) * 4), bq, y0, 0, 0, 0);
                y1 = __builtin_amdgcn_mfma_f32_16x16x4f32(*(const LAS float*)(L + G1_A + (48 + i16) * G1_PA + (4 * s8 + kk) * 4), bq, y1, 0, 0, 0); }
#pragma unroll
            for (int s4 = 0; s4 < 4; ++s4) z = __builtin_amdgcn_mfma_f32_16x16x4f32(*(const LAS float*)(L + G1_TF + (32 + 16 * ti + i16) * G1_PA + (32 + 4 * kk + s4) * 4), y0[s4], z, 0, 0, 0);
#pragma unroll
            for (int s4 = 0; s4 < 4; ++s4) z = __builtin_amdgcn_mfma_f32_16x16x4f32(*(const LAS float*)(L + G1_TF + (32 + 16 * ti + i16) * G1_PA + (48 + 4 * kk + s4) * 4), y1[s4], z, 0, 0, 0);
#pragma unroll
            for (int r = 0; r < 4; ++r) *(LAS float*)(L + G1_TF + (32 + 16 * ti + 4 * kk + r) * G1_PA + (16 * tj + i16) * 4) = -z[r];
        }
    }
    __syncthreads();
    { const int i = tid >> 3, c0 = (tid & 7) * 8;
      const f32x4 a = *(const LAS f32x4*)(L + G1_TF + i * G1_PA + c0 * 4), c = *(const LAS f32x4*)(L + G1_TF + i * G1_PA + c0 * 4 + 16);
      v4u o; o.x = pk2(a[0], a[1]); o.y = pk2(a[2], a[3]); o.z = pk2(c[0], c[1]); o.w = pk2(c[2], c[3]); *(LAS v4u*)(L + G1_T + i * G1_PT + c0 * 2) = o; }
    __syncthreads();
    {
        const int ti = wave >> 2, cb = wave & 3, r = lane & 31, hh = lane >> 5;
        const unsigned lbase = (unsigned)(uintptr_t)L;
        const int q = (lane & 15) >> 2, p = lane & 3, blk = (lane >> 4) & 1;
        f32x16 au = {}, aw = {};
        const unsigned rv = lbase + G1_VB + (unsigned)((8 * hh + q) * G1_PX + (32 * cb + 16 * blk + 4 * p) * 2), rk = rv + (G1_KB - G1_VB);
        s16x4 xv[8], xk[8];
#define G1_TR8(dst, base) asm volatile("ds_read_b64_tr_b16 %0, %8 offset:%c9\n\tds_read_b64_tr_b16 %1, %8 offset:%c10\n\tds_read_b64_tr_b16 %2, %8 offset:%c11\n\tds_read_b64_tr_b16 %3, %8 offset:%c12\n\t" \
            "ds_read_b64_tr_b16 %4, %8 offset:%c13\n\tds_read_b64_tr_b16 %5, %8 offset:%c14\n\tds_read_b64_tr_b16 %6, %8 offset:%c15\n\tds_read_b64_tr_b16 %7, %8 offset:%c16\n\ts_waitcnt lgkmcnt(0)" \
            : "=&v"(dst[0]), "=&v"(dst[1]), "=&v"(dst[2]), "=&v"(dst[3]), "=&v"(dst[4]), "=&v"(dst[5]), "=&v"(dst[6]), "=&v"(dst[7]) \
            : "v"(base), "i"(0), "i"(4 * G1_PX), "i"(16 * G1_PX), "i"(20 * G1_PX), "i"(32 * G1_PX), "i"(36 * G1_PX), "i"(48 * G1_PX), "i"(52 * G1_PX) : "memory")
        G1_TR8(xv, rv); G1_TR8(xk, rk);
#undef G1_TR8
#pragma unroll
        for (int s = 0; s < 4; ++s) {
            const bf16x8 ta = *(const LAS bf16x8*)(L + G1_T + (32 * ti + r) * G1_PT + (16 * s + 8 * hh) * 2);
            au = mfma32(ta, __builtin_shufflevector(xv[2 * s], xv[2 * s + 1], 0, 1, 2, 3, 4, 5, 6, 7), au);
            aw = mfma32(ta, __builtin_shufflevector(xk[2 * s], xk[2 * s + 1], 0, 1, 2, 3, 4, 5, 6, 7), aw);
        }
        const int c = 32 * cb + r, nt = c >> 4, fr = c & 15;
#pragma unroll
        for (int g = 0; g < 4; ++g) { const int rowb = 32 * ti + 8 * g + 4 * hh, mt = rowb >> 4, fq = (rowb & 15) >> 2;
            *(f32x4*)(gu + GU_U + (size_t)(((mt * 8 + nt) * 64) + fq * 16 + fr) * 16) = (f32x4){au[4 * g], au[4 * g + 1], au[4 * g + 2], au[4 * g + 3]}; }
        __syncthreads();
#pragma unroll
        for (int reg = 0; reg < 16; ++reg) { const int i = 32 * ti + crow(reg, hh); *(LAS unsigned short*)(L + G1_WST + i * 256 + c * 2) = (unsigned short)f2bf(aw[reg]); }
    }
    __syncthreads();
    for (int e = tid; e < 1024; e += 512) {
        const int i = e >> 4, dk0 = (e & 15) * 8; const v4u v = *(const LAS v4u*)(L + G1_WST + i * 256 + dk0 * 2);
        const int mt = i >> 4, fr = i & 15, s = dk0 >> 5, fq = (dk0 & 31) >> 3;
        *(v4u*)(gu + GU_WF + (size_t)((mt * 4 + s) * 64 + fq * 16 + fr) * 16) = v; }
}
constexpr int SC_SB = 0, SC_VN = 32 * 272, SC_AO = SC_VN + 32 * 144, SC_PS = 272, SC_PV = 144;
__device__ __forceinline__ f32x4s mfma16(bf16x8 a, bf16x8 b, f32x4s c) { return __builtin_amdgcn_mfma_f32_16x16x32_bf16(a, b, c, 0, 0, 0); }
struct ScanB { bf16x8 wf[4], qd[4]; f32x4s u[2]; };
struct ScanE { bf16x8 qk[2], kd[2][2]; float dec; };
__device__ __forceinline__ void scan_loadB(ScanB& f, const unsigned char* gu, int mp, int cq, int lane) {
#pragma unroll
    for (int s = 0; s < 4; ++s) { f.wf[s] = *(const bf16x8*)(gu + GU_WF + (size_t)((mp * 4 + s) * 64 + lane) * 16); f.qd[s] = *(const bf16x8*)(gu + GU_QD + (size_t)((mp * 4 + s) * 64 + lane) * 16); }
#pragma unroll
    for (int nt = 0; nt < 2; ++nt) f.u[nt] = *(const f32x4s*)(gu + GU_U + (size_t)(((mp * 8 + 2 * cq + nt) * 64) + lane) * 16);
}
__device__ __forceinline__ void scan_loadE(ScanE& f, const unsigned char* gu, int mp, int lane) {
#pragma unroll
    for (int s = 0; s < 2; ++s) { f.qk[s] = *(const bf16x8*)(gu + GU_QKM + (size_t)((mp * 2 + s) * 64 + lane) * 16);
        f.kd[0][s] = *(const bf16x8*)(gu + GU_KDT + (size_t)(((2 * mp) * 2 + s) * 64 + lane) * 16); f.kd[1][s] = *(const bf16x8*)(gu + GU_KDT + (size_t)(((2 * mp + 1) * 2 + s) * 64 + lane) * 16); }
    f.dec = *(const float*)(gu + GU_DEC);
}
__device__ __forceinline__ void scan_stepB(const ScanB& f, LAS unsigned char* L, int mp, int lane, int fr, int fq) {
    f32x4s av[2] = {{0.f, 0.f, 0.f, 0.f}, {0.f, 0.f, 0.f, 0.f}}, ao[2] = {{0.f, 0.f, 0.f, 0.f}, {0.f, 0.f, 0.f, 0.f}};
#pragma unroll
    for (int s = 0; s < 4; ++s)
#pragma unroll
        for (int nt = 0; nt < 2; ++nt) { const bf16x8 sb = *(const LAS bf16x8*)(L + SC_SB + (16 * nt + fr) * SC_PS + (32 * s + 8 * fq) * 2); av[nt] = mfma16(f.wf[s], sb, av[nt]); ao[nt] = mfma16(f.qd[s], sb, ao[nt]); }
#pragma unroll
    for (int nt = 0; nt < 2; ++nt) { const f32x4s vn = f.u[nt] - av[nt]; v2u w; w.x = pk2(vn[0], vn[1]); w.y = pk2(vn[2], vn[3]);
        *(LAS v2u*)(L + SC_VN + (16 * nt + fr) * SC_PV + (16 * mp + 4 * fq) * 2) = w; *(LAS f32x4s*)(L + SC_AO + ((mp * 2 + nt) * 64 + lane) * 16) = ao[nt]; }
    __syncthreads();
    __syncthreads();
}
__device__ __forceinline__ void scan_stepE(const ScanE& f, f32x4s (&S)[2][2], LAS unsigned char* L, float* og, int mp, int lane, int fr, int fq, unsigned* prog, unsigned stepno) {
    __syncthreads();
    bf16x8 vb[2][2];
#pragma unroll
    for (int nt = 0; nt < 2; ++nt)
#pragma unroll
        for (int s = 0; s < 2; ++s) vb[nt][s] = *(const LAS bf16x8*)(L + SC_VN + (16 * nt + fr) * SC_PV + (32 * s + 8 * fq) * 2);
#pragma unroll
    for (int nt = 0; nt < 2; ++nt) { f32x4s o = *(const LAS f32x4s*)(L + SC_AO + ((mp * 2 + nt) * 64 + lane) * 16);
#pragma unroll
        for (int s = 0; s < 2; ++s) o = mfma16(f.qk[s], vb[nt][s], o);
#pragma unroll
        for (int i = 0; i < 4; ++i) og[(size_t)(16 * mp + 4 * fq + i) * 512 + 16 * nt + fr] = o[i]; }
#pragma unroll
    for (int t = 0; t < 2; ++t)
#pragma unroll
        for (int nt = 0; nt < 2; ++nt) { S[t][nt] = S[t][nt] * f.dec;
#pragma unroll
            for (int s = 0; s < 2; ++s) S[t][nt] = mfma16(f.kd[t][s], vb[nt][s], S[t][nt]);
            v2u w; w.x = pk2(S[t][nt][0], S[t][nt][1]); w.y = pk2(S[t][nt][2], S[t][nt][3]); *(LAS v2u*)(L + SC_SB + (16 * nt + fr) * SC_PS + (16 * (2 * mp + t) + 4 * fq) * 2) = w; }
    if (prog && lane == 0) __hip_atomic_store(prog, stepno, __ATOMIC_RELAXED, __HIP_MEMORY_SCOPE_AGENT);
    __syncthreads();
}
template <int VAR>
__device__ __forceinline__ void gdn_scan_unit(Frame& F, int unit) {
    const int bh = unit >> 2, cq = unit & 3, b = bh >> 2, h = bh & 3;
    int tid_o = threadIdx.x; asm volatile("" : "+v"(tid_o));
    const int lane = tid_o & 63, wave = __builtin_amdgcn_readfirstlane(tid_o >> 6), mp = wave & 3, fr = lane & 15, fq = lane >> 4;
    LAS unsigned char* L = F.lds + RING_OFF;
    __syncthreads();
    for (int e = tid_o; e < (32 * 272) / 4; e += NWAVES * 64) ((LAS unsigned*)(L + SC_SB))[e] = 0u;
    __syncthreads();
    const unsigned char* gu0 = F.ws + WS_GDN + (size_t)(bh * 128) * GU_BYTES;
    if (wave < 4) {
        ScanB f0, f1, f2, f3;
        scan_loadB(f0, gu0, mp, cq, lane); scan_loadB(f1, gu0 + GU_BYTES, mp, cq, lane); scan_loadB(f2, gu0 + 2 * GU_BYTES, mp, cq, lane);
        for (int n = 0; n < 128; n += 4) {
            if (VAR != 1) scan_loadB(f3, gu0 + (size_t)(n + 3) * GU_BYTES, mp, cq, lane); if (VAR != 2) scan_stepB(f0, L, mp, lane, fr, fq); else asm volatile("" :: "v"(f0.wf[0]), "v"(f0.qd[3]), "v"(f0.u[1]));
            if (VAR != 1 && n + 4 < 128) scan_loadB(f0, gu0 + (size_t)(n + 4) * GU_BYTES, mp, cq, lane); if (VAR != 2) scan_stepB(VAR == 1 ? f0 : f1, L, mp, lane, fr, fq); else asm volatile("" :: "v"(f1.wf[0]), "v"(f1.qd[3]), "v"(f1.u[1]));
            if (VAR != 1 && n + 5 < 128) scan_loadB(f1, gu0 + (size_t)(n + 5) * GU_BYTES, mp, cq, lane); if (VAR != 2) scan_stepB(VAR == 1 ? f0 : f2, L, mp, lane, fr, fq); else asm volatile("" :: "v"(f2.wf[0]), "v"(f2.qd[3]), "v"(f2.u[1]));
            if (VAR != 1 && n + 6 < 128) scan_loadB(f2, gu0 + (size_t)(n + 6) * GU_BYTES, mp, cq, lane); if (VAR != 2) scan_stepB(VAR == 1 ? f0 : f3, L, mp, lane, fr, fq); else asm volatile("" :: "v"(f3.wf[0]), "v"(f3.qd[3]), "v"(f3.u[1]));
        }
    } else {
        f32x4s S[2][2] = {{{0.f, 0.f, 0.f, 0.f}, {0.f, 0.f, 0.f, 0.f}}, {{0.f, 0.f, 0.f, 0.f}, {0.f, 0.f, 0.f, 0.f}}};
        float* og0 = (float*)(F.ws + WS_OG) + (size_t)b * SEQ * 512 + h * 128 + 32 * cq;
        unsigned* prog = nullptr;
        ScanE f0, f1, f2, f3;
        scan_loadE(f0, gu0, mp, lane); scan_loadE(f1, gu0 + GU_BYTES, mp, lane); scan_loadE(f2, gu0 + 2 * GU_BYTES, mp, lane);
        for (int n = 0; n < 128; n += 4) {
            if (VAR != 1) scan_loadE(f3, gu0 + (size_t)(n + 3) * GU_BYTES, mp, lane); if (VAR != 2) scan_stepE(f0, S, L, og0 + (size_t)n * 64 * 512, mp, lane, fr, fq, prog, (unsigned)(n + 1)); else asm volatile("" :: "v"(f0.qk[0]), "v"(f0.kd[1][1]));
            if (VAR != 1 && n + 4 < 128) scan_loadE(f0, gu0 + (size_t)(n + 4) * GU_BYTES, mp, lane); if (VAR != 2) scan_stepE(VAR == 1 ? f0 : f1, S, L, og0 + (size_t)(n + 1) * 64 * 512, mp, lane, fr, fq, prog, (unsigned)(n + 2)); else asm volatile("" :: "v"(f1.qk[0]), "v"(f1.kd[1][1]));
            if (VAR != 1 && n + 5 < 128) scan_loadE(f1, gu0 + (size_t)(n + 5) * GU_BYTES, mp, lane); if (VAR != 2) scan_stepE(VAR == 1 ? f0 : f2, S, L, og0 + (size_t)(n + 2) * 64 * 512, mp, lane, fr, fq, prog, (unsigned)(n + 3)); else asm volatile("" :: "v"(f2.qk[0]), "v"(f2.kd[1][1]));
            if (VAR != 1 && n + 6 < 128) scan_loadE(f2, gu0 + (size_t)(n + 6) * GU_BYTES, mp, lane); if (VAR != 2) scan_stepE(VAR == 1 ? f0 : f3, S, L, og0 + (size_t)(n + 3) * 64 * 512, mp, lane, fr, fq, prog, (unsigned)(n + 4)); else asm volatile("" :: "v"(f3.qk[0]), "v"(f3.kd[1][1]));
        }
        float* so = F.out + OFF_SSP + ((size_t)bh * 128) * 128 + 32 * cq + fr;
#pragma unroll
        for (int t = 0; t < 2; ++t)
#pragma unroll
            for (int nt = 0; nt < 2; ++nt)
#pragma unroll
                for (int i = 0; i < 4; ++i) so[(size_t)(16 * (2 * mp + t) + 4 * fq + i) * 128 + 16 * nt] = S[t][nt][i];
    }
}

constexpr int AT_KP = 144, AT_VP = 192;
constexpr int AT_K0 = 0, AT_V0 = 2 * 64 * AT_KP, AT_CS = AT_V0 + 2 * 64 * AT_VP, AT_WS = AT_CS + 2 * 256, AT_RED = AT_WS + 8 * 256, AT_TOT = AT_RED + 32, AT_CQ = AT_RED + 64;
constexpr float AT_T2 = 48.f, AT_THR = 8.f;
__device__ __forceinline__ float rowmax32(const f32x16& p0, const f32x16& p1) {
    float a = fmaxf(fmaxf(p0[0], p0[1]), p1[0]), b2 = fmaxf(fmaxf(p0[2], p0[3]), p1[1]); a = fmaxf(fmaxf(a, p1[2]), p1[3]);
#pragma unroll
    for (int r = 4; r < 16; r += 4) { a = fmaxf(fmaxf(a, p0[r]), p0[r + 1]); b2 = fmaxf(fmaxf(b2, p0[r + 2]), p0[r + 3]); a = fmaxf(fmaxf(a, p1[r]), p1[r + 1]); b2 = fmaxf(fmaxf(b2, p1[r + 2]), p1[r + 3]); }
    const float m = fmaxf(a, b2);
    return fmaxf(m, __shfl_xor(m, 32));
}
__device__ __forceinline__ bf16x8 pack_frag(const f32x16& x, int s) {
    v4u p; p.x = pk2(x[8 * s], x[8 * s + 1]); p.y = pk2(x[8 * s + 2], x[8 * s + 3]); p.z = pk2(x[8 * s + 4], x[8 * s + 5]); p.w = pk2(x[8 * s + 6], x[8 * s + 7]);
    return __builtin_bit_cast(bf16x8, p);
}
__device__ __forceinline__ void attn_unit(Frame& F, int unit, float qkb) {
    const int b = unit >> 8, h = (unit >> 5) & 7, qb = unit & 31;
    int tid_o = threadIdx.x; asm volatile("" : "+v"(tid_o));
    const int tid = tid_o, lane = tid & 63, wave = __builtin_amdgcn_readfirstlane(tid >> 6), r = lane & 31, hh = lane >> 5;
    LAS unsigned char* L = F.lds + RING_OFF;
    const bf16* QB = (const bf16*)(F.ws + WS_QB); const bf16* KB = (const bf16*)(F.ws + WS_KB); const bf16* VB = (const bf16*)(F.ws + WS_VB);
    const float* CUM = (const float*)(F.ws + WS_CUM);
    bf16* OAB = (bf16*)(F.ws + WS_OAB);
    const size_t rowb = (size_t)b * SEQ; const int q0 = qb * 256, qrow = q0 + 32 * wave + r;
    LAS float* wsf = (LAS float*)(L + AT_WS) + wave * 64; LAS float* red = (LAS float*)(L + AT_RED);
    bf16x8 qr[4];
#pragma unroll
    for (int s = 0; s < 4; ++s) qr[s] = *(const bf16x8*)(QB + (rowb + qrow) * FW + h * 64 + 16 * s + 8 * hh);
    const float cq = CUM[(rowb + qrow) * 8 + h];
    float aq = cq;
    float l_run = 0.f; f32x16 o0 = {}, o1 = {};
    const int tdiag = (q0 + 255) >> 6;
    const int srow = tid >> 3, sch = tid & 7;
    __syncthreads();
    v4u kreg = *(const v4u*)(KB + (rowb + 64 * tdiag + srow) * FW + h * 64 + sch * 8), vreg = *(const v4u*)(VB + (rowb + 64 * tdiag + srow) * FW + h * 64 + sch * 8);
    float creg = (tid < 64) ? CUM[(rowb + 64 * tdiag + tid) * 8 + h] : 0.f;
    *(LAS v4u*)(L + AT_K0 + srow * AT_KP + sch * 16) = kreg; *(LAS v4u*)(L + AT_V0 + srow * AT_VP + sch * 16) = vreg; if (tid < 64) *(LAS float*)(L + AT_CS + tid * 4) = creg;
    __syncthreads();
    const unsigned lbase = (unsigned)(uintptr_t)L;
    const int tq = (lane & 15) >> 2, tp = lane & 3, tblk = (lane >> 4) & 1;
    float G = 0.f; bool first = true; int buf = 0;
    for (int t = tdiag; t >= 0; --t) {
        if (t == tdiag - 4) {
            float a = aq;
#pragma unroll
            for (int o = 1; o < 64; o <<= 1) a = fmaxf(a, __shfl_xor(a, o));
            if (lane == 0) red[wave] = a;
            __syncthreads();
            G = fmaxf(fmaxf(fmaxf(red[0], red[1]), fmaxf(red[2], red[3])), fmaxf(fmaxf(red[4], red[5]), fmaxf(red[6], red[7])));
        }
        if (t <= tdiag - 4) { const float cl = *(const LAS float*)(L + AT_CS + buf * 256 + 63 * 4); if (qkb + G - cl < -AT_T2) break; }
        const bool more = (t > 0);
        if (more) { kreg = *(const v4u*)(KB + (rowb + 64 * (t - 1) + srow) * FW + h * 64 + sch * 8); vreg = *(const v4u*)(VB + (rowb + 64 * (t - 1) + srow) * FW + h * 64 + sch * 8);
            creg = (tid < 64) ? CUM[(rowb + 64 * (t - 1) + tid) * 8 + h] : 0.f; }
        const LAS unsigned char* Kt = L + AT_K0 + buf * (64 * AT_KP); const unsigned Vt = lbase + AT_V0 + buf * (64 * AT_VP); const LAS float* cs = (const LAS float*)(L + AT_CS + buf * 256);
        if (64 * t <= q0 + 32 * wave + 31) {
            f32x16 p0, p1;
#pragma unroll
            for (int g = 0; g < 4; ++g) { const f32x4 c0 = *(const LAS f32x4*)(cs + 8 * g + 4 * hh), c1 = *(const LAS f32x4*)(cs + 32 + 8 * g + 4 * hh);
#pragma unroll
                for (int i = 0; i < 4; ++i) { p0[4 * g + i] = aq - c0[i]; p1[4 * g + i] = aq - c1[i]; } }
#pragma unroll
            for (int s = 0; s < 4; ++s) { const bf16x8 k0 = *(const LAS bf16x8*)(Kt + r * AT_KP + (16 * s + 8 * hh) * 2), k1 = *(const LAS bf16x8*)(Kt + (32 + r) * AT_KP + (16 * s + 8 * hh) * 2);
                p0 = mfma32(k0, qr[s], p0); p1 = mfma32(k1, qr[s], p1); }
            if (64 * t + 63 > q0 + 32 * wave) {
#pragma unroll
                for (int reg = 0; reg < 16; ++reg) { const int kv = 64 * t + crow(reg, hh); if (kv > qrow) p0[reg] = -INFINITY; if (kv + 32 > qrow) p1[reg] = -INFINITY; }
            }
            const float rm = rowmax32(p0, p1);
            if (first) {
                aq -= rm;
#pragma unroll
                for (int reg = 0; reg < 16; ++reg) { p0[reg] -= rm; p1[reg] -= rm; }
                first = false;
            } else if (__any(rm > AT_THR)) {
                const float dl = fmaxf(rm, 0.f); aq -= dl; const float f = __builtin_amdgcn_exp2f(-dl); l_run *= f;
#pragma unroll
                for (int reg = 0; reg < 16; ++reg) { p0[reg] -= dl; p1[reg] -= dl; }
                if (hh == 0) wsf[r] = f;
                LDS_WAIT();
#pragma unroll
                for (int g = 0; g < 4; ++g) { const f32x4 fv = *(const LAS f32x4*)(wsf + 8 * g + 4 * hh);
#pragma unroll
                    for (int i = 0; i < 4; ++i) { o0[4 * g + i] *= fv[i]; o1[4 * g + i] *= fv[i]; } }
            }
            float rs = 0.f;
#pragma unroll
            for (int reg = 0; reg < 16; ++reg) { p0[reg] = __builtin_amdgcn_exp2f(p0[reg]); p1[reg] = __builtin_amdgcn_exp2f(p1[reg]); rs += p0[reg] + p1[reg]; }
            l_run += rs;
#pragma unroll
            for (int blk = 0; blk < 2; ++blk) {
                const unsigned ad = Vt + (unsigned)((32 * blk + 4 * hh + tq) * AT_VP + (16 * tblk + 4 * tp) * 2);
                s16x4 v[8];
                asm volatile("ds_read_b64_tr_b16 %0, %8 offset:%c9\n\tds_read_b64_tr_b16 %1, %8 offset:%c10\n\tds_read_b64_tr_b16 %2, %8 offset:%c11\n\tds_read_b64_tr_b16 %3, %8 offset:%c12\n\t"
                             "ds_read_b64_tr_b16 %4, %8 offset:%c13\n\tds_read_b64_tr_b16 %5, %8 offset:%c14\n\tds_read_b64_tr_b16 %6, %8 offset:%c15\n\tds_read_b64_tr_b16 %7, %8 offset:%c16\n\ts_waitcnt lgkmcnt(0)"
                             : "=&v"(v[0]), "=&v"(v[1]), "=&v"(v[2]), "=&v"(v[3]), "=&v"(v[4]), "=&v"(v[5]), "=&v"(v[6]), "=&v"(v[7])
                             : "v"(ad), "i"(0), "i"(8 * AT_VP), "i"(64), "i"(8 * AT_VP + 64), "i"(16 * AT_VP), "i"(24 * AT_VP), "i"(16 * AT_VP + 64), "i"(24 * AT_VP + 64) : "memory");
                const bf16x8 pa0 = pack_frag(blk ? p1 : p0, 0), pa1 = pack_frag(blk ? p1 : p0, 1);
                o0 = mfma32(pa0, __builtin_shufflevector(v[0], v[1], 0, 1, 2, 3, 4, 5, 6, 7), o0);
                o1 = mfma32(pa0, __builtin_shufflevector(v[2], v[3], 0, 1, 2, 3, 4, 5, 6, 7), o1);
                o0 = mfma32(pa1, __builtin_shufflevector(v[4], v[5], 0, 1, 2, 3, 4, 5, 6, 7), o0);
                o1 = mfma32(pa1, __builtin_shufflevector(v[6], v[7], 0, 1, 2, 3, 4, 5, 6, 7), o1);
            }
        }
        if (more) { const int nb = buf ^ 1; *(LAS v4u*)(L + AT_K0 + nb * (64 * AT_KP) + srow * AT_KP + sch * 16) = kreg; *(LAS v4u*)(L + AT_V0 + nb * (64 * AT_VP) + srow * AT_VP + sch * 16) = vreg;
            if (tid < 64) *(LAS float*)(L + AT_CS + nb * 256 + tid * 4) = creg; }
        __syncthreads();
        buf ^= 1;
    }
    l_run += __shfl_xor(l_run, 32);
    if (hh == 0) wsf[32 + r] = 1.0f / l_run;
    LDS_WAIT();
#pragma unroll
    for (int g = 0; g < 4; ++g) { const f32x4 iv = *(const LAS f32x4*)(wsf + 32 + 8 * g + 4 * hh);
#pragma unroll
        for (int i = 0; i < 4; ++i) { const int q = q0 + 32 * wave + 8 * g + 4 * hh + i; bf16* op = OAB + (rowb + q) * D + h * 64;
            op[r] = (bf16)f2bf(o0[4 * g + i] * iv[i]); op[32 + r] = (bf16)f2bf(o1[4 * g + i] * iv[i]); } }
}

__device__ __forceinline__ void gdn_sample_unit(Frame& F, int unit) {
    int tid_o = threadIdx.x; asm volatile("" : "+v"(tid_o));
    const int s = unit >> 2, h = unit & 3, tid = tid_o;
    LAS float* L = (LAS float*)(F.lds + RING_OFF);
    LAS float* qkv = L; LAS float* red = L + 1536; LAS float* scal = L + 2048 + 64;
    const bf16* GQ = (const bf16*)(F.ws + WS_GQ); const float* GAB = (const float*)(F.ws + WS_GAB); const float* cw = F.in[15];
    __syncthreads();
    if (tid < 384) {
        const int X = tid >> 7, c = tid & 127, ch = X * 512 + h * 128 + c;
        float xp[7];
#pragma unroll
        for (int i = 0; i < 3; ++i) xp[i] = F.in[7][((size_t)s * 3 + i) * CCH + ch];
#pragma unroll
        for (int j = 0; j < 4; ++j) xp[3 + j] = bf2f(GQ[(size_t)(MP + s * 4 + j) * CCH + ch]);
        const float w0 = cw[ch], w1 = cw[CCH + ch], w2 = cw[2 * CCH + ch], w3 = cw[3 * CCH + ch];
#pragma unroll
        for (int j = 0; j < 4; ++j) { const float y = w0 * xp[j] + w1 * xp[j + 1] + w2 * xp[j + 2] + w3 * xp[j + 3]; qkv[(X * 4 + j) * 128 + c] = y * __builtin_amdgcn_rcpf(1.0f + __expf(-y)); }
    }
    if (tid >= 448 && tid < 452) { const int j = tid - 448; scal[j] = __expf(GAB[(size_t)(MP + s * 4 + j) * 8 + h]); scal[4 + j] = GAB[(size_t)(MP + s * 4 + j) * 8 + 4 + h]; }
    __syncthreads();
    { const int w = F.wave, X = w >> 2, j = w & 3; LAS float* v = qkv + (X * 4 + j) * 128; const float a = v[F.lane], b2 = v[64 + F.lane];
      const float ss = wave_sum(a * a + b2 * b2); float rn = __builtin_amdgcn_rsqf(ss + EPS); if (X == 0) rn *= 0.08838834764831845f;
      v[F.lane] = a * rn; v[64 + F.lane] = b2 * rn; }
    __syncthreads();
    const int dv = tid & 127, rg = tid >> 7;
    float S[32];
    const float* sp = F.in[8] + ((size_t)(s * 4 + h) * 128 + rg * 32) * 128 + dv;
#pragma unroll
    for (int i = 0; i < 32; ++i) S[i] = sp[(size_t)i * 128];
    float ov[4];
#pragma unroll
    for (int j = 0; j < 4; ++j) {
        const float a = scal[j], be = scal[4 + j]; const LAS float* qj = qkv + (0 * 4 + j) * 128 + rg * 32; const LAS float* kj = qkv + (1 * 4 + j) * 128 + rg * 32;
        float ks = 0.f;
#pragma unroll
        for (int i = 0; i < 32; ++i) { S[i] *= a; ks += kj[i] * S[i]; }
        red[rg * 128 + dv] = ks; __syncthreads();
        const float kS = red[dv] + red[128 + dv] + red[256 + dv] + red[384 + dv];
        const float vn = be * (qkv[(2 * 4 + j) * 128 + dv] - kS);
        float os = 0.f;
#pragma unroll
        for (int i = 0; i < 32; ++i) { S[i] += kj[i] * vn; os += qj[i] * S[i]; }
        __syncthreads();
        red[rg * 128 + dv] = os; __syncthreads();
        ov[j] = red[dv] + red[128 + dv] + red[256 + dv] + red[384 + dv];
        __syncthreads();
    }
    float* so = F.out + OFF_SSS + ((size_t)(s * 4 + h) * 128 + rg * 32) * 128 + dv;
#pragma unroll
    for (int i = 0; i < 32; ++i) so[(size_t)i * 128] = S[i];
    {
        float ssj[4];
#pragma unroll
        for (int j = 0; j < 4; ++j) { const float v = wave_sum(ov[j] * ov[j]); if (F.lane == 0) red[j * 8 + F.wave] = v; }
        __syncthreads();
#pragma unroll
        for (int j = 0; j < 4; ++j) ssj[j] = red[j * 8] + red[j * 8 + 1];
        if (rg == 0) {
            const bf16* GZ = (const bf16*)(F.ws + WS_GZ); bf16* OAB = (bf16*)(F.ws + WS_OAB); const float gn = F.in[18][dv];
#pragma unroll
            for (int j = 0; j < 4; ++j) { const size_t row = MP + s * 4 + j; const float y = ov[j] * __builtin_amdgcn_rsqf(ssj[j] * (1.0f / 128.0f) + EPS) * gn * bf2f(GZ[row * 512 + h * 128 + dv]);
                OAB[row * D + 512 + h * 128 + dv] = (bf16)f2bf(y); }
        }
    }
    __syncthreads();
}
__device__ __forceinline__ void fox_cumsum_seg(Frame& F, int w) {
    int tid_o = threadIdx.x; asm volatile("" : "+v"(tid_o));
    const int b = w >> 7, seg = w & 127, i = tid_o >> 3, h = tid_o & 7;
    LAS float* part = (LAS float*)(F.lds + RING_OFF);
    const float* src = (const float*)(F.ws + WS_LGF) + (size_t)b * SEQ * 8;
    __syncthreads();
    float a = 0.f;
    { float a0 = 0.f, a1 = 0.f, a2 = 0.f, a3 = 0.f; int sgi = 0;
      for (; sgi + 8 <= seg; sgi += 8) { float v[8];
#pragma unroll
          for (int q = 0; q < 8; ++q) v[q] = src[(size_t)(64 * (sgi + q) + i) * 8 + h];
          a0 += v[0] + v[4]; a1 += v[1] + v[5]; a2 += v[2] + v[6]; a3 += v[3] + v[7]; }
      for (; sgi < seg; ++sgi) a0 += src[(size_t)(64 * sgi + i) * 8 + h];
      a = (a0 + a1) + (a2 + a3); }
    const float mine = src[(size_t)(64 * seg + i) * 8 + h];
    part[i * 8 + h] = a; part[512 + i * 8 + h] = mine;
    __syncthreads();
    float run = 0.f;
#pragma unroll 8
    for (int q = 0; q < 64; ++q) run += part[q * 8 + h];
    for (int q = 0; q <= i; ++q) run += part[512 + q * 8 + h];
    ((float*)(F.ws + WS_CUM))[((size_t)b * SEQ + 64 * seg + i) * 8 + h] = run * LOG2E;
    __syncthreads();
}
__device__ __forceinline__ void conv_out_job(Frame& F) {
    const bf16* GQ = (const bf16*)(F.ws + WS_GQ);
    for (int e = F.vcu * (NWAVES * 64) + F.tid; e < (NB * 3 + DB * 3) * CCH; e += F.G * NWAVES * 64) {
        const int rr = e / CCH, c = e % CCH;
        if (rr < NB * 3) { const int b = rr / 3, i = rr % 3; F.out[OFF_CVP + (size_t)rr * CCH + c] = bf2f(GQ[((size_t)b * SEQ + SEQ - 3 + i) * CCH + c]); }
        else { const int r2 = rr - NB * 3, s = r2 / 3, i = r2 % 3; F.out[OFF_CVS + (size_t)r2 * CCH + c] = bf2f(GQ[(size_t)(MP + s * 4 + 1 + i) * CCH + c]); }
    }
}
__device__ __forceinline__ void gdn_outnorm_rows(Frame& F) {
    const float* OG = (const float*)(F.ws + WS_OG); const bf16* GZ = (const bf16*)(F.ws + WS_GZ); bf16* OAB = (bf16*)(F.ws + WS_OAB);
    const int gw = F.vcu * NWAVES + F.wave, NGW = F.G * NWAVES, lane = F.lane;
    const f32x4 g0 = *(const f32x4*)(F.in[18] + (lane & 15) * 8), g1 = *(const f32x4*)(F.in[18] + (lane & 15) * 8 + 4);
    for (int m0 = gw; m0 < MP; m0 += 4 * NGW) {
        f32x4 a[4], c[4]; v4u z[4];
#pragma unroll
        for (int k = 0; k < 4; ++k) { const size_t m = (size_t)m0 + (size_t)k * NGW; a[k] = *(const f32x4*)(OG + m * 512 + lane * 8); c[k] = *(const f32x4*)(OG + m * 512 + lane * 8 + 4); z[k] = *(const v4u*)(GZ + m * 512 + lane * 8); }
#pragma unroll
        for (int k = 0; k < 4; ++k) { const size_t m = (size_t)m0 + (size_t)k * NGW;
            float ss = (a[k][0] * a[k][0] + a[k][1] * a[k][1]) + (a[k][2] * a[k][2] + a[k][3] * a[k][3]) + (c[k][0] * c[k][0] + c[k][1] * c[k][1]) + (c[k][2] * c[k][2] + c[k][3] * c[k][3]);
            ss = red16(ss);
            const float rs = __builtin_amdgcn_rsqf(ss * (1.0f / 128.0f) + EPS);
            v4u o; o.x = pk2(a[k][0] * rs * g0[0] * bflo(z[k].x), a[k][1] * rs * g0[1] * bfhi(z[k].x)); o.y = pk2(a[k][2] * rs * g0[2] * bflo(z[k].y), a[k][3] * rs * g0[3] * bfhi(z[k].y));
            o.z = pk2(c[k][0] * rs * g1[0] * bflo(z[k].z), c[k][1] * rs * g1[1] * bfhi(z[k].z)); o.w = pk2(c[k][2] * rs * g1[2] * bflo(z[k].w), c[k][3] * rs * g1[3] * bfhi(z[k].w));
            *(v4u*)(OAB + m * D + 512 + lane * 8) = o; }
    }
}
template <bool AF32, bool SUMSQ>
__device__ __forceinline__ void skinny_tile(const void* A, int lda, const bf16* Bt, int ldb, int n0, int k0, int k1, int wave, int lane, f32x4s& acc, float& ssq) {
    const int fr = lane & 15, fq = lane >> 4;
    acc = (f32x4s){0.f, 0.f, 0.f, 0.f}; float s = 0.f;
    const bf16* bp = Bt + (size_t)(n0 + fr) * ldb + 8 * fq;
    const float* apf = (const float*)A + (size_t)(16 * wave + fr) * lda + 8 * fq;
    const bf16* aph = (const bf16*)A + (size_t)(16 * wave + fr) * lda + 8 * fq;
#pragma unroll 8
    for (int k = k0; k < k1; k += 32) {
        const bf16x8 b = *(const bf16x8*)(bp + k);
        bf16x8 a;
        if constexpr (AF32) { const f32x4 x0 = *(const f32x4*)(apf + k), x1 = *(const f32x4*)(apf + k + 4);
            if constexpr (SUMSQ) s += (x0[0] * x0[0] + x0[1] * x0[1]) + (x0[2] * x0[2] + x0[3] * x0[3]) + (x1[0] * x1[0] + x1[1] * x1[1]) + (x1[2] * x1[2] + x1[3] * x1[3]);
            v4u p; p.x = pk2(x0[0], x0[1]); p.y = pk2(x0[2], x0[3]); p.z = pk2(x1[0], x1[1]); p.w = pk2(x1[2], x1[3]); a = __builtin_bit_cast(bf16x8, p);
        } else { const v4u p = *(const v4u*)(aph + k); a = __builtin_bit_cast(bf16x8, p);
            if constexpr (SUMSQ) { float t0 = bflo(p.x), t1 = bfhi(p.x), t2 = bflo(p.y), t3 = bfhi(p.y), t4 = bflo(p.z), t5 = bfhi(p.z), t6 = bflo(p.w), t7 = bfhi(p.w);
                s += (t0 * t0 + t1 * t1) + (t2 * t2 + t3 * t3) + (t4 * t4 + t5 * t5) + (t6 * t6 + t7 * t7); } }
        acc = mfma16(a, b, acc);
    }
    if constexpr (SUMSQ) { s += __shfl_xor(s, 16); s += __shfl_xor(s, 32); }
    ssq = s;
}
template <bool AF32, bool SUMSQ>
__device__ __forceinline__ void skinny_half(const void* A, int lda, const bf16* Bt, int ldb, int n0, int k0, int k1, int mh, int wave, int lane, LAS unsigned char* scr, f32x4s& acc, float& ssq) {
    const int mt = wave & 3, kh = wave >> 2, kl = (k1 - k0) >> 1;
    const void* Ah = AF32 ? (const void*)((const float*)A + (size_t)(64 * mh) * lda) : (const void*)((const bf16*)A + (size_t)(64 * mh) * lda);
    skinny_tile<AF32, SUMSQ>(Ah, lda, Bt, ldb, n0, k0 + kh * kl, k0 + kh * kl + kl, mt, lane, acc, ssq);
    __syncthreads();
    if (kh == 1) { *(LAS f32x4s*)(scr + (mt * 64 + lane) * 16) = acc; if (SUMSQ) *(LAS float*)(scr + 4096 + (mt * 64 + lane) * 4) = ssq; }
    __syncthreads();
    if (kh == 0) { acc += *(const LAS f32x4s*)(scr + (mt * 64 + lane) * 16); if (SUMSQ) ssq += *(const LAS float*)(scr + 4096 + (mt * 64 + lane) * 4); }
}
__device__ __forceinline__ void sample_p5(Frame& F, int u) {
    int tid_o = threadIdx.x; asm volatile("" : "+v"(tid_o));
    const int lane = tid_o & 63, wave = __builtin_amdgcn_readfirstlane(tid_o >> 6), fr = lane & 15, fq = lane >> 4;
    LAS unsigned char* scr = F.lds + RING_OFF;
    const bf16* OAB = (const bf16*)(F.ws + WS_OAB) + (size_t)MP * D; const bf16* GT = (const bf16*)(F.ws + WS_GT) + (size_t)MP * 2048;
    if (u < 128) {
        const int cu = u >> 1, mh = u & 1; f32x4s aa, ab; float d;
        skinny_half<false, false>(OAB, D, (const bf16*)(F.ws + WS_WAB), D, 16 * cu, 0, 512, mh, wave, lane, scr, aa, d);
        __syncthreads();
        skinny_half<false, false>(OAB, D, (const bf16*)(F.ws + WS_WAB), D, 16 * cu, 512, 1024, mh, wave, lane, scr, ab, d);
        if (wave < 4) { bf16* MRG = (bf16*)(F.ws + WS_MRG) + (size_t)MP * D;
#pragma unroll
            for (int i = 0; i < 4; ++i) { const int row = 64 * mh + 16 * wave + 4 * fq + i, col = 16 * cu + fr;
                const float ga = bf2f(GT[(size_t)row * 2048 + col]), gb = bf2f(GT[(size_t)row * 2048 + 1024 + col]);
                MRG[(size_t)row * D + col] = (bf16)f2bf(ga * aa[i] + gb * ab[i]); } }
    } else if (u < 256) {
        const int cu = (u - 128) >> 1, mh = u & 1; f32x4s a; float d;
        skinny_half<false, false>((const bf16*)(F.ws + WS_PLB) + (size_t)MP * PLE, PLE, (const bf16*)(F.ws + WS_WPL), PLE, 16 * cu, 0, PLE, mh, wave, lane, scr, a, d);
        if (wave < 4) { bf16* PL = (bf16*)(F.ws + WS_PL) + (size_t)MP * D;
#pragma unroll
            for (int i = 0; i < 4; ++i) PL[(size_t)(64 * mh + 16 * wave + 4 * fq + i) * D + 16 * cu + fr] = (bf16)f2bf(a[i]); }
    }
}
__device__ __forceinline__ void sample_zero_x2(Frame& F, int q) {
    float* X2 = (float*)(F.ws + WS_X2) + (size_t)MP * D + (size_t)q * 32 * D;
    for (int e = F.tid; e < 32 * D / 4; e += NWAVES * 64) ((f32x4*)X2)[e] = (f32x4){0.f, 0.f, 0.f, 0.f};
}
__device__ __forceinline__ void sample_p6(Frame& F, int u) {
    int tid_o = threadIdx.x; asm volatile("" : "+v"(tid_o));
    const int lane = tid_o & 63, wave = __builtin_amdgcn_readfirstlane(tid_o >> 6), fr = lane & 15, fq = lane >> 4;
    if (u >= 128) return;
    const int cu = u >> 1, mh = u & 1; f32x4s a; float d;
    skinny_half<false, false>((const bf16*)(F.ws + WS_MRG) + (size_t)MP * D, D, (const bf16*)(F.ws + WS_WOUT), D, 16 * cu, 0, D, mh, wave, lane, F.lds + RING_OFF, a, d);
    if (wave < 4) { float* X1 = (float*)(F.ws + WS_X1) + (size_t)MP * D; bf16* X1B = (bf16*)(F.ws + WS_X1B) + (size_t)MP * D;
#pragma unroll
        for (int i = 0; i < 4; ++i) { const int row = 64 * mh + 16 * wave + 4 * fq + i, col = 16 * cu + fr; const float v = a[i] + F.in[1][(size_t)row * D + col];
            X1[(size_t)row * D + col] = v; X1B[(size_t)row * D + col] = (bf16)f2bf(v); } }
}
template <bool SUMSQ>
__device__ __forceinline__ void skinny_half2(const bf16* A, int lda, const bf16* Bt, int ldb, int n0, int k0, int k1, int mh, int wave, int lane, LAS unsigned char* scr, f32x4s (&acc)[2], float& ssq) {
    const int mt = wave & 3, kh = wave >> 2, kl = (k1 - k0) >> 1, fr = lane & 15, fq = lane >> 4;
    acc[0] = (f32x4s){0.f, 0.f, 0.f, 0.f}; acc[1] = (f32x4s){0.f, 0.f, 0.f, 0.f}; float s = 0.f;
    const bf16* ap = A + (size_t)(64 * mh + 16 * mt + fr) * lda + 8 * fq; const bf16* bp0 = Bt + (size_t)(n0 + fr) * ldb + 8 * fq; const bf16* bp1 = bp0 + (size_t)16 * ldb;
    const int ka = k0 + kh * kl;
#pragma unroll 8
    for (int ks = 0; ks < 16; ++ks) { const int k = ka + 32 * ks;
        const v4u p = *(const v4u*)(ap + k); const bf16x8 a = __builtin_bit_cast(bf16x8, p); const bf16x8 b0 = *(const bf16x8*)(bp0 + k), b1 = *(const bf16x8*)(bp1 + k);
        if constexpr (SUMSQ) { float t0 = bflo(p.x), t1 = bfhi(p.x), t2 = bflo(p.y), t3 = bfhi(p.y), t4 = bflo(p.z), t5 = bfhi(p.z), t6 = bflo(p.w), t7 = bfhi(p.w);
            s += (t0 * t0 + t1 * t1) + (t2 * t2 + t3 * t3) + (t4 * t4 + t5 * t5) + (t6 * t6 + t7 * t7); }
        acc[0] = mfma16(a, b0, acc[0]); acc[1] = mfma16(a, b1, acc[1]);
    }
    if constexpr (SUMSQ) { s += __shfl_xor(s, 16); s += __shfl_xor(s, 32); }
    __syncthreads();
    if (kh == 1) { *(LAS f32x4s*)(scr + (mt * 64 + lane) * 32) = acc[0]; *(LAS f32x4s*)(scr + (mt * 64 + lane) * 32 + 16) = acc[1]; if (SUMSQ) *(LAS float*)(scr + 8192 + (mt * 64 + lane) * 4) = s; }
    __syncthreads();
    if (kh == 0) { acc[0] += *(const LAS f32x4s*)(scr + (mt * 64 + lane) * 32); acc[1] += *(const LAS f32x4s*)(scr + (mt * 64 + lane) * 32 + 16); if (SUMSQ) s += *(const LAS float*)(scr + 8192 + (mt * 64 + lane) * 4); }
    ssq = s;
}
__device__ __forceinline__ void sample_p7(Frame& F, int u) {
    int tid_o = threadIdx.x; asm volatile("" : "+v"(tid_o));
    const int lane = tid_o & 63, wave = __builtin_amdgcn_readfirstlane(tid_o >> 6), fr = lane & 15, fq = lane >> 4;
    if (u >= 256) return;
    const int cu = u >> 1, mh = u & 1; f32x4s a[2]; float ss;
    skinny_half2<true>((const bf16*)(F.ws + WS_X1B) + (size_t)MP * D, D, (const bf16*)(F.ws + WS_WUP), D, 32 * cu, 0, D, mh, wave, lane, F.lds + RING_OFF, a, ss);
    if (wave < 4) { const float rs = __builtin_amdgcn_rsqf(ss * (1.0f / D) + EPS); bf16* HB = (bf16*)(F.ws + WS_HB) + (size_t)MP * DFF;
#pragma unroll
        for (int i = 0; i < 4; ++i) { const float r = __shfl(rs, 4 * fq + i);
#pragma unroll
            for (int nt = 0; nt < 2; ++nt) { const float v = fmaxf(a[nt][i] * r, 0.f); HB[(size_t)(64 * mh + 16 * wave + 4 * fq + i) * DFF + 32 * cu + 16 * nt + fr] = (bf16)f2bf(v * v); } } }
}
__device__ __forceinline__ void sample_p8(Frame& F, int u) {
    int tid_o = threadIdx.x; asm volatile("" : "+v"(tid_o));
    const int lane = tid_o & 63, wave = __builtin_amdgcn_readfirstlane(tid_o >> 6), fr = lane & 15, fq = lane >> 4;
    if (u >= 256) return;
    const int cu = u & 31, mh = (u >> 5) & 1, kq = u >> 6; f32x4s a[2]; float d;
    skinny_half2<false>((const bf16*)(F.ws + WS_HB) + (size_t)MP * DFF, DFF, (const bf16*)(F.ws + WS_WDN), DFF, 32 * cu, 1024 * kq, 1024 * kq + 1024, mh, wave, lane, F.lds + RING_OFF, a, d);
    if (wave < 4) { float* X2 = (float*)(F.ws + WS_X2) + (size_t)MP * D; const float* X1 = (const float*)(F.ws + WS_X1) + (size_t)MP * D;
#pragma unroll
        for (int i = 0; i < 4; ++i)
#pragma unroll
            for (int nt = 0; nt < 2; ++nt) { const int row = 64 * mh + 16 * wave + 4 * fq + i, col = 32 * cu + 16 * nt + fr; float v = a[nt][i]; if (kq == 0) v += X1[(size_t)row * D + col]; atomicAdd(X2 + (size_t)row * D + col, v); } }
}
__device__ __forceinline__ void sample_p9(Frame& F, int u) {
    int tid_o = threadIdx.x; asm volatile("" : "+v"(tid_o));
    const int lane = tid_o & 63, wave = __builtin_amdgcn_readfirstlane(tid_o >> 6), fr = lane & 15, fq = lane >> 4;
    if (u >= 128) return;
    const int cu = u >> 1, mh = u & 1;
    const float* X2 = (const float*)(F.ws + WS_X2) + (size_t)MP * D; const bf16* PL = (const bf16*)(F.ws + WS_PL) + (size_t)MP * D;
    f32x4s a; float ss;
    skinny_half<true, true>(X2, D, (const bf16*)(F.ws + WS_WGT), D, 16 * cu, 0, D, mh, wave, lane, F.lds + RING_OFF, a, ss);
    if (wave < 4) { const float rs = __builtin_amdgcn_rsqf(ss * (1.0f / D) + EPS);
#pragma unroll
        for (int i = 0; i < 4; ++i) { const int row = 64 * mh + 16 * wave + 4 * fq + i, col = 16 * cu + fr; const float r = __shfl(rs, 4 * fq + i);
            F.out[OFF_YS + (size_t)row * D + col] = X2[(size_t)row * D + col] + bf2f(PL[(size_t)row * D + col]) * __builtin_amdgcn_rcpf(1.0f + __expf(-a[i] * r)); } }
}
#ifndef MK_N_LAUNCHES
#define MK_N_LAUNCHES 1
#endif
constexpr int N_PHASES = 10;
__device__ __forceinline__ int q_fetch(Frame& F, int qi) {
    __syncthreads();
    if (F.tid == 0) F.MISC[16] = __hip_atomic_fetch_add((unsigned*)(F.ctl + CW_Q + 64 * qi), 1u, __ATOMIC_RELAXED, __HIP_MEMORY_SCOPE_AGENT);
    __syncthreads();
    return (int)F.MISC[16];
}
__device__ __forceinline__ void p2_publish(Frame& F) {
    asm volatile("s_waitcnt vmcnt(0)" ::: "memory"); __syncthreads();
    if (F.tid == 0) { __builtin_amdgcn_fence(__ATOMIC_RELEASE, "agent"); asm volatile("s_waitcnt vmcnt(0)" ::: "memory");
        (void)__hip_atomic_fetch_add((unsigned*)(F.ctl + CW_PROG + 64 * 16), 1u, __ATOMIC_RELAXED, __HIP_MEMORY_SCOPE_AGENT); }
}
__device__ __forceinline__ void p2_wait(Frame& F, unsigned* tmo) {
    if (F.tid == 0) { unsigned sp = 0;
        while (__hip_atomic_load((unsigned*)(F.ctl + CW_PROG + 64 * 16), __ATOMIC_RELAXED, __HIP_MEMORY_SCOPE_AGENT) < (unsigned)F.G) { __builtin_amdgcn_s_sleep(2);
            if ((++sp & 255u) == 0u) { if (__hip_atomic_load(tmo, __ATOMIC_RELAXED, __HIP_MEMORY_SCOPE_AGENT)) break; if (sp > (1u << 20)) { atomicAdd(tmo, 1u); break; } } }
        __builtin_amdgcn_fence(__ATOMIC_ACQUIRE, "agent"); asm volatile("s_waitcnt vmcnt(0)" ::: "memory"); }
    __syncthreads();
}
__global__ void __launch_bounds__(NWAVES * 64, 2) mk_fwd(Args args) {
    extern __shared__ __attribute__((aligned(16))) unsigned char lds[];
    Frame F;
    F.lds = (LAS unsigned char*)lds;
    F.MISC = (volatile LAS unsigned*)(F.lds + MISC_OFF);
    F.tid = threadIdx.x; F.lane = F.tid & 63; F.wave = __builtin_amdgcn_readfirstlane(F.tid >> 6);
    F.G = gridDim.x; { const int bx = blockIdx.x; F.vcu = (F.G % 8 == 0) ? (bx % 8) * (F.G / 8) + bx / 8 : bx; }
    F.ws = args.ws; F.out = args.out; F.ctl = (gu32*)(args.ws + WS_CTL);
#pragma unroll
    for (int i = 0; i < 28; ++i) F.in[i] = (const float*)args.in[i];
    F.page_table = (const int*)args.in[9];
    for (int u = F.tid; u < (LDS_BYTES - LDSCTL_OFF) / 4; u += NWAVES * 64) ((LAS unsigned*)(F.lds + LDSCTL_OFF))[u] = 0u;
    __syncthreads();
    XcdBarrier bar; bar.bar = (unsigned*)(F.ctl + CW_BAR); bar.x = 0; bar.st = nullptr;
    if (MK_N_LAUNCHES == 1) bar = xcd_barrier_post((unsigned*)(F.ctl + CW_BAR), F.MISC + 8);
#define GRID_BAR() do { if (MK_N_LAUNCHES == 1) xcd_barrier(bar); } while (0)
    const int lo = args.ph_lo, hi = args.ph_hi;
#ifndef PH_MASK
#define PH_MASK 0x3ff
#endif
#define IN(k) (((PH_MASK >> (k)) & 1) && lo <= (k) && (k) < hi)
#define BOTH(k) (IN(k) && IN((k) + 1))
    unsigned char* ws = args.ws;
    bf16* XN = (bf16*)(ws + WS_XN); bf16* QB = (bf16*)(ws + WS_QB); bf16* KB = (bf16*)(ws + WS_KB); bf16* VB = (bf16*)(ws + WS_VB);
    bf16* GQ = (bf16*)(ws + WS_GQ); bf16* GZ = (bf16*)(ws + WS_GZ); bf16* GT = (bf16*)(ws + WS_GT);
    float* GAB = (float*)(ws + WS_GAB); float* LGF = (float*)(ws + WS_LGF);
    bf16* OAB = (bf16*)(ws + WS_OAB); bf16* MRG = (bf16*)(ws + WS_MRG); float* X1 = (float*)(ws + WS_X1); bf16* X1B = (bf16*)(ws + WS_X1B);
    bf16* HB = (bf16*)(ws + WS_HB); float* X2 = (float*)(ws + WS_X2); bf16* X2B = (bf16*)(ws + WS_X2B); bf16* PL = (bf16*)(ws + WS_PL);
    float* SS1 = (float*)(F.ctl + CW_SS1); float* SS2 = (float*)(F.ctl + CW_SS2);

    if (IN(0)) { p0_prologue(F); if (BOTH(0)) GRID_BAR(); }
    if (IN(1)) {
        pg8::Gemm g{XN, (const bf16*)(ws + WS_WIN), MPAD, NIN, D}; pg8::QueueOrder S; S.init(MPAD, NIN, (unsigned*)(F.ctl + CW_Q + 64 * 6), F.MISC + 12);
        { LAS float* par = (LAS float*)(F.lds + MISC_OFF + 256);
          if (F.tid < 64) { par[F.tid] = F.in[13][F.tid]; par[64 + F.tid] = F.in[14][F.tid]; }
          if (F.tid < 8) par[128 + F.tid] = F.in[12][F.tid];
          if (F.tid < 4) { par[136 + F.tid] = -__expf(F.in[16][F.tid]); par[140 + F.tid] = F.in[17][F.tid]; }
          __syncthreads(); }
        pg8::EpiIn E{QB, KB, VB, GQ, GZ, GT, GAB, LGF, F.out, (const LAS float*)(F.lds + MISC_OFF + 256)};
        pg8::gemm_phase<pg8::EpiIn, pg8::QueueOrder, true, true>(F.lds + RING_OFF, g, S, E);
        if (BOTH(1)) GRID_BAR();
    }
    if (IN(2)) {
        { PrepIn pin; if (F.vcu < 1024) prep_load(F, pin, F.vcu, F.tid);
          for (int u = F.vcu; u < 1024; u += F.G) gdn_prep_unit<0>(F, u, pin, (u + F.G < 1024) ? u + F.G : -1); }
        if (F.vcu < NB * 128) fox_cumsum_seg(F, F.vcu);
        conv_out_job(F);
        if (BOTH(2)) p2_publish(F);
    }
    if (IN(3)) {
        { const int su = (F.G == 256) ? (((F.vcu & 31) < 4) ? (F.vcu >> 5) * 4 + (F.vcu & 31) : -1) : (F.vcu < 32 ? F.vcu : -1);
          if (su >= 0) { if (lo <= 2) p2_wait(F, (unsigned*)(F.ctl + CW_BAR) + XB_TMO); gdn_scan_unit<0>(F, su); } }
        for (;;) { const int u = q_fetch(F, 0); if (u >= DB * GH) break; gdn_sample_unit(F, u); }
        for (;;) { const int u2 = q_fetch(F, 1); if (u2 >= DB * NPAGES / 2) break; decode_unit(F, 2 * u2, F.wave); decode_unit(F, 2 * u2 + 1, F.wave); }
        float qkb;
        { const float a = fabsf(F.in[13][F.lane]), c = fabsf(F.in[14][F.lane]); float ma = a, mc = c;
#pragma unroll
          for (int o = 1; o < 64; o <<= 1) { ma = fmaxf(ma, __shfl_xor(ma, o)); mc = fmaxf(mc, __shfl_xor(mc, o)); }
          qkb = 64.0f * ma * mc * C2 * 1.02f; }
        if (lo <= 2) p2_wait(F, (unsigned*)(F.ctl + CW_BAR) + XB_TMO);
        for (;;) { const int u = q_fetch(F, 2); if (u >= NB * FH * 32) break; attn_unit(F, ((u & 15) << 5) | (31 - (u >> 4)), qkb); }
        if (BOTH(3)) GRID_BAR();
    }
    if (IN(4)) {
        for (int r = F.vcu * NWAVES + F.wave; r < DB * FH * DS; r += F.G * NWAVES) decode_combine_row(F, r);
        gdn_outnorm_rows(F);
        if (F.vcu >= F.G - 4) sample_zero_x2(F, F.vcu - (F.G - 4));
        if (BOTH(4)) GRID_BAR();
    }
    if (IN(5)) {
        { pg8::Gemm g{OAB, (const bf16*)(ws + WS_WAB), MP, D, D}; pg8::StaticOrder S; S.init(MP, D, F.G, (int)blockIdx.x);
          pg8::EpiMerge E{MRG, GT};
          pg8::gemm_phase<pg8::EpiMerge, pg8::StaticOrder, true, true>(F.lds + RING_OFF, g, S, E); }
        __syncthreads();
        { pg8::Gemm g{(const bf16*)(ws + WS_PLB), (const bf16*)(ws + WS_WPL), MP, D, PLE}; pg8::StaticOrder S; S.init(MP, D, F.G, (int)blockIdx.x);
          pg8::EpiBf<0> E{PL, D, nullptr};
          pg8::gemm_phase<pg8::EpiBf<0>, pg8::StaticOrder, true, true>(F.lds + RING_OFF, g, S, E); }
        sample_p5(F, (F.G == 256) ? (F.vcu & 31) * 8 + (F.vcu >> 5) : F.vcu);
        if (BOTH(5)) GRID_BAR();
    }
    if (IN(6)) {
        pg8::Gemm g{MRG, (const bf16*)(ws + WS_WOUT), MP, D, D}; pg8::StaticOrder S; S.init(MP, D, F.G, (int)blockIdx.x);
        pg8::EpiRes<false, false> E{F.in[0], X1B, SS1, nullptr};
        pg8::gemm_phase<pg8::EpiRes<false, false>, pg8::StaticOrder, true, true>(F.lds + RING_OFF, g, S, E);
        sample_p6(F, (F.G == 256) ? (((F.vcu & 31) < 16) ? (F.vcu & 31) * 8 + (F.vcu >> 5) : 1000) : F.vcu);
        if (BOTH(6)) GRID_BAR();
    }
    if (IN(7)) {
        pg8::Gemm g{X1B, (const bf16*)(ws + WS_WUP), MP, DFF, D}; pg8::StaticOrder S; S.init(MP, DFF, F.G, (int)blockIdx.x);
        pg8::EpiBf<2> E{HB, DFF, nullptr};
        pg8::gemm_phase<pg8::EpiBf<2>, pg8::StaticOrder, true, true>(F.lds + RING_OFF, g, S, E);
        sample_p7(F, F.vcu);
        if (BOTH(7)) GRID_BAR();
    }
    if (IN(8)) {
        { pg8::Gemm g{HB, (const bf16*)(ws + WS_WDN), MP, D, DFF}; pg8::StaticOrder S; S.init(MP, D, F.G, (int)blockIdx.x);
          pg8::EpiRes<true, true> E{X1B, X2B, SS2, SS1};
          pg8::gemm_phase<pg8::EpiRes<true, true>, pg8::StaticOrder, true, true>(F.lds + RING_OFF, g, S, E); }
        sample_p8(F, F.vcu);
        if (BOTH(8)) GRID_BAR();
    }
    if (IN(9)) {
        pg8::Gemm g{X2B, (const bf16*)(ws + WS_WGT), MP, D, D}; pg8::StaticOrder S; S.init(MP, D, F.G, (int)blockIdx.x);
        pg8::EpiFinal E{X2B, PL, SS2, F.out};
        pg8::gemm_phase<pg8::EpiFinal, pg8::StaticOrder, true, true>(F.lds + RING_OFF, g, S, E);
        sample_p9(F, (F.G == 256) ? (((F.vcu & 31) < 16) ? (F.vcu & 31) * 8 + (F.vcu >> 5) : 1000) : F.vcu);
    }
#undef IN
#undef BOTH
}

extern "C" void kernel_launch(void* const* d_in, const int* in_sizes, int n_in, void* d_out, int out_size, void* d_ws, size_t ws_size, hipStream_t stream) {
    static int grid = 0;
    if (grid == 0) {
        if (n_in != 28 || out_size != (int)OUT_TOTAL || ws_size < WS_END) { fprintf(stderr, "kernel_launch: unexpected shapes (n_in %d out %d ws %zu)\n", n_in, out_size, ws_size); grid = -1; return; }
        int dev = 0, cus = 0, per_cu = 0;
        if (hipGetDevice(&dev) != hipSuccess || hipDeviceGetAttribute(&cus, hipDeviceAttributeMultiprocessorCount, dev) != hipSuccess) { grid = -1; return; }
        if (hipFuncSetAttribute((const void*)mk_fwd, hipFuncAttributeMaxDynamicSharedMemorySize, LDS_BYTES) != hipSuccess) { fprintf(stderr, "kernel_launch: hipFuncSetAttribute failed\n"); grid = -1; return; }
        if (hipOccupancyMaxActiveBlocksPerMultiprocessor(&per_cu, (const void*)mk_fwd, NWAVES * 64, LDS_BYTES) != hipSuccess || per_cu < 1)
            fprintf(stderr, "kernel_launch: occupancy query reports %d workgroups per CU\n", per_cu);
        (void)hipGetLastError();
        grid = cus;
        if (cus != 256) fprintf(stderr, "kernel_launch: built for a 256-CU device (unit-to-workgroup maps assume 256 workgroups); this one reports %d\n", cus);
    }
    if (grid < 0) return;
    if (hipMemsetAsync((char*)d_ws + WS_CTL, 0, CTL_ZERO_BYTES, stream) != hipSuccess) return;
    Args a{};
    for (int i = 0; i < 28; ++i) a.in[i] = d_in[i];
    a.out = (float*)d_out; a.ws = (unsigned char*)d_ws;
    if (MK_N_LAUNCHES == 1) { a.ph_lo = 0; a.ph_hi = N_PHASES; a.li = 0; hipLaunchKernelGGL(mk_fwd, dim3(grid), dim3(NWAVES * 64), LDS_BYTES, stream, a); }
    else for (int li = 0; li < N_PHASES; ++li) { a.ph_lo = li; a.ph_hi = li + 1; a.li = li; hipLaunchKernelGGL(mk_fwd, dim3(grid), dim3(NWAVES * 64), LDS_BYTES, stream, a); }
}
```

```cpp
#include <hip/hip_runtime.h>
#include <cstdio>
#include <cstdint>
#include <cmath>

constexpr int D = 1024, SEQ = 8192, NB = 2, MP = NB * SEQ;
constexpr int DB = 32, DS = 4, MS = DB * DS;
constexpr int MT = MP + MS, MPAD = 16640;
constexpr int FH = 8, FD = 64, FW = 512;
constexpr int GH = 4, GK = 128, GV = 128, CCH = 1536, CW = 4;
constexpr int DFF = 4096, PLE = 256, DIN = 5648;
constexpr int PAST = 8192, PAGE = 128, NPAGES = 64;
constexpr int NIN = 5888;
constexpr float EPS = 1e-6f;
constexpr float C2 = 0.125f * 1.4426950408889634f;
constexpr float LOG2E = 1.4426950408889634f;

constexpr size_t OFF_YP = 0, OFF_YS = 16777216, OFF_KP = 16908288, OFF_VP = 25296896, OFF_LFP = 33685504, OFF_CVP = 33816576,
                 OFF_SSP = 33825792, OFF_KS = 33956864, OFF_VS = 34022400, OFF_LFS = 34087936, OFF_CVS = 34088960, OFF_SSS = 34236416, OUT_TOTAL = 36333568;

constexpr size_t MiB = 1u << 20;
constexpr size_t WS_CTL = 0, CTL_ZERO_BYTES = 1 * MiB;
constexpr size_t WS_WIN = 2 * MiB, WS_WAB = 14 * MiB, WS_WOUT = 16 * MiB, WS_WUP = 18 * MiB, WS_WDN = 26 * MiB, WS_WGT = 34 * MiB, WS_WPL = 36 * MiB;
constexpr size_t WS_XN = 40 * MiB, WS_QB = 74 * MiB, WS_KB = 91 * MiB, WS_VB = 108 * MiB, WS_GQ = 126 * MiB, WS_GZ = 176 * MiB, WS_GT = 194 * MiB;
constexpr size_t WS_GAB = 260 * MiB, WS_LGF = 261 * MiB, WS_CUM = 262 * MiB, WS_OAB = 264 * MiB, WS_MRG = 298 * MiB, WS_X1 = 332 * MiB, WS_X1B = 398 * MiB;
constexpr size_t WS_HB = 432 * MiB, WS_X2 = 563 * MiB, WS_X2B = 629 * MiB, WS_PL = 663 * MiB, WS_GDN = 700 * MiB, WS_OG = 790 * MiB, WS_SFX = 824 * MiB, WS_DPART = 834 * MiB;
constexpr size_t WS_PLB = 856 * MiB;
constexpr size_t WS_END = 880 * MiB;
constexpr int CW_TMO = 0, CW_CODE = 1;
constexpr int CW_BAR = 4096;
constexpr int CW_Q = 8192;
constexpr int CW_PROG = 12288;
constexpr int CW_SS1 = 65536, CW_SS2 = 65536 + 16640 + 64;
static_assert((CW_SS2 + 16640) * 4 <= (int)CTL_ZERO_BYTES, "ctl");

constexpr int RING_OFF = 0, RING_BYTES = 131072;
constexpr int LDSCTL_OFF = RING_BYTES, MISC_OFF = LDSCTL_OFF + 320;
constexpr int LDS_BYTES = 147456;
constexpr int NWAVES = 8;

#define GAS __attribute__((address_space(1)))
#define LAS __attribute__((address_space(3)))
typedef unsigned short bf16;
typedef unsigned v4u __attribute__((ext_vector_type(4)));
typedef unsigned v2u __attribute__((ext_vector_type(2)));
typedef float f32x4 __attribute__((ext_vector_type(4)));
typedef float f32x16 __attribute__((ext_vector_type(16)));
typedef float f32x4s __attribute__((ext_vector_type(4)));
typedef short bf16x8 __attribute__((ext_vector_type(8)));
typedef short s16x4 __attribute__((ext_vector_type(4)));
typedef GAS unsigned gu32;
#define RLX_AGENT __ATOMIC_RELAXED, __HIP_MEMORY_SCOPE_AGENT
#define LDS_WAIT() asm volatile("s_waitcnt lgkmcnt(0)" ::: "memory")
#define VM_WAIT() asm volatile("s_waitcnt vmcnt(0)" ::: "memory")
typedef float f32x2_t __attribute__((ext_vector_type(2))); typedef __bf16 bf16x2_t __attribute__((ext_vector_type(2)));
__device__ __forceinline__ unsigned pk2(float lo, float hi) { const f32x2_t v = {lo, hi}; return __builtin_bit_cast(unsigned, __builtin_convertvector(v, bf16x2_t)); }
__device__ __forceinline__ unsigned f2bf(float f) { return pk2(f, 0.f) & 0xffffu; }
__device__ __forceinline__ float bf2f(unsigned short b) { return __builtin_bit_cast(float, (unsigned)b << 16); }
__device__ __forceinline__ float bflo(unsigned w) { return __builtin_bit_cast(float, w << 16); }
__device__ __forceinline__ float bfhi(unsigned w) { return __builtin_bit_cast(float, w & 0xffff0000u); }
__device__ __forceinline__ float sigmoidf_(float x) { return 1.0f / (1.0f + __expf(-x)); }
__device__ __forceinline__ float siluf_(float x) { return x / (1.0f + __expf(-x)); }
__device__ __forceinline__ float log_sigmoidf_(float z) { return fminf(z, 0.f) - __logf(1.0f + __expf(-fabsf(z))); }
__device__ __forceinline__ float softplusf_(float z) { return fmaxf(z, 0.f) + __logf(1.0f + __expf(-fabsf(z))); }
__device__ __forceinline__ float wave_sum(float v) {
#pragma unroll
    for (int o = 1; o < 64; o <<= 1) v += __shfl_xor(v, o);
    return v;
}
namespace pg8 {
#define PG8_LAS __attribute__((address_space(3)))
typedef unsigned short bf16_t;
typedef short bf16x8 __attribute__((ext_vector_type(8)));
typedef float f32x4 __attribute__((ext_vector_type(4)));
typedef unsigned u32x4 __attribute__((ext_vector_type(4)));
constexpr int BM = 256, BK = 64, HALF = 128, HTB = HALF * BK * 2  , STAGE_BYTES = 8 * HTB, NXCD = 8, WGM = 8;

__host__ __device__ __forceinline__ int lds_byte(int r, int c) { const int st = (r >> 4) * 2 + (c >> 5), rr = r & 15, cc = c & 31, ob = rr * 64 + cc * 2; return st * 1024 + (ob ^ (((ob >> 9) & 1) << 5)); }
__host__ __device__ __forceinline__ void stage_rc(int b, int& R, int& C) { const int st = b / 1024, sb = b % 1024, swz = sb ^ (((sb >> 9) & 1) << 5); R = (st >> 1) * 16 + swz / 64; C = (st & 1) * 32 + (swz % 64) / 2; }
__host__ __device__ __forceinline__ int perm32(int rho) { const int n = rho >> 4, i = rho & 15; return 8 * (i >> 2) + 4 * n + (i & 3); }

struct Unit { int pm, pn; };
struct Gemm { const bf16_t* A; const bf16_t* Bt; int M, N, K; };

struct StaticOrder {
    int nM, nN, nwg, G, c;
    __host__ __device__ void init(int M, int N, int G_, int c_) { nM = M / BM; nN = N / BM; nwg = nM * nN; G = G_; c = c_; }
    __host__ __device__ bool next(int i, Unit& u) const {
        const long L = (long)i * G + c; if (L >= nwg) return false;
        int wgid = (int)L; { const int q = nwg / NXCD, r = nwg % NXCD, xcd = wgid % NXCD, off = wgid / NXCD; wgid = (xcd < r ? xcd * (q + 1) : r * (q + 1) + (xcd - r) * q) + off; }
        const int nig = WGM * nN, gid = wgid / nig, fm = gid * WGM, gsz = (nM - fm) < WGM ? (nM - fm) : WGM;
        u.pm = fm + ((wgid % nig) % gsz); u.pn = (wgid % nig) / gsz; return true;
    }
    __device__ __forceinline__ void prefetch(int) const {}
    __device__ __forceinline__ void a_ready(const Unit&) const {}
    __device__ __forceinline__ void done(const Unit&) const {}
};
struct QueueOrder {
    unsigned* head; volatile PG8_LAS unsigned* slot; int nM, nN, nwg;
    __device__ __forceinline__ void init(int M, int N, unsigned* h, volatile PG8_LAS unsigned* s) { nM = M / BM; nN = N / BM; nwg = nM * nN; head = h; slot = s; }
    __device__ __forceinline__ void prefetch(int i) const { if (threadIdx.x == 0) slot[i & 1] = __hip_atomic_fetch_add(head, 1u, __ATOMIC_RELAXED, __HIP_MEMORY_SCOPE_AGENT); }
    __device__ __forceinline__ bool next(int i, Unit& u) const {
        if (i == 0) { __syncthreads(); prefetch(0); __syncthreads(); }
        const int idx = (int)slot[i & 1]; if (idx >= nwg) return false;
        const int nig = WGM * nN, gid = idx / nig, fm = gid * WGM, gsz = (nM - fm) < WGM ? (nM - fm) : WGM;
        u.pm = fm + ((idx % nig) % gsz); u.pn = (idx % nig) / gsz; return true;
    }
    __device__ __forceinline__ void a_ready(const Unit&) const {}
    __device__ __forceinline__ void done(const Unit&) const {}
};

__device__ __forceinline__ unsigned cvt_pk_bf16(float lo, float hi) { unsigned r; asm volatile("v_cvt_pk_bf16_f32 %0, %1, %2" : "=v"(r) : "v"(lo), "v"(hi)); return r; }
#define EPI_GEOM int t_ = threadIdx.x; asm volatile("" : "+v"(t_)); const int wid_ = t_ >> 6, wr = wid_ >> 2, wc = wid_ & 3, fr = t_ & 15, fq = (t_ & 63) >> 4;
__device__ __forceinline__ u32x4 pack8(const f32x4 v0, const f32x4 v1) { u32x4 w; w.x = cvt_pk_bf16(v0[0], v0[1]); w.y = cvt_pk_bf16(v0[2], v0[3]); w.z = cvt_pk_bf16(v1[0], v1[1]); w.w = cvt_pk_bf16(v1[2], v1[3]); return w; }
__device__ __forceinline__ float* out_row(float* out, size_t offp, size_t offs, int row, int width) {
    if (row < MP) return out + offp + (size_t)row * width;
    if (row < MT) return out + offs + (size_t)(row - MP) * width;
    return nullptr;
}
struct EpiIn {
    static constexpr bool PERM = true, AFTER_DRAIN = false, MIDK = false;
    bf16_t *QB, *KB, *VB, *GQ, *GZ, *GT; float *GAB, *LGF; float* out;
    const PG8_LAS float* par;
    __device__ __forceinline__ void operator()(const f32x4 (&acc)[2][2][4][2], const Unit& u, int, int, int, int) const {
        EPI_GEOM
        const int pn = u.pn; const int row0 = u.pm * BM + wr * 64 + fr;
        if (pn < 4) {
            const bool isk = pn >= 2; const int head = 4 * (pn & 1) + wc; const PG8_LAS float* gv = par + (isk ? 64 : 0);
            f32x4 g[2][2];
#pragma unroll
            for (int bj = 0; bj < 2; ++bj)
#pragma unroll
                for (int n = 0; n < 2; ++n) g[bj][n] = *(const PG8_LAS f32x4*)(gv + 32 * bj + 8 * fq + 4 * n);
#pragma unroll
            for (int ai = 0; ai < 2; ++ai)
#pragma unroll
                for (int m = 0; m < 4; ++m) {
                    float ss = 0.f;
#pragma unroll
                    for (int bj = 0; bj < 2; ++bj)
#pragma unroll
                        for (int n = 0; n < 2; ++n) { const f32x4 x = acc[ai][bj][m][n]; ss += (x[0] * x[0] + x[1] * x[1]) + (x[2] * x[2] + x[3] * x[3]); }
                    ss += __shfl_xor(ss, 16); ss += __shfl_xor(ss, 32);
                    float rs = __builtin_amdgcn_rsqf(ss * (1.0f / 64.0f) + EPS); if (!isk) rs *= C2;
                    const int row = row0 + ai * HALF + m * 16;
                    float* orow = isk ? out_row(out, OFF_KP, OFF_KS, row, FW) : nullptr;
#pragma unroll
                    for (int bj = 0; bj < 2; ++bj) {
                        const f32x4 v0 = acc[ai][bj][m][0] * rs * g[bj][0], v1 = acc[ai][bj][m][1] * rs * g[bj][1];
                        const int col = head * 64 + 32 * bj + 8 * fq;
                        *(u32x4*)((isk ? KB : QB) + (size_t)row * FW + col) = pack8(v0, v1);
                        if (orow) { *(f32x4*)(orow + col) = v0; *(f32x4*)(orow + col + 4) = v1; }
                    }
                }
        } else if (pn < 6) {
#pragma unroll
            for (int ai = 0; ai < 2; ++ai)
#pragma unroll
                for (int m = 0; m < 4; ++m) { const int row = row0 + ai * HALF + m * 16; float* orow = out_row(out, OFF_VP, OFF_VS, row, FW);
#pragma unroll
                    for (int bj = 0; bj < 2; ++bj) { const int col = 256 * (pn - 4) + 128 * bj + 32 * wc + 8 * fq; const f32x4 v0 = acc[ai][bj][m][0], v1 = acc[ai][bj][m][1];
                        *(u32x4*)(VB + (size_t)row * FW + col) = pack8(v0, v1);
                        if (orow) { *(f32x4*)(orow + col) = v0; *(f32x4*)(orow + col + 4) = v1; } } }
        } else if (pn < 12) {
#pragma unroll
            for (int ai = 0; ai < 2; ++ai)
#pragma unroll
                for (int m = 0; m < 4; ++m) { const int row = row0 + ai * HALF + m * 16;
#pragma unroll
                    for (int bj = 0; bj < 2; ++bj) { const int col = 256 * (pn - 6) + 128 * bj + 32 * wc + 8 * fq;
                        *(u32x4*)(GQ + (size_t)row * CCH + col) = pack8(acc[ai][bj][m][0], acc[ai][bj][m][1]); } }
        } else if (pn < 14) {
#pragma unroll
            for (int ai = 0; ai < 2; ++ai)
#pragma unroll
                for (int m = 0; m < 4; ++m) { const int row = row0 + ai * HALF + m * 16;
#pragma unroll
                    for (int bj = 0; bj < 2; ++bj) { const int col = 256 * (pn - 12) + 128 * bj + 32 * wc + 8 * fq; f32x4 v0 = acc[ai][bj][m][0], v1 = acc[ai][bj][m][1];
#pragma unroll
                        for (int i = 0; i < 4; ++i) { v0[i] = v0[i] * __builtin_amdgcn_rcpf(1.0f + __expf(-v0[i])); v1[i] = v1[i] * __builtin_amdgcn_rcpf(1.0f + __expf(-v1[i])); }
                        *(u32x4*)(GZ + (size_t)row * 512 + col) = pack8(v0, v1); } }
        } else if (pn < 22) {
#pragma unroll
            for (int ai = 0; ai < 2; ++ai)
#pragma unroll
                for (int m = 0; m < 4; ++m) { const int row = row0 + ai * HALF + m * 16;
#pragma unroll
                    for (int bj = 0; bj < 2; ++bj) { const int col = 256 * (pn - 14) + 128 * bj + 32 * wc + 8 * fq; f32x4 v0 = acc[ai][bj][m][0], v1 = acc[ai][bj][m][1];
#pragma unroll
                        for (int i = 0; i < 4; ++i) { v0[i] = __builtin_amdgcn_rcpf(1.0f + __expf(-v0[i])); v1[i] = __builtin_amdgcn_rcpf(1.0f + __expf(-v1[i])); }
                        *(u32x4*)(GT + (size_t)row * 2048 + col) = pack8(v0, v1); } }
        } else {
            if (wc == 0 && fq < 2) {
#pragma unroll
                for (int ai = 0; ai < 2; ++ai)
#pragma unroll
                    for (int m = 0; m < 4; ++m) { const int row = row0 + ai * HALF + m * 16; const f32x4 a0 = acc[ai][0][m][0], a1 = acc[ai][0][m][1];
                        if (fq == 0) { f32x4 l0, l1;
#pragma unroll
                            for (int i = 0; i < 4; ++i) { l0[i] = log_sigmoidf_(a0[i] + par[128 + i]); l1[i] = log_sigmoidf_(a1[i] + par[132 + i]); }
                            *(f32x4*)(LGF + (size_t)row * 8) = l0; *(f32x4*)(LGF + (size_t)row * 8 + 4) = l1;
                            float* orow = out_row(out, OFF_LFP, OFF_LFS, row, 8); if (orow) { *(f32x4*)orow = l0; *(f32x4*)(orow + 4) = l1; }
                        } else { f32x4 ld, be;
#pragma unroll
                            for (int i = 0; i < 4; ++i) { ld[i] = par[136 + i] * softplusf_(a0[i] + par[140 + i]); be[i] = __builtin_amdgcn_rcpf(1.0f + __expf(-a1[i])); }
                            *(f32x4*)(GAB + (size_t)row * 8) = ld; *(f32x4*)(GAB + (size_t)row * 8 + 4) = be; } }
            }
        }
    }
};
template <int ACT> struct EpiBf {
    static constexpr bool PERM = true, AFTER_DRAIN = false, MIDK = false;
    bf16_t* O; int ldc; const float* ss;
    __device__ __forceinline__ void operator()(const f32x4 (&acc)[2][2][4][2], const Unit& u, int, int, int, int) const {
        EPI_GEOM
        const int row0 = u.pm * BM + wr * 64 + fr, col0 = u.pn * BM + wc * 32 + 8 * fq;
        float rsv[8];
        if (ACT == 1) {
#pragma unroll
            for (int g = 0; g < 8; ++g) rsv[g] = ss[row0 + (g >> 2) * HALF + (g & 3) * 16];
#pragma unroll
            for (int g = 0; g < 8; ++g) rsv[g] = __builtin_amdgcn_rsqf(rsv[g] * (1.0f / D) + EPS);
        }
#pragma unroll
        for (int ai = 0; ai < 2; ++ai)
#pragma unroll
            for (int m = 0; m < 4; ++m) { const int row = row0 + ai * HALF + m * 16; const float rs = (ACT == 1) ? rsv[ai * 4 + m] : 1.f;
#pragma unroll
                for (int bj = 0; bj < 2; ++bj) { f32x4 v0 = acc[ai][bj][m][0], v1 = acc[ai][bj][m][1];
                    if (ACT == 1 || ACT == 2) {
#pragma unroll
                        for (int i = 0; i < 4; ++i) { float a = fmaxf(v0[i] * rs, 0.f), b = fmaxf(v1[i] * rs, 0.f); v0[i] = a * a; v1[i] = b * b; } }
                    *(u32x4*)(O + (size_t)row * ldc + col0 + bj * HALF) = pack8(v0, v1); } }
    }
};
struct EpiMerge {
    static constexpr bool PERM = true, AFTER_DRAIN = false, MIDK = true;
    bf16_t* O; const bf16_t* GT;
    __device__ __forceinline__ void mid(f32x4 (&acc)[2][2][4][2], const Unit& u, int, int, int, int) const {
        int t_ = threadIdx.x; asm volatile("" : "+v"(t_));
        const int wid_ = t_ >> 6, wr = wid_ >> 2, wc = wid_ & 3, fr = t_ & 15, fq = (t_ & 63) >> 4;
        const int row0 = u.pm * BM + wr * 64 + fr, col0 = u.pn * BM + wc * 32 + 8 * fq;
        u32x4 ga[2], gb[2], na[2], nb[2];
        { const bf16_t* gp = GT + (size_t)row0 * 2048 + col0; ga[0] = *(const u32x4*)gp; ga[1] = *(const u32x4*)(gp + HALF); gb[0] = *(const u32x4*)(gp + 1024); gb[1] = *(const u32x4*)(gp + 1024 + HALF); }
#pragma unroll
        for (int g = 0; g < 8; ++g) { const int ai = g >> 2, m = g & 3;
            if (g < 7) { const bf16_t* gp = GT + (size_t)(row0 + ((g + 1) >> 2) * HALF + ((g + 1) & 3) * 16) * 2048 + col0; na[0] = *(const u32x4*)gp; na[1] = *(const u32x4*)(gp + HALF); nb[0] = *(const u32x4*)(gp + 1024); nb[1] = *(const u32x4*)(gp + 1024 + HALF); }
#pragma unroll
            for (int bj = 0; bj < 2; ++bj)
#pragma unroll
                for (int w = 0; w < 4; ++w) { const float a0 = bflo(ga[bj][w]), a1 = bfhi(ga[bj][w]), b0 = fmaxf(bflo(gb[bj][w]), 1e-30f), b1 = fmaxf(bfhi(gb[bj][w]), 1e-30f);
                    acc[ai][bj][m][w >> 1][(w & 1) * 2] *= a0 * __builtin_amdgcn_rcpf(b0); acc[ai][bj][m][w >> 1][(w & 1) * 2 + 1] *= a1 * __builtin_amdgcn_rcpf(b1); }
            asm volatile("" : "+v"(acc[ai][0][m][0]), "+v"(acc[ai][0][m][1]), "+v"(acc[ai][1][m][0]), "+v"(acc[ai][1][m][1]) :: "memory");
            ga[0] = na[0]; ga[1] = na[1]; gb[0] = nb[0]; gb[1] = nb[1]; }
    }
    __device__ __forceinline__ void operator()(const f32x4 (&acc)[2][2][4][2], const Unit& u, int, int, int, int) const {
        EPI_GEOM
        const int row0 = u.pm * BM + wr * 64 + fr, col0 = u.pn * BM + wc * 32 + 8 * fq;
        u32x4 gb[2], nb[2];
        { const bf16_t* gp = GT + (size_t)row0 * 2048 + 1024 + col0; gb[0] = *(const u32x4*)gp; gb[1] = *(const u32x4*)(gp + HALF); }
#pragma unroll
        for (int g = 0; g < 8; ++g) { const int ai = g >> 2, m = g & 3; const int row = row0 + ai * HALF + m * 16;
            if (g < 7) { const bf16_t* gp = GT + (size_t)(row0 + ((g + 1) >> 2) * HALF + ((g + 1) & 3) * 16) * 2048 + 1024 + col0; nb[0] = *(const u32x4*)gp; nb[1] = *(const u32x4*)(gp + HALF); }
#pragma unroll
            for (int bj = 0; bj < 2; ++bj) { f32x4 v0 = acc[ai][bj][m][0], v1 = acc[ai][bj][m][1]; const u32x4 q = gb[bj];
                v0[0] *= fmaxf(bflo(q[0]), 1e-30f); v0[1] *= fmaxf(bfhi(q[0]), 1e-30f); v0[2] *= fmaxf(bflo(q[1]), 1e-30f); v0[3] *= fmaxf(bfhi(q[1]), 1e-30f);
                v1[0] *= fmaxf(bflo(q[2]), 1e-30f); v1[1] *= fmaxf(bfhi(q[2]), 1e-30f); v1[2] *= fmaxf(bflo(q[3]), 1e-30f); v1[3] *= fmaxf(bfhi(q[3]), 1e-30f);
                *(u32x4*)(O + (size_t)row * D + col0 + bj * HALF) = pack8(v0, v1); }
            gb[0] = nb[0]; gb[1] = nb[1]; }
    }
};
template <bool BASE16, bool SCALE> struct EpiRes {
    static constexpr bool PERM = false, AFTER_DRAIN = false, MIDK = false;
    const void* base; bf16_t* XB; float* ss; const float* ss_in;
    __device__ __forceinline__ void operator()(const f32x4 (&acc)[2][2][4][2], const Unit& u, int, int, int, int) const {
        EPI_GEOM
        const int row0 = u.pm * BM + wr * 64 + fr, col0 = u.pn * BM + wc * 32 + 4 * fq;
        f32x4 cur[2][2], nxt[2][2];
        auto ld = [&](int g, f32x4 (&d)[2][2]) { const size_t o = (size_t)(row0 + (g >> 2) * HALF + (g & 3) * 16) * D + col0;
#pragma unroll
            for (int bj = 0; bj < 2; ++bj)
#pragma unroll
                for (int n = 0; n < 2; ++n) {
                    if constexpr (BASE16) { const v2u w = *(const v2u*)((const bf16_t*)base + o + bj * HALF + n * 16); d[bj][n] = (f32x4){bflo(w.x), bfhi(w.x), bflo(w.y), bfhi(w.y)}; }
                    else d[bj][n] = *(const f32x4*)((const float*)base + o + bj * HALF + n * 16); } };
        float r2[8];
        if constexpr (SCALE) {
#pragma unroll
            for (int g = 0; g < 8; ++g) r2[g] = ss_in[row0 + (g >> 2) * HALF + (g & 3) * 16];
        }
        ld(0, cur);
#pragma unroll
        for (int g = 0; g < 8; ++g) { const int ai = g >> 2, m = g & 3; const int row = row0 + ai * HALF + m * 16;
            if (g < 7) ld(g + 1, nxt);
            float sc = 1.f; if constexpr (SCALE) sc = __builtin_amdgcn_rcpf(r2[g] * (1.0f / D) + EPS);
            float s = 0.f;
#pragma unroll
            for (int bj = 0; bj < 2; ++bj)
#pragma unroll
                for (int n = 0; n < 2; ++n) { const int col = col0 + bj * HALF + n * 16; const f32x4 v = acc[ai][bj][m][n] * sc + cur[bj][n];
                    s += (v[0] * v[0] + v[1] * v[1]) + (v[2] * v[2] + v[3] * v[3]);
                    v2u w; w.x = cvt_pk_bf16(v[0], v[1]); w.y = cvt_pk_bf16(v[2], v[3]); *(v2u*)(XB + (size_t)row * D + col) = w; }
            s += __shfl_xor(s, 16); s += __shfl_xor(s, 32);
            if (fq == 0) atomicAdd(ss + row, s);
#pragma unroll
            for (int bj = 0; bj < 2; ++bj)
#pragma unroll
                for (int n = 0; n < 2; ++n) cur[bj][n] = nxt[bj][n]; }
    }
};
struct EpiFinal {
    static constexpr bool PERM = false, AFTER_DRAIN = false, MIDK = false;
    const bf16_t* X2B; const bf16_t* PL; const float* ss; float* out;
    __device__ __forceinline__ void operator()(const f32x4 (&acc)[2][2][4][2], const Unit& u, int, int, int, int) const {
        EPI_GEOM
        const int row0 = u.pm * BM + wr * 64 + fr, col0 = u.pn * BM + wc * 32 + 4 * fq;
        float rsv[8];
#pragma unroll
        for (int g = 0; g < 8; ++g) rsv[g] = ss[row0 + (g >> 2) * HALF + (g & 3) * 16];
        v2u cx[2][2], nx[2][2], cp[2][2], np[2][2];
        { const size_t o = (size_t)row0 * D + col0;
#pragma unroll
          for (int bj = 0; bj < 2; ++bj)
#pragma unroll
            for (int n = 0; n < 2; ++n) { cx[bj][n] = *(const v2u*)(X2B + o + bj * HALF + n * 16); cp[bj][n] = *(const v2u*)(PL + o + bj * HALF + n * 16); } }
#pragma unroll
        for (int g = 0; g < 8; ++g) { const int ai = g >> 2, m = g & 3; const int row = row0 + ai * HALF + m * 16;
            if (g < 7) { const size_t o = (size_t)(row0 + ((g + 1) >> 2) * HALF + ((g + 1) & 3) * 16) * D + col0;
#pragma unroll
                for (int bj = 0; bj < 2; ++bj)
#pragma unroll
                    for (int n = 0; n < 2; ++n) { nx[bj][n] = *(const v2u*)(X2B + o + bj * HALF + n * 16); np[bj][n] = *(const v2u*)(PL + o + bj * HALF + n * 16); } }
            const float rs = __builtin_amdgcn_rsqf(rsv[g] * (1.0f / D) + EPS);
#pragma unroll
            for (int bj = 0; bj < 2; ++bj)
#pragma unroll
                for (int n = 0; n < 2; ++n) { const int col = col0 + bj * HALF + n * 16; const f32x4 a = acc[ai][bj][m][n]; const v2u x = cx[bj][n]; const v2u p = cp[bj][n]; f32x4 y;
                    y[0] = bflo(x.x) + bflo(p.x) * __builtin_amdgcn_rcpf(1.0f + __expf(-a[0] * rs)); y[1] = bfhi(x.x) + bfhi(p.x) * __builtin_amdgcn_rcpf(1.0f + __expf(-a[1] * rs));
                    y[2] = bflo(x.y) + bflo(p.y) * __builtin_amdgcn_rcpf(1.0f + __expf(-a[2] * rs)); y[3] = bfhi(x.y) + bfhi(p.y) * __builtin_amdgcn_rcpf(1.0f + __expf(-a[3] * rs));
                    *(f32x4*)(out + (size_t)row * D + col) = y; }
#pragma unroll
            for (int bj = 0; bj < 2; ++bj)
#pragma unroll
                for (int n = 0; n < 2; ++n) { cx[bj][n] = nx[bj][n]; cp[bj][n] = np[bj][n]; } }
    }
};
template <class Epi, class Sched, bool ALIGN_EPI = false, bool SP2 = false>
__device__ __forceinline__ void gemm_phase(PG8_LAS unsigned char* lds, const Gemm g, const Sched& S, const Epi& E) {
    int tid_ = threadIdx.x; asm volatile("" : "+v"(tid_));
    const int tid = tid_, wid = __builtin_amdgcn_readfirstlane(tid >> 6), lane = tid & 63, wr = wid >> 2, wc = wid & 3, fr = lane & 15, fq = lane >> 4;
    const int K = g.K, nt = K / BK;
    unsigned voffA[2], voffB[2];
#pragma unroll
    for (int i = 0; i < 2; ++i) { int R, C; stage_rc(tid * 16 + i * 8192, R, C); const int Rb = Epi::PERM ? ((R & ~31) + perm32(R & 31)) : R;
        voffA[i] = (unsigned)(R * K + C) * 2u; voffB[i] = (unsigned)(Rb * K + C) * 2u; }
    const size_t kstep = (size_t)(BK * 2);
    const size_t hstep = (size_t)HALF * K * 2;
    const size_t tstep = 2 * hstep;
    const unsigned ldsw = (unsigned)wid * 1024u;
    const int aoff = lds_byte(wr * 64 + fr, fq * 8), boff = lds_byte(wc * 32 + fr, fq * 8);
#define PG8_SA(b, h) (((b) * 2 + (h)) * HTB)
#define PG8_SB(b, h) ((4 + (b) * 2 + (h)) * HTB)
#define PG8_STAGE(bufoff, gbase, voff) do { _Pragma("unroll") for (int _i = 0; _i < 2; ++_i) \
        __builtin_amdgcn_global_load_lds((const unsigned*)((const char*)(gbase) + (voff)[_i]), (PG8_LAS unsigned*)(lds + (bufoff) + ldsw + _i * 8192), 16, 0, 0); } while (0)
#define PG8_LDA(dst, b, h) do { _Pragma("unroll") for (int m = 0; m < 4; ++m) _Pragma("unroll") for (int k = 0; k < 2; ++k) dst[m][k] = *(const PG8_LAS bf16x8*)(lds + PG8_SA(b, h) + aoff + m * 2048 + k * 1024); } while (0)
#define PG8_LDB(dst, b, h) do { _Pragma("unroll") for (int n = 0; n < 2; ++n) _Pragma("unroll") for (int k = 0; k < 2; ++k) dst[n][k] = *(const PG8_LAS bf16x8*)(lds + PG8_SB(b, h) + boff + n * 2048 + k * 1024); } while (0)
#define PG8_MMA(ai, bj, At, Bt) do { __builtin_amdgcn_s_setprio(1); _Pragma("unroll") for (int m = 0; m < 4; ++m) _Pragma("unroll") for (int n = 0; n < 2; ++n) _Pragma("unroll") for (int k = 0; k < 2; ++k) \
        acc[ai][bj][m][n] = __builtin_amdgcn_mfma_f32_16x16x32_bf16(Bt[n][k], At[m][k], acc[ai][bj][m][n], 0, 0, 0); __builtin_amdgcn_s_setprio(0); } while (0)
#define PG8_WAIT_V(n) asm volatile("s_waitcnt vmcnt(" #n ")" ::: "memory")
#define PG8_WAIT_L(n) asm volatile("s_waitcnt lgkmcnt(" #n ")" ::: "memory")
#define PG8_BAR __builtin_amdgcn_s_barrier()
#define PG8_SCHED __builtin_amdgcn_sched_barrier(0)
    Unit cur, nxt; int ui = 0;
    if (!S.next(0, cur)) return;
    f32x4 acc[2][2][4][2];
#pragma unroll
    for (int a = 0; a < 2; ++a)
#pragma unroll
        for (int b = 0; b < 2; ++b)
#pragma unroll
            for (int m = 0; m < 4; ++m)
#pragma unroll
                for (int n = 0; n < 2; ++n) acc[a][b][m][n] = (f32x4){0.f, 0.f, 0.f, 0.f};
    bf16x8 At[4][2], B0[2][2], B1[2][2];
    const char* cA = (const char*)g.A + (size_t)cur.pm * tstep; const char* cB = (const char*)g.Bt + (size_t)cur.pn * tstep;
    S.a_ready(cur);
    if constexpr (SP2) {
        PG8_STAGE(PG8_SB(0, 0), cB, voffB); PG8_STAGE(PG8_SB(0, 1), cB + hstep, voffB); PG8_STAGE(PG8_SA(0, 0), cA, voffA); PG8_STAGE(PG8_SA(0, 1), cA + hstep, voffA);
        if (wr == 1) PG8_BAR;
        PG8_WAIT_V(2); PG8_BAR;
        PG8_STAGE(PG8_SB(1, 0), cB + kstep, voffB); PG8_STAGE(PG8_SA(1, 0), cA + kstep, voffA); PG8_STAGE(PG8_SB(1, 1), cB + hstep + kstep, voffB);
        PG8_WAIT_V(6); PG8_BAR;
    } else {
        PG8_STAGE(PG8_SB(0, 0), cB, voffB); PG8_STAGE(PG8_SA(0, 0), cA, voffA); PG8_STAGE(PG8_SB(0, 1), cB + hstep, voffB); PG8_STAGE(PG8_SA(0, 1), cA + hstep, voffA);
        if (wr == 1) PG8_BAR;
        PG8_WAIT_V(4); PG8_BAR;
        PG8_STAGE(PG8_SB(1, 0), cB + kstep, voffB); PG8_STAGE(PG8_SA(1, 0), cA + kstep, voffA); PG8_STAGE(PG8_SB(1, 1), cB + hstep + kstep, voffB);
        PG8_WAIT_V(6); PG8_BAR;
    }
    for (;;) {
        S.prefetch(ui + 1);
        bool has_next = false; const char* nA = cA; const char* nB = cB;
#pragma unroll 1
        for (int t = 0; t < nt; t += 2) {
            if constexpr (Epi::MIDK) { if (t == (nt >> 1)) E.mid(acc, cur, wr, wc, fr, fq); }
            const bool last = (t == nt - 2);
            if (last) { has_next = S.next(ui + 1, nxt); if (has_next) { nA = (const char*)g.A + (size_t)nxt.pm * tstep; nB = (const char*)g.Bt + (size_t)nxt.pn * tstep; } }
            const char* a1 = cA + (size_t)(t + 1) * kstep;
            const char* a2 = last ? nA : cA + (size_t)(t + 2) * kstep; const char* b2 = last ? nB : cB + (size_t)(t + 2) * kstep;
            const char* a3 = a2 + kstep; const char* b3 = b2 + kstep;
            if (last && has_next) S.a_ready(nxt);
            if constexpr (SP2) {
            PG8_LDB(B0, 0, 0); PG8_LDB(B1, 0, 1); PG8_SCHED; PG8_LDA(At, 0, 0); PG8_STAGE(PG8_SA(1, 1), a1 + hstep, voffA);
            PG8_WAIT_V(8); PG8_WAIT_L(0); PG8_BAR; PG8_MMA(0, 0, At, B0); PG8_MMA(0, 1, At, B1); PG8_BAR; PG8_SCHED;
            PG8_LDA(At, 0, 1); PG8_STAGE(PG8_SB(0, 0), b2, voffB); PG8_STAGE(PG8_SB(0, 1), b2 + hstep, voffB); PG8_STAGE(PG8_SA(0, 0), a2, voffA);
            PG8_WAIT_V(8); PG8_WAIT_L(0); PG8_BAR; PG8_MMA(1, 0, At, B0); PG8_MMA(1, 1, At, B1); PG8_BAR; PG8_SCHED;
            PG8_LDB(B0, 1, 0); PG8_LDB(B1, 1, 1); PG8_SCHED; PG8_LDA(At, 1, 0); PG8_STAGE(PG8_SA(0, 1), a2 + hstep, voffA);
            PG8_WAIT_V(8); PG8_WAIT_L(0); PG8_BAR; PG8_MMA(0, 0, At, B0); PG8_MMA(0, 1, At, B1); PG8_BAR; PG8_SCHED;
            PG8_LDA(At, 1, 1); PG8_STAGE(PG8_SB(1, 0), b3, voffB); PG8_STAGE(PG8_SB(1, 1), b3 + hstep, voffB); PG8_STAGE(PG8_SA(1, 0), a3, voffA);
            PG8_WAIT_V(8); PG8_WAIT_L(0); PG8_BAR; PG8_MMA(1, 0, At, B0); PG8_MMA(1, 1, At, B1); PG8_BAR; PG8_SCHED;
            } else {
            PG8_LDB(B0, 0, 0); PG8_SCHED; PG8_LDA(At, 0, 0); PG8_STAGE(PG8_SA(1, 1), a1 + hstep, voffA);
            PG8_WAIT_L(8); PG8_BAR; PG8_WAIT_L(0); PG8_MMA(0, 0, At, B0); PG8_BAR; PG8_SCHED;
            PG8_LDB(B1, 0, 1); PG8_STAGE(PG8_SB(0, 0), b2, voffB);
            PG8_BAR; PG8_WAIT_L(0); PG8_MMA(0, 1, At, B1); PG8_BAR;
            PG8_LDA(At, 0, 1); PG8_STAGE(PG8_SA(0, 0), a2, voffA);
            PG8_BAR; PG8_WAIT_L(0); PG8_MMA(1, 0, At, B0); PG8_BAR; PG8_SCHED;
            PG8_STAGE(PG8_SB(0, 1), b2 + hstep, voffB);
            PG8_WAIT_V(6); PG8_BAR; PG8_MMA(1, 1, At, B1); PG8_BAR;
            PG8_LDB(B0, 1, 0); PG8_SCHED; PG8_LDA(At, 1, 0); PG8_STAGE(PG8_SA(0, 1), a2 + hstep, voffA);
            PG8_WAIT_L(8); PG8_BAR; PG8_WAIT_L(0); PG8_MMA(0, 0, At, B0); PG8_BAR; PG8_SCHED;
            PG8_LDB(B1, 1, 1); PG8_STAGE(PG8_SB(1, 0), b3, voffB);
            PG8_BAR; PG8_WAIT_L(0); PG8_MMA(0, 1, At, B1); PG8_BAR;
            PG8_LDA(At, 1, 1); PG8_STAGE(PG8_SA(1, 0), a3, voffA);
            PG8_BAR; PG8_WAIT_L(0); PG8_MMA(1, 0, At, B0); PG8_BAR; PG8_SCHED;
            PG8_STAGE(PG8_SB(1, 1), b3 + hstep, voffB);
            PG8_WAIT_V(6); PG8_BAR; PG8_MMA(1, 1, At, B1); PG8_BAR;
            }
        }
        if constexpr (ALIGN_EPI) { if (wr == 0) PG8_BAR; }
        if constexpr (!Epi::AFTER_DRAIN) { E(acc, cur, wr, wc, fr, fq); S.done(cur); }
        if (!has_next) break;
#pragma unroll
        for (int a = 0; a < 2; ++a)
#pragma unroll
            for (int b = 0; b < 2; ++b)
#pragma unroll
                for (int m = 0; m < 4; ++m)
#pragma unroll
                    for (int n = 0; n < 2; ++n) acc[a][b][m][n] = (f32x4){0.f, 0.f, 0.f, 0.f};
        cur = nxt; cA = nA; cB = nB; ++ui;
        if constexpr (ALIGN_EPI) { if (wr == 1) PG8_BAR; }
    }
    PG8_WAIT_V(0);
    if constexpr (!ALIGN_EPI) { if (wr == 0) PG8_BAR; }
    PG8_BAR;
    if constexpr (Epi::AFTER_DRAIN) { E.fused(acc, cur, wr, wc, fr, fq, lds, wid, lane); S.done(cur); }
#undef PG8_SA
#undef PG8_SB
#undef PG8_STAGE
#undef PG8_LDA
#undef PG8_LDB
#undef PG8_MMA
#undef PG8_WAIT_V
#undef PG8_WAIT_L
#undef PG8_BAR
#undef PG8_SCHED
}
}
#define XB_TMO      128
#define XB_XCNT(j)  (256  + 64 * (j))
#define XB_XSUB(j)  (1280 + 64 * (j))
#define XB_XGEN(j)  (2304 + 64 * (j))
#define XB_TOP      3328
#define XB_TOPGEN   3392
#define XCD_BAR_WORDS 3456
#define XB_SPIN_CAP (1u << 18)

__device__ __forceinline__ unsigned xb_ld(unsigned* p)              { return __hip_atomic_load(p, __ATOMIC_RELAXED, __HIP_MEMORY_SCOPE_AGENT); }
__device__ __forceinline__ unsigned xb_add(unsigned* p, unsigned v) { return __hip_atomic_fetch_add(p, v, __ATOMIC_RELAXED, __HIP_MEMORY_SCOPE_AGENT); }
__device__ __forceinline__ unsigned xb_xcc_id() { return (unsigned)__builtin_amdgcn_s_getreg((3 << 11) | 20) & 0xFu; }
#define XB_SPIN(cond, bar) do { unsigned _sp = 0; while (cond) { __builtin_amdgcn_s_sleep(1); \
    if ((++_sp & 255u) == 0u) { if (xb_ld(&(bar)[XB_TMO])) break; if (_sp > XB_SPIN_CAP) { atomicAdd(&(bar)[XB_TMO], 1u); break; } } } } while (0)

struct XcdBarrier {
    unsigned* bar; unsigned x;
    volatile LAS unsigned* st;
};

__device__ __forceinline__ XcdBarrier xcd_barrier_post(unsigned* bar, volatile LAS unsigned* st) {
    XcdBarrier b; b.bar = bar; b.x = xb_xcc_id(); b.st = st;
    if (threadIdx.x == 0) (void)xb_add(&bar[XB_XCNT(b.x)], 1u);
    return b;
}
__device__ __forceinline__ void xcd_barrier_complete(unsigned* bar, unsigned x, unsigned& nloc, unsigned& nx) {
    const unsigned G = gridDim.x * gridDim.y * gridDim.z;
    unsigned sum, cnt, mine, sp = 0u;
    for (;;) {
        sum = 0u; cnt = 0u; mine = 0u;
#pragma unroll
        for (unsigned j = 0; j < 16; ++j) { const unsigned c = xb_ld(&bar[XB_XCNT(j)]); sum += c; cnt += (c > 0u) ? 1u : 0u; mine = (j == x) ? c : mine; }
        if (sum == G) break;
        __builtin_amdgcn_s_sleep(1);
        if ((++sp & 255u) == 0u) { if (xb_ld(&bar[XB_TMO])) break; if (sp > XB_SPIN_CAP) { atomicAdd(&bar[XB_TMO], 1u); break; } }
    }
    nloc = mine > 0u ? mine : 1u; nx = cnt > 0u ? cnt : 1u;
}

__device__ __forceinline__ void xcd_barrier(const XcdBarrier& b) {
    asm volatile("s_waitcnt vmcnt(0)" ::: "memory");
    __syncthreads();
    if (threadIdx.x == 0) {
        unsigned* bar = b.bar;
        __builtin_amdgcn_s_waitcnt(0);
        unsigned nloc = b.st[0], nx = b.st[1];
        if (nloc == 0u) { xcd_barrier_complete(bar, b.x, nloc, nx); b.st[0] = nloc; b.st[1] = nx; }
        const unsigned old = xb_add(&bar[XB_XSUB(b.x)], 1u);
        const unsigned gen = old / nloc;
        if (old + 1u == (gen + 1u) * nloc) {
            __builtin_amdgcn_fence(__ATOMIC_RELEASE, "agent");
            asm volatile("s_waitcnt vmcnt(0)" ::: "memory");
            const unsigned og = xb_add(&bar[XB_TOP], 1u);
            const unsigned tg = og / nx;
            if (og + 1u == (tg + 1u) * nx) xb_add(&bar[XB_TOPGEN], 1u);
            else XB_SPIN(xb_ld(&bar[XB_TOPGEN]) == tg, bar);
            __builtin_amdgcn_fence(__ATOMIC_ACQUIRE, "agent");
            xb_add(&bar[XB_XGEN(b.x)], 1u);
            asm volatile("s_waitcnt vmcnt(0)" ::: "memory");
        } else {
            XB_SPIN(xb_ld(&bar[XB_XGEN(b.x)]) == gen, bar);
            __builtin_amdgcn_fence(__ATOMIC_ACQUIRE, "agent");
            asm volatile("s_waitcnt vmcnt(0)" ::: "memory");
        }
    }
    __syncthreads();
}
struct Frame {
    LAS unsigned char* lds;
    volatile LAS unsigned* MISC;
    gu32* ctl;
    int tid, lane, wave;
    int vcu, G;
    unsigned char* ws; float* out;
    const float* in[28]; const int* page_table;
};
struct Args { const void* in[28]; float* out; unsigned char* ws; int ph_lo, ph_hi, li, pad; };

__device__ __forceinline__ int in_srccol(int n0) {
    if (n0 < 1024) { const int t = n0 >> 8, w = n0 & 255, bj = w >> 7, wc = (w & 127) >> 5; return 256 * t + 64 * wc + 32 * bj; }
    if (n0 < 1536) return n0;
    if (n0 < 3072) return n0 + 8;
    return n0 + 16;
}
__device__ __forceinline__ void p0_transpose_item(const float* W, int ldw, bf16* WT, int ldk, int koff, int k0, int n0dst, int n0src, const float* gain, LAS float* scr, int lane) {
    { float v[32];
#pragma unroll
      for (int i = 0; i < 32; ++i) v[i] = W[(size_t)(k0 + 2 * i + (lane >> 5)) * ldw + n0src + (lane & 31)];
      if (gain) {
#pragma unroll
          for (int i = 0; i < 32; ++i) v[i] *= gain[k0 + 2 * i + (lane >> 5)]; }
#pragma unroll
      for (int i = 0; i < 32; ++i) scr[(2 * i + (lane >> 5)) * 33 + (lane & 31)] = v[i]; }
    LDS_WAIT(); asm volatile("" ::: "memory");
    const int c = lane & 7;
#pragma unroll
    for (int j = 0; j < 4; ++j) { const int n = (lane >> 3) + 8 * j; const LAS float* s = scr + (8 * c) * 33 + n;
        v4u o; o.x = pk2(s[0 * 33], s[1 * 33]); o.y = pk2(s[2 * 33], s[3 * 33]); o.z = pk2(s[4 * 33], s[5 * 33]); o.w = pk2(s[6 * 33], s[7 * 33]);
        *(GAS v4u*)(WT + (size_t)(n0dst + n) * ldk + koff + k0 + 8 * c) = o; }
    LDS_WAIT(); asm volatile("" ::: "memory");
}
__device__ __forceinline__ void p0_prologue(Frame& F) {
    LAS float* scr = (LAS float*)(F.lds + RING_OFF + F.wave * 16384);
    const int gw = F.vcu * NWAVES + F.wave, NGW = F.G * NWAVES;
    bf16* WIN = (bf16*)(F.ws + WS_WIN); bf16* WAB = (bf16*)(F.ws + WS_WAB); bf16* WOUT = (bf16*)(F.ws + WS_WOUT); bf16* WUP = (bf16*)(F.ws + WS_WUP);
    bf16* WDN = (bf16*)(F.ws + WS_WDN); bf16* WGT = (bf16*)(F.ws + WS_WGT); bf16* WPL = (bf16*)(F.ws + WS_WPL);
    constexpr int I_IN = 16 * 176, I_A = 8 * 32, I_B = 8 * 32, I_O = 16 * 32, I_UP = 16 * 128, I_DN = 64 * 32, I_G = 16 * 32, I_P = 4 * 32;
    constexpr int NITEMS = I_IN + I_A + I_B + I_O + I_UP + I_DN + I_G + I_P;
    for (int it = gw; it < NITEMS; it += NGW) {
        int r = it;
        if (r < I_IN) { const int kb = r / 176, nb = r % 176; p0_transpose_item(F.in[11], DIN, WIN, D, 0, 64 * kb, 32 * nb, in_srccol(32 * nb), nullptr, scr, F.lane); continue; } r -= I_IN;
        if (r < I_A) { const int kb = r / 32, nb = r % 32; p0_transpose_item(F.in[19], D, WAB, D, 0, 64 * kb, 32 * nb, 32 * nb, nullptr, scr, F.lane); continue; } r -= I_A;
        if (r < I_B) { const int kb = r / 32, nb = r % 32; p0_transpose_item(F.in[20], D, WAB, D, 512, 64 * kb, 32 * nb, 32 * nb, nullptr, scr, F.lane); continue; } r -= I_B;
        if (r < I_O) { const int kb = r / 32, nb = r % 32; p0_transpose_item(F.in[21], D, WOUT, D, 0, 64 * kb, 32 * nb, 32 * nb, nullptr, scr, F.lane); continue; } r -= I_O;
        if (r < I_UP) { const int kb = r / 128, nb = r % 128; p0_transpose_item(F.in[23], DFF, WUP, D, 0, 64 * kb, 32 * nb, 32 * nb, F.in[22], scr, F.lane); continue; } r -= I_UP;
        if (r < I_DN) { const int kb = r / 32, nb = r % 32; p0_transpose_item(F.in[24], D, WDN, DFF, 0, 64 * kb, 32 * nb, 32 * nb, nullptr, scr, F.lane); continue; } r -= I_DN;
        if (r < I_G) { const int kb = r / 32, nb = r % 32; p0_transpose_item(F.in[26], D, WGT, D, 0, 64 * kb, 32 * nb, 32 * nb, F.in[25], scr, F.lane); continue; } r -= I_G;
        { const int kb = r / 32, nb = r % 32; p0_transpose_item(F.in[27], D, WPL, PLE, 0, 64 * kb, 32 * nb, 32 * nb, nullptr, scr, F.lane); }
    }
    { const int gt = F.vcu * (NWAVES * 64) + F.tid;
      if (gt < 16 * D) { const int r = gt / D, k = gt % D; const int col = r < 8 ? 1536 + r : (r < 12 ? 3080 + (r - 8) : 3084 + (r - 12));
          WIN[(size_t)(5632 + r) * D + k] = (bf16)f2bf(F.in[11][(size_t)k * DIN + col]); } }
    { bf16* XN = (bf16*)(F.ws + WS_XN); const GAS f32x4* gr = (const GAS f32x4*)F.in[10] + F.lane; f32x4 g[4];
#pragma unroll
      for (int j = 0; j < 4; ++j) g[j] = gr[64 * j];
      for (int m0 = gw; m0 < MT; m0 += 2 * NGW) {
          const int m1 = m0 + NGW; const bool two = m1 < MT;
          const float* x0 = m0 < MP ? F.in[0] + (size_t)m0 * D : F.in[1] + (size_t)(m0 - MP) * D;
          const float* x1 = !two ? x0 : (m1 < MP ? F.in[0] + (size_t)m1 * D : F.in[1] + (size_t)(m1 - MP) * D);
          const GAS f32x4* r0 = (const GAS f32x4*)x0 + F.lane; const GAS f32x4* r1 = (const GAS f32x4*)x1 + F.lane; f32x4 v0[4], v1[4]; float s0 = 0.f, s1 = 0.f;
#pragma unroll
          for (int j = 0; j < 4; ++j) { v0[j] = r0[64 * j]; v1[j] = r1[64 * j]; }
#pragma unroll
          for (int j = 0; j < 4; ++j) { s0 += (v0[j].x * v0[j].x + v0[j].y * v0[j].y) + (v0[j].z * v0[j].z + v0[j].w * v0[j].w); s1 += (v1[j].x * v1[j].x + v1[j].y * v1[j].y) + (v1[j].z * v1[j].z + v1[j].w * v1[j].w); }
          const float rs0 = __builtin_amdgcn_rsqf(wave_sum(s0) * (1.f / D) + EPS), rs1 = __builtin_amdgcn_rsqf(wave_sum(s1) * (1.f / D) + EPS);
          GAS unsigned long long* o0 = (GAS unsigned long long*)(XN + (size_t)m0 * D) + F.lane;
#pragma unroll
          for (int j = 0; j < 4; ++j) { const f32x4 y = v0[j] * rs0 * g[j]; o0[64 * j] = (unsigned long long)pk2(y.x, y.y) | ((unsigned long long)pk2(y.z, y.w) << 32); }
          if (two) { GAS unsigned long long* o1 = (GAS unsigned long long*)(XN + (size_t)m1 * D) + F.lane;
#pragma unroll
              for (int j = 0; j < 4; ++j) { const f32x4 y = v1[j] * rs1 * g[j]; o1[64 * j] = (unsigned long long)pk2(y.x, y.y) | ((unsigned long long)pk2(y.z, y.w) << 32); } }
      } }
    { bf16* PLB = (bf16*)(F.ws + WS_PLB);
      for (int m0 = gw; m0 < MT; m0 += 4 * NGW) { f32x4 v[4];
#pragma unroll
          for (int k = 0; k < 4; ++k) { const int m = m0 + k * NGW; if (m < MT) { const float* pr = m < MP ? F.in[2] + (size_t)m * PLE : F.in[3] + (size_t)(m - MP) * PLE; v[k] = *((const GAS f32x4*)pr + F.lane); } }
#pragma unroll
          for (int k = 0; k < 4; ++k) { const int m = m0 + k * NGW; if (m < MT) *((GAS unsigned long long*)(PLB + (size_t)m * PLE) + F.lane) = (unsigned long long)pk2(v[k].x, v[k].y) | ((unsigned long long)pk2(v[k].z, v[k].w) << 32); } } }
    { float* PT = (float*)(F.ws + WS_SFX);
      for (int u = gw; u < DB * NPAGES; u += NGW) { const int page = F.page_table[u]; const f32x4* src = (const f32x4*)(F.in[6] + (size_t)page * PAGE * FH) + F.lane * 4;
          const f32x4 a = src[0], b2 = src[1], c = src[2], d = src[3];
          f32x4 lo = a + c, hi = b2 + d;
#pragma unroll
          for (int o = 1; o < 64; o <<= 1) {
#pragma unroll
              for (int i = 0; i < 4; ++i) { lo[i] += __shfl_xor(lo[i], o); hi[i] += __shfl_xor(hi[i], o); } }
          if (F.lane == 0) { *(f32x4*)(PT + (size_t)u * FH) = lo; *(f32x4*)(PT + (size_t)u * FH + 4) = hi; } } }
}

constexpr float DC_T2 = 48.f;
constexpr int DP_STRIDE = 68;
#define DPPF(v, ctrl) __builtin_bit_cast(float, __builtin_amdgcn_update_dpp(0, __builtin_bit_cast(int, (v)), (ctrl), 0xf, 0xf, true))
__device__ __forceinline__ float red16(float v) { v += DPPF(v, 0xB1); v += DPPF(v, 0x4E); v += DPPF(v, 0x141); v += DPPF(v, 0x140); return v; }
__device__ __forceinline__ int wave_fetch(Frame& F, int qi, int lane) { unsigned v = 0; if (lane == 0) v = __hip_atomic_fetch_add((unsigned*)(F.ctl + CW_Q + 64 * qi), 1u, __ATOMIC_RELAXED, __HIP_MEMORY_SCOPE_AGENT); return (int)__builtin_amdgcn_readfirstlane(v); }
constexpr int DEC_XL_OFF = 110592, DEC_XL_WAVE = 640;
template <bool PF>
__device__ __forceinline__ void decode_unit(Frame& F, int unit, int h) {
    int tid_o = threadIdx.x; asm volatile("" : "+v"(tid_o));
    const int s = unit >> 6, pg = unit & 63, wv = __builtin_amdgcn_readfirstlane(tid_o >> 6), lane = tid_o & 63, dc = lane & 15, sub = lane >> 4;
    const bf16* QB = (const bf16*)(F.ws + WS_QB); const bf16* KB = (const bf16*)(F.ws + WS_KB); const float* LGF = (const float*)(F.ws + WS_LGF);
    const float* PT = (const float*)(F.ws + WS_SFX);
    const int page = F.page_table[s * NPAGES + pg];
    const float* kp = F.in[4] + (size_t)page * PAGE * FW + h * 64 + dc * 4; const float* vp = F.in[5] + (size_t)page * PAGE * FW + h * 64 + dc * 4;
    v2u qw[4], kw[4]; float lg[4];
#pragma unroll
    for (int j = 0; j < 4; ++j) { const size_t row = MP + s * 4 + j; qw[j] = *(const v2u*)(QB + row * FW + h * 64 + dc * 4); kw[j] = *(const v2u*)(KB + row * FW + h * 64 + dc * 4); lg[j] = LGF[row * 8 + h]; }
    const float pt = (lane > pg) ? PT[((size_t)s * NPAGES + lane) * FH + h] : 0.f;
    const float* lp = F.in[6] + (size_t)page * PAGE * FH + h; const float l0 = lp[(size_t)lane * FH], l1 = lp[(size_t)(64 + lane) * FH];
    f32x4 kx[32];
#pragma unroll
    for (int i = 0; i < 32; ++i) kx[i] = __builtin_nontemporal_load((const f32x4*)(kp + (size_t)(4 * i + sub) * FW));
    float tch[4] = {0.f, 0.f, 0.f, 0.f};
    if (PF) { const int pageN = F.page_table[s * NPAGES + pg + 1]; const float* kn = F.in[4] + (size_t)pageN * PAGE * FW + h * 64 + (lane & 3) * 16;
#pragma unroll
        for (int c = 0; c < 4; ++c) tch[c] = kn[(size_t)(16 * c + (lane >> 2)) * FW]; }
    float q[4][4], xself[4], cnew[4];
    { float run = 0.f;
#pragma unroll
      for (int j = 0; j < 4; ++j) {
          q[j][0] = bflo(qw[j].x); q[j][1] = bfhi(qw[j].x); q[j][2] = bflo(qw[j].y); q[j][3] = bfhi(qw[j].y);
          xself[j] = red16(q[j][0] * bflo(kw[j].x) + q[j][1] * bfhi(kw[j].x) + q[j][2] * bflo(kw[j].y) + q[j][3] * bfhi(kw[j].y));
          run += lg[j]; cnew[j] = run * LOG2E; } }
    LAS float* xl = (LAS float*)(F.lds + DEC_XL_OFF) + wv * DEC_XL_WAVE; LAS float* sfl = xl + 512;
    float pm[4] = {-INFINITY, -INFINITY, -INFINITY, -INFINITY};
    { const float off = wave_sum(pt);
      float s0 = l0, s1 = l1;
#pragma unroll
      for (int o = 1; o < 64; o <<= 1) { const float t0 = __shfl_down(s0, o), t1 = __shfl_down(s1, o); if (lane + o < 64) { s0 += t0; s1 += t1; } }
      const float tot1 = __shfl(s1, 0);
      sfl[64 + lane] = (off + s1 - l1) * LOG2E; sfl[lane] = (off + tot1 + s0 - l0) * LOG2E; }
    LDS_WAIT();
#pragma unroll
    for (int i = 0; i < 32; ++i) { float d[4]; const float sf = sfl[4 * i + sub];
#pragma unroll
        for (int j = 0; j < 4; ++j) { d[j] = red16(q[j][0] * kx[i][0] + q[j][1] * kx[i][1] + q[j][2] * kx[i][2] + q[j][3] * kx[i][3]) + sf + cnew[j]; pm[j] = fmaxf(pm[j], d[j]); }
        if (dc == 0) *(LAS f32x4*)(xl + (4 * i + sub) * 4) = (f32x4){d[0], d[1], d[2], d[3]}; }
    bool need = false;
#pragma unroll
    for (int j = 0; j < 4; ++j) { pm[j] = fmaxf(pm[j], __shfl_xor(pm[j], 16)); pm[j] = fmaxf(pm[j], __shfl_xor(pm[j], 32)); need = need || (pm[j] >= xself[j] - DC_T2); }
    float* dp = (float*)(F.ws + WS_DPART) + ((size_t)((s * FH + h) * NPAGES + pg) * 4) * DP_STRIDE;
    if (PF) asm volatile("" :: "v"(tch[0]), "v"(tch[1]), "v"(tch[2]), "v"(tch[3]));
    if (!need) { if (lane < 4) { dp[lane * DP_STRIDE] = -INFINITY; dp[lane * DP_STRIDE + 1] = 0.f; } return; }
    float o[4][4] = {}, l[4] = {0.f, 0.f, 0.f, 0.f};
    LDS_WAIT();
#pragma unroll 1
    for (int qt = 0; qt < 4; ++qt) {
        f32x4 vx[8];
#pragma unroll
        for (int i = 0; i < 8; ++i) { const int pos = 4 * (8 * qt + i) + sub; vx[i] = __builtin_nontemporal_load((const f32x4*)(vp + (size_t)pos * FW)); }
#pragma unroll
        for (int i = 0; i < 8; ++i) { const f32x4 xv = *(const LAS f32x4*)(xl + (4 * (8 * qt + i) + sub) * 4);
#pragma unroll
            for (int j = 0; j < 4; ++j) { const float p = __builtin_amdgcn_exp2f(xv[j] - pm[j]); l[j] += p;
                o[j][0] += p * vx[i][0]; o[j][1] += p * vx[i][1]; o[j][2] += p * vx[i][2]; o[j][3] += p * vx[i][3]; } }
    }
#pragma unroll
    for (int j = 0; j < 4; ++j) { l[j] += __shfl_xor(l[j], 16); l[j] += __shfl_xor(l[j], 32);
#pragma unroll
        for (int d = 0; d < 4; ++d) { o[j][d] += __shfl_xor(o[j][d], 16); o[j][d] += __shfl_xor(o[j][d], 32); }
        if (sub == 0) *(f32x4*)(dp + j * DP_STRIDE + 4 + dc * 4) = (f32x4){o[j][0], o[j][1], o[j][2], o[j][3]};
        if (lane == 0) { dp[j * DP_STRIDE] = pm[j]; dp[j * DP_STRIDE + 1] = l[j]; } }
}
__device__ __forceinline__ void decode_combine_row(Frame& F, int rowid) {
    const int s = rowid >> 5, h = (rowid >> 2) & 7, j = rowid & 3, lane = F.lane;
    const bf16* QB = (const bf16*)(F.ws + WS_QB); const float* LGF = (const float*)(F.ws + WS_LGF);
    const float* dp = (const float*)(F.ws + WS_DPART) + ((size_t)((s * FH + h) * NPAGES) * 4 + j) * DP_STRIDE;
    const size_t row = MP + s * 4 + j;
    const float qd = bf2f(QB[row * FW + h * 64 + lane]);
    float xn[4], cum[4]; { float run = 0.f;
#pragma unroll
      for (int i = 0; i < 4; ++i) { run += LGF[(MP + s * 4 + i) * 8 + h]; cum[i] = run * LOG2E; } }
    float m = -INFINITY;
#pragma unroll
    for (int i = 0; i < 4; ++i) { const float kd = F.out[OFF_KS + (size_t)(s * 4 + i) * FW + h * 64 + lane]; float d = wave_sum(qd * kd) + cum[j] - cum[i]; xn[i] = (i <= j) ? d : -INFINITY; m = fmaxf(m, xn[i]); }
    const float pmv = dp[(size_t)lane * 4 * DP_STRIDE], plv = dp[(size_t)lane * 4 * DP_STRIDE + 1];
    float mm = (plv > 0.f) ? pmv : -INFINITY;
#pragma unroll
    for (int o = 1; o < 64; o <<= 1) mm = fmaxf(mm, __shfl_xor(mm, o));
    m = fmaxf(m, mm);
    float acc = 0.f, l = 0.f;
#pragma unroll
    for (int i = 0; i < 4; ++i) { const float p = __builtin_amdgcn_exp2f(xn[i] - m); l += p; acc += p * F.out[OFF_VS + (size_t)(s * 4 + i) * FW + h * 64 + lane]; }
    for (int pg = 0; pg < NPAGES; ++pg) { const float pl = __shfl(plv, pg); if (pl > 0.f) { const float f = __builtin_amdgcn_exp2f(__shfl(pmv, pg) - m); l += pl * f; acc += f * dp[(size_t)pg * 4 * DP_STRIDE + 4 + lane]; } }
    ((bf16*)(F.ws + WS_OAB))[row * D + h * 64 + lane] = (bf16)f2bf(acc / l);
}
constexpr size_t GU_WF = 0, GU_QD = 16384, GU_KDT = 32768, GU_QKM = 49152, GU_U = 57344, GU_DEC = 90112, GU_BYTES = 90368;
static_assert(WS_GDN + (size_t)1024 * GU_BYTES <= WS_OG, "gdn ws");
constexpr int G1_QS = 0, G1_KS = 17408, G1_KB = 34816, G1_VB = 55296, G1_A = 75776, G1_T = 93184, G1_QK = 102400, G1_SC = 110592, G1_TF = 111616  , G1_WST = 0  ;
constexpr int G1_PQ = 272, G1_PX = 320, G1_PA = 272, G1_PT = 144;

__device__ __forceinline__ f32x16 mfma32(bf16x8 a, bf16x8 b, f32x16 c) { return __builtin_amdgcn_mfma_f32_32x32x16_bf16(a, b, c, 0, 0, 0); }
__device__ __forceinline__ int crow(int r, int hi) { return (r & 3) + 8 * (r >> 2) + 4 * hi; }
__device__ __forceinline__ s16x4 tr_read(unsigned lds_addr) { s16x4 r; asm volatile("ds_read_b64_tr_b16 %0, %1\n\ts_waitcnt lgkmcnt(0)" : "=&v"(r) : "v"(lds_addr) : "memory"); return r; }

template <int VAR>
__device__ __forceinline__ void gdn_prep_unit(Frame& F, int unit) {
    const int bh = unit >> 7, n = unit & 127, b = bh >> 2, h = bh & 3;
    int tid_o = threadIdx.x; asm volatile("" : "+v"(tid_o));
    const int tid = tid_o, lane = tid & 63, wave = __builtin_amdgcn_readfirstlane(tid >> 6);
    LAS unsigned char* L = F.lds + RING_OFF;
    LAS float* sc = (LAS float*)(L + G1_SC);
    const bf16* GQ = (const bf16*)(F.ws + WS_GQ); const float* GAB = (const float*)(F.ws + WS_GAB);
    const size_t row0 = (size_t)b * SEQ + (size_t)n * 64;
    unsigned char* gu = F.ws + WS_GDN + (size_t)unit * GU_BYTES;
    __syncthreads();
    if (wave == 0) {
        const float g = GAB[(row0 + lane) * 8 + h], be = GAB[(row0 + lane) * 8 + 4 + h];
        float c = g;
#pragma unroll
        for (int o = 1; o < 64; o <<= 1) { const float t = __shfl_up(c, o); if (lane >= o) c += t; }
        const float cl = __shfl(c, 63);
        sc[lane] = c; sc[64 + lane] = be; sc[128 + lane] = __expf(c); sc[192 + lane] = __expf(cl - c);
        if (lane == 0) *(float*)(gu + GU_DEC) = __expf(cl);
    } else if (tid < 64 + 384) {
        const int c = tid - 64, ch = (c >> 7) * 512 + h * 128 + (c & 127); const float* cw = F.in[15];
#pragma unroll
        for (int d = 0; d < 4; ++d) *(LAS float*)(L + G1_TF + (d * 384 + c) * 4) = cw[d * CCH + ch];
    }
    v4u xr[3][4][2];
    { const int i = tid >> 3, sg = tid & 7;
#pragma unroll
      for (int X = 0; X < 3; ++X)
#pragma unroll
        for (int d = 0; d < 4; ++d) { const int tok = n * 64 + i - 3 + d; const int cbase = X * 512 + h * 128 + sg * 16;
            if (tok >= 0) { xr[X][d][0] = *(const v4u*)(GQ + ((size_t)b * SEQ + tok) * CCH + cbase); xr[X][d][1] = *(const v4u*)(GQ + ((size_t)b * SEQ + tok) * CCH + cbase + 8); }
            else { xr[X][d][0] = (v4u){0u, 0u, 0u, 0u}; xr[X][d][1] = (v4u){0u, 0u, 0u, 0u}; } } }
    __syncthreads();
    {
        const int i = tid >> 3, sg = tid & 7;
        const float ecum = sc[128 + i], beta = sc[64 + i];
#pragma unroll
        for (int X = 0; X < 3; ++X) {
            float y[16];
#pragma unroll
            for (int c = 0; c < 16; ++c) y[c] = 0.f;
#pragma unroll
            for (int d = 0; d < 4; ++d) {
                const v4u x0 = xr[X][d][0], x1 = xr[X][d][1]; const LAS float* wl = (const LAS float*)(L + G1_TF) + d * 384 + X * 128 + sg * 16;
                const f32x4 w0 = *(const LAS f32x4*)(wl), w1 = *(const LAS f32x4*)(wl + 4), w2 = *(const LAS f32x4*)(wl + 8), w3 = *(const LAS f32x4*)(wl + 12);
                y[0] += w0[0] * bflo(x0.x); y[1] += w0[1] * bfhi(x0.x); y[2] += w0[2] * bflo(x0.y); y[3] += w0[3] * bfhi(x0.y);
                y[4] += w1[0] * bflo(x0.z); y[5] += w1[1] * bfhi(x0.z); y[6] += w1[2] * bflo(x0.w); y[7] += w1[3] * bfhi(x0.w);
                y[8] += w2[0] * bflo(x1.x); y[9] += w2[1] * bfhi(x1.x); y[10] += w2[2] * bflo(x1.y); y[11] += w2[3] * bfhi(x1.y);
                y[12] += w3[0] * bflo(x1.z); y[13] += w3[1] * bfhi(x1.z); y[14] += w3[2] * bflo(x1.w); y[15] += w3[3] * bfhi(x1.w);
            }
            float ss = 0.f;
#pragma unroll
            for (int c = 0; c < 16; ++c) { y[c] = y[c] * __builtin_amdgcn_rcpf(1.0f + __expf(-y[c])); ss += y[c] * y[c]; }
            if (X < 2) {
                ss += __shfl_xor(ss, 1); ss += __shfl_xor(ss, 2); ss += __shfl_xor(ss, 4);
                float rn = __builtin_amdgcn_rsqf(ss + EPS); if (X == 0) rn *= 0.08838834764831845f;
#pragma unroll
                for (int c = 0; c < 16; ++c) y[c] *= rn;
            }
            if (X == 0) {
                v4u a, c2; a.x = pk2(y[0], y[1]); a.y = pk2(y[2], y[3]); a.z = pk2(y[4], y[5]); a.w = pk2(y[6], y[7]); c2.x = pk2(y[8], y[9]); c2.y = pk2(y[10], y[11]); c2.z = pk2(y[12], y[13]); c2.w = pk2(y[14], y[15]);
                *(LAS v4u*)(L + G1_QS + i * G1_PQ + sg * 32) = a; *(LAS v4u*)(L + G1_QS + i * G1_PQ + sg * 32 + 16) = c2;
                v4u d0, d1; d0.x = pk2(y[0] * ecum, y[1] * ecum); d0.y = pk2(y[2] * ecum, y[3] * ecum); d0.z = pk2(y[4] * ecum, y[5] * ecum); d0.w = pk2(y[6] * ecum, y[7] * ecum);
                d1.x = pk2(y[8] * ecum, y[9] * ecum); d1.y = pk2(y[10] * ecum, y[11] * ecum); d1.z = pk2(y[12] * ecum, y[13] * ecum); d1.w = pk2(y[14] * ecum, y[15] * ecum);
                const int mt = i >> 4, fr = i & 15, s = sg >> 1, fq0 = (sg & 1) * 2;
                *(v4u*)(gu + GU_QD + ((size_t)((mt * 4 + s) * 64 + fq0 * 16 + fr)) * 16) = d0;
                *(v4u*)(gu + GU_QD + ((size_t)((mt * 4 + s) * 64 + (fq0 + 1) * 16 + fr)) * 16) = d1;
            } else if (X == 1) {
                v4u a, c2; a.x = pk2(y[0], y[1]); a.y = pk2(y[2], y[3]); a.z = pk2(y[4], y[5]); a.w = pk2(y[6], y[7]); c2.x = pk2(y[8], y[9]); c2.y = pk2(y[10], y[11]); c2.z = pk2(y[12], y[13]); c2.w = pk2(y[14], y[15]);
                *(LAS v4u*)(L + G1_KS + i * G1_PQ + sg * 32) = a; *(LAS v4u*)(L + G1_KS + i * G1_PQ + sg * 32 + 16) = c2;
                const float f = beta * ecum;
                a.x = pk2(y[0] * f, y[1] * f); a.y = pk2(y[2] * f, y[3] * f); a.z = pk2(y[4] * f, y[5] * f); a.w = pk2(y[6] * f, y[7] * f); c2.x = pk2(y[8] * f, y[9] * f); c2.y = pk2(y[10] * f, y[11] * f); c2.z = pk2(y[12] * f, y[13] * f); c2.w = pk2(y[14] * f, y[15] * f);
                *(LAS v4u*)(L + G1_KB + i * G1_PX + sg * 32) = a; *(LAS v4u*)(L + G1_KB + i * G1_PX + sg * 32 + 16) = c2;
            } else {
                v4u a, c2; a.x = pk2(y[0] * beta, y[1] * beta); a.y = pk2(y[2] * beta, y[3] * beta); a.z = pk2(y[4] * beta, y[5] * beta); a.w = pk2(y[6] * beta, y[7] * beta);
                c2.x = pk2(y[8] * beta, y[9] * beta); c2.y = pk2(y[10] * beta, y[11] * beta); c2.z = pk2(y[12] * beta, y[13] * beta); c2.w = pk2(y[14] * beta, y[15] * beta);
                *(LAS v4u*)(L + G1_VB + i * G1_PX + sg * 32) = a; *(LAS v4u*)(L + G1_VB + i * G1_PX + sg * 32 + 16) = c2;
            }
        }
    }
    __syncthreads();
    if (VAR == 2) return;
    {
        const int which = wave >> 2, ti = (wave >> 1) & 1, tj = wave & 1, r = lane & 31, hh = lane >> 5;
        const LAS unsigned char* Ap = L + (which ? G1_QS : G1_KS) + (32 * ti + r) * G1_PQ + hh * 16;
        const LAS unsigned char* Bp = L + G1_KS + (32 * tj + r) * G1_PQ + hh * 16;
        f32x16 acc = {};
#pragma unroll
        for (int s = 0; s < 8; ++s) acc = mfma32(*(const LAS bf16x8*)(Ap + s * 32), *(const LAS bf16x8*)(Bp + s * 32), acc);
        const int j = 32 * tj + r; const float cj = sc[j];
        if (which == 0) {
#pragma unroll
            for (int reg = 0; reg < 16; ++reg) { const int i = 32 * ti + crow(reg, hh); const float v = (i > j) ? sc[64 + i] * acc[reg] * __expf(sc[i] - cj) : 0.f;
                *(LAS float*)(L + G1_A + i * G1_PA + j * 4) = v; }
        } else {
#pragma unroll
            for (int reg = 0; reg < 16; ++reg) { const int i = 32 * ti + crow(reg, hh); const float v = (i >= j) ? acc[reg] * __expf(sc[i] - cj) : 0.f;
                *(LAS unsigned short*)(L + G1_QK + i * 128 + j * 2) = (unsigned short)f2bf(v); }
        }
    }
    __syncthreads();
    if (wave == 0 && VAR != 1) {
        const int bk = lane >> 4, c = lane & 15; float t[16];
#pragma unroll
        for (int i = 0; i < 16; ++i) {
            float a = (c == i) ? 1.f : 0.f;
#pragma unroll
            for (int j4 = 0; j4 < (i + 3) / 4; ++j4) { const f32x4 av = *(const LAS f32x4*)(L + G1_A + (16 * bk + i) * G1_PA + (16 * bk + 4 * j4) * 4);
#pragma unroll
                for (int q = 0; q < 4; ++q) { const int j = 4 * j4 + q; if (j < i) a -= av[q] * t[j]; } }
            t[i] = a;
            *(LAS float*)(L + G1_TF + (16 * bk + i) * G1_PA + (16 * bk + c) * 4) = a;
        }
    } else if (wave != 0) {
        const int t7 = tid - 64;
        for (int e = t7; e < 6 * 256; e += 448) { const int bq = e >> 8, w = e & 255; const int br = bq < 3 ? 0 : (bq < 5 ? 1 : 2), bc = bq < 3 ? bq + 1 : (bq < 5 ? bq - 1 : 3);
            *(LAS float*)(L + G1_TF + (16 * br + (w >> 4)) * G1_PA + (16 * bc + (w & 15)) * 4) = 0.f; }
        for (int e = t7; e < 512; e += 448) {
            const int i = e >> 3, j0 = (e & 7) * 8; const v4u v = *(const LAS v4u*)(L + G1_QK + i * 128 + j0 * 2);
            const int mt = i >> 4, fr = i & 15, s = j0 >> 5, fq = (j0 & 31) >> 3;
            *(v4u*)(gu + GU_QKM + (size_t)((mt * 2 + s) * 64 + fq * 16 + fr) * 16) = v; }
        for (int e = t7; e < 1024; e += 448) {
            const int dk = e & 127, i0 = (e >> 7) * 8; unsigned short v[8];
#pragma unroll
            for (int q = 0; q < 8; ++q) v[q] = (unsigned short)f2bf(bf2f(*(const LAS unsigned short*)(L + G1_KS + (i0 + q) * G1_PQ + dk * 2)) * sc[192 + i0 + q]);
            v4u o; o.x = v[0] | ((unsigned)v[1] << 16); o.y = v[2] | ((unsigned)v[3] << 16); o.z = v[4] | ((unsigned)v[5] << 16); o.w = v[6] | ((unsigned)v[7] << 16);
            const int mt = dk >> 4, fr = dk & 15, s = i0 >> 5, fq = (i0 & 31) >> 3;
            *(v4u*)(gu + GU_KDT + (size_t)((mt * 2 + s) * 64 + fq * 16 + fr) * 16) = o; }
    }
    __syncthreads();
    if (VAR != 1) {
        const int i16 = lane & 15, kk = lane >> 4;
        if (wave < 2) {
            const int r0 = 32 * wave; f32x4s x = {0.f, 0.f, 0.f, 0.f}, y = {0.f, 0.f, 0.f, 0.f};
#pragma unroll
            for (int s4 = 0; s4 < 4; ++s4) x = __builtin_amdgcn_mfma_f32_16x16x4f32(*(const LAS float*)(L + G1_A + (r0 + 16 + i16) * G1_PA + (r0 + 4 * s4 + kk) * 4),
                                                                                     *(const LAS float*)(L + G1_TF + (r0 + 4 * s4 + kk) * G1_PA + (r0 + i16) * 4), x, 0, 0, 0);
#pragma unroll
            for (int s4 = 0; s4 < 4; ++s4) y = __builtin_amdgcn_mfma_f32_16x16x4f32(*(const LAS float*)(L + G1_TF + (r0 + 16 + i16) * G1_PA + (r0 + 16 + 4 * kk + s4) * 4), x[s4], y, 0, 0, 0);
#pragma unroll
            for (int r = 0; r < 4; ++r) *(LAS float*)(L + G1_TF + (r0 + 16 + 4 * kk + r) * G1_PA + (r0 + i16) * 4) = -y[r];
        }
    }
    __syncthreads();
    if (VAR != 1) {
        const int i16 = lane & 15, kk = lane >> 4;
        if (wave < 4) {
            const int ti = wave >> 1, tj = wave & 1; f32x4s y0 = {0.f, 0.f, 0.f, 0.f}, y1 = {0.f, 0.f, 0.f, 0.f}, z = {0.f, 0.f, 0.f, 0.f};
#pragma unroll
            for (int s8 = 0; s8 < 8; ++s8) { const float bq = *(const LAS float*)(L + G1_TF + (4 * s8 + kk) * G1_PA + (16 * tj + i16) * 4);
                y0 = __builtin_amdgcn_mfma_f32_16x16x4f32(*(const LAS float*)(L + G1_A + (32 + i16) * G1_PA + (4 * s8 + kk) * 4), bq, y0, 0, 0, 0);
                y1 = __builtin_amdgcn_mfma_f32_16x16x4f32(*(const LAS float*)(L + G1_A + (48 + i16) * G1_PA + (4 * s8 + kk) * 4), bq, y1, 0, 0, 0); }
#pragma unroll
            for (int s4 = 0; s4 < 4; ++s4) z = __builtin_amdgcn_mfma_f32_16x16x4f32(*(const LAS float*)(L + G1_TF + (32 + 16 * ti + i16) * G1_PA + (32 + 4 * kk + s4) * 4), y0[s4], z, 0, 0, 0);
#pragma unroll
            for (int s4 = 0; s4 < 4; ++s4) z = __builtin_amdgcn_mfma_f32_16x16x4f32(*(const LAS float*)(L + G1_TF + (32 + 16 * ti + i16) * G1_PA + (48 + 4 * kk + s4) * 4), y1[s4], z, 0, 0, 0);
#pragma unroll
            for (int r = 0; r < 4; ++r) *(LAS float*)(L + G1_TF + (32 + 16 * ti + 4 * kk + r) * G1_PA + (16 * tj + i16) * 4) = -z[r];
        }
    }
    __syncthreads();
    { const int i = tid >> 3, c0 = (tid & 7) * 8;
      const f32x4 a = *(const LAS f32x4*)(L + G1_TF + i * G1_PA + c0 * 4), c = *(const LAS f32x4*)(L + G1_TF + i * G1_PA + c0 * 4 + 16);
      v4u o; o.x = pk2(a[0], a[1]); o.y = pk2(a[2], a[3]); o.z = pk2(c[0], c[1]); o.w = pk2(c[2], c[3]); *(LAS v4u*)(L + G1_T + i * G1_PT + c0 * 2) = o; }
    __syncthreads();
    {
        const int ti = wave >> 2, cb = wave & 3, r = lane & 31, hh = lane >> 5;
        const unsigned lbase = (unsigned)(uintptr_t)L;
        const int q = (lane & 15) >> 2, p = lane & 3, blk = (lane >> 4) & 1;
        f32x16 au = {}, aw = {};
        const unsigned rv = lbase + G1_VB + (unsigned)((8 * hh + q) * G1_PX + (32 * cb + 16 * blk + 4 * p) * 2), rk = rv + (G1_KB - G1_VB);
        s16x4 xv[8], xk[8];
#define G1_TR8(dst, base) asm volatile("ds_read_b64_tr_b16 %0, %8 offset:%c9\n\tds_read_b64_tr_b16 %1, %8 offset:%c10\n\tds_read_b64_tr_b16 %2, %8 offset:%c11\n\tds_read_b64_tr_b16 %3, %8 offset:%c12\n\t" \
            "ds_read_b64_tr_b16 %4, %8 offset:%c13\n\tds_read_b64_tr_b16 %5, %8 offset:%c14\n\tds_read_b64_tr_b16 %6, %8 offset:%c15\n\tds_read_b64_tr_b16 %7, %8 offset:%c16\n\ts_waitcnt lgkmcnt(0)" \
            : "=&v"(dst[0]), "=&v"(dst[1]), "=&v"(dst[2]), "=&v"(dst[3]), "=&v"(dst[4]), "=&v"(dst[5]), "=&v"(dst[6]), "=&v"(dst[7]) \
            : "v"(base), "i"(0), "i"(4 * G1_PX), "i"(16 * G1_PX), "i"(20 * G1_PX), "i"(32 * G1_PX), "i"(36 * G1_PX), "i"(48 * G1_PX), "i"(52 * G1_PX) : "memory")
        G1_TR8(xv, rv); G1_TR8(xk, rk);
#undef G1_TR8
#pragma unroll
        for (int s = 0; s < 4; ++s) {
            const bf16x8 ta = *(const LAS bf16x8*)(L + G1_T + (32 * ti + r) * G1_PT + (16 * s + 8 * hh) * 2);
            au = mfma32(ta, __builtin_shufflevector(xv[2 * s], xv[2 * s + 1], 0, 1, 2, 3, 4, 5, 6, 7), au);
            aw = mfma32(ta, __builtin_shufflevector(xk[2 * s], xk[2 * s + 1], 0, 1, 2, 3, 4, 5, 6, 7), aw);
        }
        const int c = 32 * cb + r, nt = c >> 4, fr = c & 15;
#pragma unroll
        for (int g = 0; g < 4; ++g) { const int rowb = 32 * ti + 8 * g + 4 * hh, mt = rowb >> 4, fq = (rowb & 15) >> 2;
            *(f32x4*)(gu + GU_U + (size_t)(((mt * 8 + nt) * 64) + fq * 16 + fr) * 16) = (f32x4){au[4 * g], au[4 * g + 1], au[4 * g + 2], au[4 * g + 3]}; }
        __syncthreads();
#pragma unroll
        for (int reg = 0; reg < 16; ++reg) { const int i = 32 * ti + crow(reg, hh); *(LAS unsigned short*)(L + G1_WST + i * 256 + c * 2) = (unsigned short)f2bf(aw[reg]); }
    }
    __syncthreads();
    for (int e = tid; e < 1024; e += 512) {
        const int i = e >> 4, dk0 = (e & 15) * 8; const v4u v = *(const LAS v4u*)(L + G1_WST + i * 256 + dk0 * 2);
        const int mt = i >> 4, fr = i & 15, s = dk0 >> 5, fq = (dk0 & 31) >> 3;
        *(v4u*)(gu + GU_WF + (size_t)((mt * 4 + s) * 64 + fq * 16 + fr) * 16) = v; }
}
constexpr int SC_SB = 0, SC_VN = 32 * 272, SC_AO = SC_VN + 32 * 144, SC_PS = 272, SC_PV = 144;
__device__ __forceinline__ f32x4s mfma16(bf16x8 a, bf16x8 b, f32x4s c) { return __builtin_amdgcn_mfma_f32_16x16x32_bf16(a, b, c, 0, 0, 0); }
struct ScanB { bf16x8 wf[4], qd[4]; f32x4s u[2]; };
struct ScanE { bf16x8 qk[2], kd[2][2]; float dec; };
__device__ __forceinline__ void scan_loadB(ScanB& f, const unsigned char* gu, int mp, int cq, int lane) {
#pragma unroll
    for (int s = 0; s < 4; ++s) { f.wf[s] = *(const bf16x8*)(gu + GU_WF + (size_t)((mp * 4 + s) * 64 + lane) * 16); f.qd[s] = *(const bf16x8*)(gu + GU_QD + (size_t)((mp * 4 + s) * 64 + lane) * 16); }
#pragma unroll
    for (int nt = 0; nt < 2; ++nt) f.u[nt] = *(const f32x4s*)(gu + GU_U + (size_t)(((mp * 8 + 2 * cq + nt) * 64) + lane) * 16);
}
__device__ __forceinline__ void scan_loadE(ScanE& f, const unsigned char* gu, int mp, int lane) {
#pragma unroll
    for (int s = 0; s < 2; ++s) { f.qk[s] = *(const bf16x8*)(gu + GU_QKM + (size_t)((mp * 2 + s) * 64 + lane) * 16);
        f.kd[0][s] = *(const bf16x8*)(gu + GU_KDT + (size_t)(((2 * mp) * 2 + s) * 64 + lane) * 16); f.kd[1][s] = *(const bf16x8*)(gu + GU_KDT + (size_t)(((2 * mp + 1) * 2 + s) * 64 + lane) * 16); }
    f.dec = *(const float*)(gu + GU_DEC);
}
__device__ __forceinline__ void scan_stepB(const ScanB& f, LAS unsigned char* L, int mp, int lane, int fr, int fq) {
    f32x4s av[2] = {{0.f, 0.f, 0.f, 0.f}, {0.f, 0.f, 0.f, 0.f}}, ao[2] = {{0.f, 0.f, 0.f, 0.f}, {0.f, 0.f, 0.f, 0.f}};
#pragma unroll
    for (int s = 0; s < 4; ++s)
#pragma unroll
        for (int nt = 0; nt < 2; ++nt) { const bf16x8 sb = *(const LAS bf16x8*)(L + SC_SB + (16 * nt + fr) * SC_PS + (32 * s + 8 * fq) * 2); av[nt] = mfma16(f.wf[s], sb, av[nt]); ao[nt] = mfma16(f.qd[s], sb, ao[nt]); }
#pragma unroll
    for (int nt = 0; nt < 2; ++nt) { const f32x4s vn = f.u[nt] - av[nt]; v2u w; w.x = pk2(vn[0], vn[1]); w.y = pk2(vn[2], vn[3]);
        *(LAS v2u*)(L + SC_VN + (16 * nt + fr) * SC_PV + (16 * mp + 4 * fq) * 2) = w; *(LAS f32x4s*)(L + SC_AO + ((mp * 2 + nt) * 64 + lane) * 16) = ao[nt]; }
    __syncthreads();
    __syncthreads();
}
__device__ __forceinline__ void scan_stepE(const ScanE& f, f32x4s (&S)[2][2], LAS unsigned char* L, float* og, int mp, int lane, int fr, int fq, unsigned* prog, unsigned stepno) {
    __syncthreads();
    bf16x8 vb[2][2];
#pragma unroll
    for (int nt = 0; nt < 2; ++nt)
#pragma unroll
        for (int s = 0; s < 2; ++s) vb[nt][s] = *(const LAS bf16x8*)(L + SC_VN + (16 * nt + fr) * SC_PV + (32 * s + 8 * fq) * 2);
#pragma unroll
    for (int nt = 0; nt < 2; ++nt) { f32x4s o = *(const LAS f32x4s*)(L + SC_AO + ((mp * 2 + nt) * 64 + lane) * 16);
#pragma unroll
        for (int s = 0; s < 2; ++s) o = mfma16(f.qk[s], vb[nt][s], o);
#pragma unroll
        for (int i = 0; i < 4; ++i) og[(size_t)(16 * mp + 4 * fq + i) * 512 + 16 * nt + fr] = o[i]; }
#pragma unroll
    for (int t = 0; t < 2; ++t)
#pragma unroll
        for (int nt = 0; nt < 2; ++nt) { S[t][nt] = S[t][nt] * f.dec;
#pragma unroll
            for (int s = 0; s < 2; ++s) S[t][nt] = mfma16(f.kd[t][s], vb[nt][s], S[t][nt]);
            v2u w; w.x = pk2(S[t][nt][0], S[t][nt][1]); w.y = pk2(S[t][nt][2], S[t][nt][3]); *(LAS v2u*)(L + SC_SB + (16 * nt + fr) * SC_PS + (16 * (2 * mp + t) + 4 * fq) * 2) = w; }
    if (prog && lane == 0) __hip_atomic_store(prog, stepno, __ATOMIC_RELAXED, __HIP_MEMORY_SCOPE_AGENT);
    __syncthreads();
}
template <int VAR>
__device__ __forceinline__ void gdn_scan_unit(Frame& F, int unit) {
    const int bh = unit >> 2, cq = unit & 3, b = bh >> 2, h = bh & 3;
    int tid_o = threadIdx.x; asm volatile("" : "+v"(tid_o));
    const int lane = tid_o & 63, wave = __builtin_amdgcn_readfirstlane(tid_o >> 6), mp = wave & 3, fr = lane & 15, fq = lane >> 4;
    LAS unsigned char* L = F.lds + RING_OFF;
    __syncthreads();
    for (int e = tid_o; e < (32 * 272) / 4; e += NWAVES * 64) ((LAS unsigned*)(L + SC_SB))[e] = 0u;
    __syncthreads();
    const unsigned char* gu0 = F.ws + WS_GDN + (size_t)(bh * 128) * GU_BYTES;
    if (wave < 4) {
        ScanB f0, f1, f2, f3;
        scan_loadB(f0, gu0, mp, cq, lane); scan_loadB(f1, gu0 + GU_BYTES, mp, cq, lane); scan_loadB(f2, gu0 + 2 * GU_BYTES, mp, cq, lane);
        for (int n = 0; n < 128; n += 4) {
            if (VAR != 1) scan_loadB(f3, gu0 + (size_t)(n + 3) * GU_BYTES, mp, cq, lane); if (VAR != 2) scan_stepB(f0, L, mp, lane, fr, fq); else asm volatile("" :: "v"(f0.wf[0]), "v"(f0.qd[3]), "v"(f0.u[1]));
            if (VAR != 1 && n + 4 < 128) scan_loadB(f0, gu0 + (size_t)(n + 4) * GU_BYTES, mp, cq, lane); if (VAR != 2) scan_stepB(VAR == 1 ? f0 : f1, L, mp, lane, fr, fq); else asm volatile("" :: "v"(f1.wf[0]), "v"(f1.qd[3]), "v"(f1.u[1]));
            if (VAR != 1 && n + 5 < 128) scan_loadB(f1, gu0 + (size_t)(n + 5) * GU_BYTES, mp, cq, lane); if (VAR != 2) scan_stepB(VAR == 1 ? f0 : f2, L, mp, lane, fr, fq); else asm volatile("" :: "v"(f2.wf[0]), "v"(f2.qd[3]), "v"(f2.u[1]));
            if (VAR != 1 && n + 6 < 128) scan_loadB(f2, gu0 + (size_t)(n + 6) * GU_BYTES, mp, cq, lane); if (VAR != 2) scan_stepB(VAR == 1 ? f0 : f3, L, mp, lane, fr, fq); else asm volatile("" :: "v"(f3.wf[0]), "v"(f3.qd[3]), "v"(f3.u[1]));
        }
    } else {
        f32x4s S[2][2] = {{{0.f, 0.f, 0.f, 0.f}, {0.f, 0.f, 0.f, 0.f}}, {{0.f, 0.f, 0.f, 0.f}, {0.f, 0.f, 0.f, 0.f}}};
        float* og0 = (float*)(F.ws + WS_OG) + (size_t)b * SEQ * 512 + h * 128 + 32 * cq;
        unsigned* prog = nullptr;
        ScanE f0, f1, f2, f3;
        scan_loadE(f0, gu0, mp, lane); scan_loadE(f1, gu0 + GU_BYTES, mp, lane); scan_loadE(f2, gu0 + 2 * GU_BYTES, mp, lane);
        for (int n = 0; n < 128; n += 4) {
            if (VAR != 1) scan_loadE(f3, gu0 + (size_t)(n + 3) * GU_BYTES, mp, lane); if (VAR != 2) scan_stepE(f0, S, L, og0 + (size_t)n * 64 * 512, mp, lane, fr, fq, prog, (unsigned)(n + 1)); else asm volatile("" :: "v"(f0.qk[0]), "v"(f0.kd[1][1]));
            if (VAR != 1 && n + 4 < 128) scan_loadE(f0, gu0 + (size_t)(n + 4) * GU_BYTES, mp, lane); if (VAR != 2) scan_stepE(VAR == 1 ? f0 : f1, S, L, og0 + (size_t)(n + 1) * 64 * 512, mp, lane, fr, fq, prog, (unsigned)(n + 2)); else asm volatile("" :: "v"(f1.qk[0]), "v"(f1.kd[1][1]));
            if (VAR != 1 && n + 5 < 128) scan_loadE(f1, gu0 + (size_t)(n + 5) * GU_BYTES, mp, lane); if (VAR != 2) scan_stepE(VAR == 1 ? f0 : f2, S, L, og0 + (size_t)(n + 2) * 64 * 512, mp, lane, fr, fq, prog, (unsigned)(n + 3)); else asm volatile("" :: "v"(f2.qk[0]), "v"(f2.kd[1][1]));
            if (VAR != 1 && n + 6 < 128) scan_loadE(f2, gu0 + (size_t)(n + 6) * GU_BYTES, mp, lane); if (VAR != 2) scan_stepE(VAR == 1 ? f0 : f3, S, L, og0 + (size_t)(n + 3) * 64 * 512, mp, lane, fr, fq, prog, (unsigned)(n + 4)); else asm volatile("" :: "v"(f3.qk[0]), "v"(f3.kd[1][1]));
        }
        float* so = F.out + OFF_SSP + ((size_t)bh * 128) * 128 + 32 * cq + fr;
#pragma unroll
        for (int t = 0; t < 2; ++t)
#pragma unroll
            for (int nt = 0; nt < 2; ++nt)
#pragma unroll
                for (int i = 0; i < 4; ++i) so[(size_t)(16 * (2 * mp + t) + 4 * fq + i) * 128 + 16 * nt] = S[t][nt][i];
    }
}

constexpr int AT_KP = 144, AT_VP = 192;
constexpr int AT_K0 = 0, AT_V0 = 2 * 64 * AT_KP, AT_CS = AT_V0 + 2 * 64 * AT_VP, AT_WS = AT_CS + 2 * 256, AT_RED = AT_WS + 8 * 256, AT_TOT = AT_RED + 32, AT_CQ = AT_RED + 64;
constexpr float AT_T2 = 48.f, AT_THR = 8.f;
__device__ __forceinline__ float rowmax32(const f32x16& p0, const f32x16& p1) {
    float a = fmaxf(fmaxf(p0[0], p0[1]), p1[0]), b2 = fmaxf(fmaxf(p0[2], p0[3]), p1[1]); a = fmaxf(fmaxf(a, p1[2]), p1[3]);
#pragma unroll
    for (int r = 4; r < 16; r += 4) { a = fmaxf(fmaxf(a, p0[r]), p0[r + 1]); b2 = fmaxf(fmaxf(b2, p0[r + 2]), p0[r + 3]); a = fmaxf(fmaxf(a, p1[r]), p1[r + 1]); b2 = fmaxf(fmaxf(b2, p1[r + 2]), p1[r + 3]); }
    const float m = fmaxf(a, b2);
    return fmaxf(m, __shfl_xor(m, 32));
}
__device__ __forceinline__ bf16x8 pack_frag(const f32x16& x, int s) {
    v4u p; p.x = pk2(x[8 * s], x[8 * s + 1]); p.y = pk2(x[8 * s + 2], x[8 * s + 3]); p.z = pk2(x[8 * s + 4], x[8 * s + 5]); p.w = pk2(x[8 * s + 6], x[8 * s + 7]);
    return __builtin_bit_cast(bf16x8, p);
}
__device__ __forceinline__ void attn_unit(Frame& F, int unit, float qkb) {
    const int b = unit >> 8, h = (unit >> 5) & 7, qb = unit & 31;
    int tid_o = threadIdx.x; asm volatile("" : "+v"(tid_o));
    const int tid = tid_o, lane = tid & 63, wave = __builtin_amdgcn_readfirstlane(tid >> 6), r = lane & 31, hh = lane >> 5;
    LAS unsigned char* L = F.lds + RING_OFF;
    const bf16* QB = (const bf16*)(F.ws + WS_QB); const bf16* KB = (const bf16*)(F.ws + WS_KB); const bf16* VB = (const bf16*)(F.ws + WS_VB);
    const float* CUM = (const float*)(F.ws + WS_CUM);
    bf16* OAB = (bf16*)(F.ws + WS_OAB);
    const size_t rowb = (size_t)b * SEQ; const int q0 = qb * 256, qrow = q0 + 32 * wave + r;
    LAS float* wsf = (LAS float*)(L + AT_WS) + wave * 64; LAS float* red = (LAS float*)(L + AT_RED);
    bf16x8 qr[4];
#pragma unroll
    for (int s = 0; s < 4; ++s) qr[s] = *(const bf16x8*)(QB + (rowb + qrow) * FW + h * 64 + 16 * s + 8 * hh);
    const float cq = CUM[(rowb + qrow) * 8 + h];
    float aq = cq;
    float l_run = 0.f; f32x16 o0 = {}, o1 = {};
    const int tdiag = (q0 + 255) >> 6;
    const int srow = tid >> 3, sch = tid & 7;
    __syncthreads();
    v4u kreg = *(const v4u*)(KB + (rowb + 64 * tdiag + srow) * FW + h * 64 + sch * 8), vreg = *(const v4u*)(VB + (rowb + 64 * tdiag + srow) * FW + h * 64 + sch * 8);
    float creg = (tid < 64) ? CUM[(rowb + 64 * tdiag + tid) * 8 + h] : 0.f;
    *(LAS v4u*)(L + AT_K0 + srow * AT_KP + sch * 16) = kreg; *(LAS v4u*)(L + AT_V0 + srow * AT_VP + sch * 16) = vreg; if (tid < 64) *(LAS float*)(L + AT_CS + tid * 4) = creg;
    __syncthreads();
    const unsigned lbase = (unsigned)(uintptr_t)L;
    const int tq = (lane & 15) >> 2, tp = lane & 3, tblk = (lane >> 4) & 1;
    float G = 0.f; bool first = true; int buf = 0;
    for (int t = tdiag; t >= 0; --t) {
        if (t == tdiag - 4) {
            float a = aq;
#pragma unroll
            for (int o = 1; o < 64; o <<= 1) a = fmaxf(a, __shfl_xor(a, o));
            if (lane == 0) red[wave] = a;
            __syncthreads();
            G = fmaxf(fmaxf(fmaxf(red[0], red[1]), fmaxf(red[2], red[3])), fmaxf(fmaxf(red[4], red[5]), fmaxf(red[6], red[7])));
        }
        if (t <= tdiag - 4) { const float cl = *(const LAS float*)(L + AT_CS + buf * 256 + 63 * 4); if (qkb + G - cl < -AT_T2) break; }
        const bool more = (t > 0);
        if (more) { kreg = *(const v4u*)(KB + (rowb + 64 * (t - 1) + srow) * FW + h * 64 + sch * 8); vreg = *(const v4u*)(VB + (rowb + 64 * (t - 1) + srow) * FW + h * 64 + sch * 8);
            creg = (tid < 64) ? CUM[(rowb + 64 * (t - 1) + tid) * 8 + h] : 0.f; }
        const LAS unsigned char* Kt = L + AT_K0 + buf * (64 * AT_KP); const unsigned Vt = lbase + AT_V0 + buf * (64 * AT_VP); const LAS float* cs = (const LAS float*)(L + AT_CS + buf * 256);
        if (64 * t <= q0 + 32 * wave + 31) {
            f32x16 p0, p1;
#pragma unroll
            for (int g = 0; g < 4; ++g) { const f32x4 c0 = *(const LAS f32x4*)(cs + 8 * g + 4 * hh), c1 = *(const LAS f32x4*)(cs + 32 + 8 * g + 4 * hh);
#pragma unroll
                for (int i = 0; i < 4; ++i) { p0[4 * g + i] = aq - c0[i]; p1[4 * g + i] = aq - c1[i]; } }
#pragma unroll
            for (int s = 0; s < 4; ++s) { const bf16x8 k0 = *(const LAS bf16x8*)(Kt + r * AT_KP + (16 * s + 8 * hh) * 2), k1 = *(const LAS bf16x8*)(Kt + (32 + r) * AT_KP + (16 * s + 8 * hh) * 2);
                p0 = mfma32(k0, qr[s], p0); p1 = mfma32(k1, qr[s], p1); }
            if (64 * t + 63 > q0 + 32 * wave) {
#pragma unroll
                for (int reg = 0; reg < 16; ++reg) { const int kv = 64 * t + crow(reg, hh); if (kv > qrow) p0[reg] = -INFINITY; if (kv + 32 > qrow) p1[reg] = -INFINITY; }
            }
            const float rm = rowmax32(p0, p1);
            if (first) {
                aq -= rm;
#pragma unroll
                for (int reg = 0; reg < 16; ++reg) { p0[reg] -= rm; p1[reg] -= rm; }
                first = false;
            } else if (__any(rm > AT_THR)) {
                const float dl = fmaxf(rm, 0.f); aq -= dl; const float f = __builtin_amdgcn_exp2f(-dl); l_run *= f;
#pragma unroll
                for (int reg = 0; reg < 16; ++reg) { p0[reg] -= dl; p1[reg] -= dl; }
                if (hh == 0) wsf[r] = f;
                LDS_WAIT();
#pragma unroll
                for (int g = 0; g < 4; ++g) { const f32x4 fv = *(const LAS f32x4*)(wsf + 8 * g + 4 * hh);
#pragma unroll
                    for (int i = 0; i < 4; ++i) { o0[4 * g + i] *= fv[i]; o1[4 * g + i] *= fv[i]; } }
            }
            float rs = 0.f;
#pragma unroll
            for (int reg = 0; reg < 16; ++reg) { p0[reg] = __builtin_amdgcn_exp2f(p0[reg]); p1[reg] = __builtin_amdgcn_exp2f(p1[reg]); rs += p0[reg] + p1[reg]; }
            l_run += rs;
#pragma unroll
            for (int blk = 0; blk < 2; ++blk) {
                const unsigned ad = Vt + (unsigned)((32 * blk + 4 * hh + tq) * AT_VP + (16 * tblk + 4 * tp) * 2);
                s16x4 v[8];
                asm volatile("ds_read_b64_tr_b16 %0, %8 offset:%c9\n\tds_read_b64_tr_b16 %1, %8 offset:%c10\n\tds_read_b64_tr_b16 %2, %8 offset:%c11\n\tds_read_b64_tr_b16 %3, %8 offset:%c12\n\t"
                             "ds_read_b64_tr_b16 %4, %8 offset:%c13\n\tds_read_b64_tr_b16 %5, %8 offset:%c14\n\tds_read_b64_tr_b16 %6, %8 offset:%c15\n\tds_read_b64_tr_b16 %7, %8 offset:%c16\n\ts_waitcnt lgkmcnt(0)"
                             : "=&v"(v[0]), "=&v"(v[1]), "=&v"(v[2]), "=&v"(v[3]), "=&v"(v[4]), "=&v"(v[5]), "=&v"(v[6]), "=&v"(v[7])
                             : "v"(ad), "i"(0), "i"(8 * AT_VP), "i"(64), "i"(8 * AT_VP + 64), "i"(16 * AT_VP), "i"(24 * AT_VP), "i"(16 * AT_VP + 64), "i"(24 * AT_VP + 64) : "memory");
                const bf16x8 pa0 = pack_frag(blk ? p1 : p0, 0), pa1 = pack_frag(blk ? p1 : p0, 1);
                o0 = mfma32(pa0, __builtin_shufflevector(v[0], v[1], 0, 1, 2, 3, 4, 5, 6, 7), o0);
                o1 = mfma32(pa0, __builtin_shufflevector(v[2], v[3], 0, 1, 2, 3, 4, 5, 6, 7), o1);
                o0 = mfma32(pa1, __builtin_shufflevector(v[4], v[5], 0, 1, 2, 3, 4, 5, 6, 7), o0);
                o1 = mfma32(pa1, __builtin_shufflevector(v[6], v[7], 0, 1, 2, 3, 4, 5, 6, 7), o1);
            }
        }
        if (more) { const int nb = buf ^ 1; *(LAS v4u*)(L + AT_K0 + nb * (64 * AT_KP) + srow * AT_KP + sch * 16) = kreg; *(LAS v4u*)(L + AT_V0 + nb * (64 * AT_VP) + srow * AT_VP + sch * 16) = vreg;
            if (tid < 64) *(LAS float*)(L + AT_CS + nb * 256 + tid * 4) = creg; }
        __syncthreads();
        buf ^= 1;
    }
    l_run += __shfl_xor(l_run, 32);
    if (hh == 0) wsf[32 + r] = 1.0f / l_run;
    LDS_WAIT();
#pragma unroll
    for (int g = 0; g < 4; ++g) { const f32x4 iv = *(const LAS f32x4*)(wsf + 32 + 8 * g + 4 * hh);
#pragma unroll
        for (int i = 0; i < 4; ++i) { const int q = q0 + 32 * wave + 8 * g + 4 * hh + i; bf16* op = OAB + (rowb + q) * D + h * 64;
            op[r] = (bf16)f2bf(o0[4 * g + i] * iv[i]); op[32 + r] = (bf16)f2bf(o1[4 * g + i] * iv[i]); } }
}

__device__ __forceinline__ void gdn_sample_unit(Frame& F, int unit) {
    int tid_o = threadIdx.x; asm volatile("" : "+v"(tid_o));
    const int s = unit >> 2, h = unit & 3, tid = tid_o;
    LAS float* L = (LAS float*)(F.lds + RING_OFF);
    LAS float* qkv = L; LAS float* red = L + 1536; LAS float* scal = L + 2048 + 64;
    const bf16* GQ = (const bf16*)(F.ws + WS_GQ); const float* GAB = (const float*)(F.ws + WS_GAB); const float* cw = F.in[15];
    __syncthreads();
    if (tid < 384) {
        const int X = tid >> 7, c = tid & 127, ch = X * 512 + h * 128 + c;
        float xp[7];
#pragma unroll
        for (int i = 0; i < 3; ++i) xp[i] = F.in[7][((size_t)s * 3 + i) * CCH + ch];
#pragma unroll
        for (int j = 0; j < 4; ++j) xp[3 + j] = bf2f(GQ[(size_t)(MP + s * 4 + j) * CCH + ch]);
        const float w0 = cw[ch], w1 = cw[CCH + ch], w2 = cw[2 * CCH + ch], w3 = cw[3 * CCH + ch];
#pragma unroll
        for (int j = 0; j < 4; ++j) { const float y = w0 * xp[j] + w1 * xp[j + 1] + w2 * xp[j + 2] + w3 * xp[j + 3]; qkv[(X * 4 + j) * 128 + c] = y * __builtin_amdgcn_rcpf(1.0f + __expf(-y)); }
    }
    if (tid >= 448 && tid < 452) { const int j = tid - 448; scal[j] = __expf(GAB[(size_t)(MP + s * 4 + j) * 8 + h]); scal[4 + j] = GAB[(size_t)(MP + s * 4 + j) * 8 + 4 + h]; }
    __syncthreads();
    { const int w = F.wave, X = w >> 2, j = w & 3; LAS float* v = qkv + (X * 4 + j) * 128; const float a = v[F.lane], b2 = v[64 + F.lane];
      const float ss = wave_sum(a * a + b2 * b2); float rn = __builtin_amdgcn_rsqf(ss + EPS); if (X == 0) rn *= 0.08838834764831845f;
      v[F.lane] = a * rn; v[64 + F.lane] = b2 * rn; }
    __syncthreads();
    const int dv = tid & 127, rg = tid >> 7;
    float S[32];
    const float* sp = F.in[8] + ((size_t)(s * 4 + h) * 128 + rg * 32) * 128 + dv;
#pragma unroll
    for (int i = 0; i < 32; ++i) S[i] = sp[(size_t)i * 128];
    float ov[4];
#pragma unroll
    for (int j = 0; j < 4; ++j) {
        const float a = scal[j], be = scal[4 + j]; const LAS float* qj = qkv + (0 * 4 + j) * 128 + rg * 32; const LAS float* kj = qkv + (1 * 4 + j) * 128 + rg * 32;
        float ks = 0.f;
#pragma unroll
        for (int i = 0; i < 32; ++i) { S[i] *= a; ks += kj[i] * S[i]; }
        red[rg * 128 + dv] = ks; __syncthreads();
        const float kS = red[dv] + red[128 + dv] + red[256 + dv] + red[384 + dv];
        const float vn = be * (qkv[(2 * 4 + j) * 128 + dv] - kS);
        float os = 0.f;
#pragma unroll
        for (int i = 0; i < 32; ++i) { S[i] += kj[i] * vn; os += qj[i] * S[i]; }
        __syncthreads();
        red[rg * 128 + dv] = os; __syncthreads();
        ov[j] = red[dv] + red[128 + dv] + red[256 + dv] + red[384 + dv];
        __syncthreads();
    }
    float* so = F.out + OFF_SSS + ((size_t)(s * 4 + h) * 128 + rg * 32) * 128 + dv;
#pragma unroll
    for (int i = 0; i < 32; ++i) so[(size_t)i * 128] = S[i];
    {
        float ssj[4];
#pragma unroll
        for (int j = 0; j < 4; ++j) { const float v = wave_sum(ov[j] * ov[j]); if (F.lane == 0) red[j * 8 + F.wave] = v; }
        __syncthreads();
#pragma unroll
        for (int j = 0; j < 4; ++j) ssj[j] = red[j * 8] + red[j * 8 + 1];
        if (rg == 0) {
            const bf16* GZ = (const bf16*)(F.ws + WS_GZ); bf16* OAB = (bf16*)(F.ws + WS_OAB); const float gn = F.in[18][dv];
#pragma unroll
            for (int j = 0; j < 4; ++j) { const size_t row = MP + s * 4 + j; const float y = ov[j] * __builtin_amdgcn_rsqf(ssj[j] * (1.0f / 128.0f) + EPS) * gn * bf2f(GZ[row * 512 + h * 128 + dv]);
                OAB[row * D + 512 + h * 128 + dv] = (bf16)f2bf(y); }
        }
    }
    __syncthreads();
}
__device__ __forceinline__ void fox_cumsum_seg(Frame& F, int w) {
    int tid_o = threadIdx.x; asm volatile("" : "+v"(tid_o));
    const int b = w >> 7, seg = w & 127, i = tid_o >> 3, h = tid_o & 7;
    LAS float* part = (LAS float*)(F.lds + RING_OFF);
    const float* src = (const float*)(F.ws + WS_LGF) + (size_t)b * SEQ * 8;
    __syncthreads();
    float a = 0.f;
    { float a0 = 0.f, a1 = 0.f, a2 = 0.f, a3 = 0.f; int sgi = 0;
      for (; sgi + 8 <= seg; sgi += 8) { float v[8];
#pragma unroll
          for (int q = 0; q < 8; ++q) v[q] = src[(size_t)(64 * (sgi + q) + i) * 8 + h];
          a0 += v[0] + v[4]; a1 += v[1] + v[5]; a2 += v[2] + v[6]; a3 += v[3] + v[7]; }
      for (; sgi < seg; ++sgi) a0 += src[(size_t)(64 * sgi + i) * 8 + h];
      a = (a0 + a1) + (a2 + a3); }
    const float mine = src[(size_t)(64 * seg + i) * 8 + h];
    part[i * 8 + h] = a; part[512 + i * 8 + h] = mine;
    __syncthreads();
    float run = 0.f;
#pragma unroll 8
    for (int q = 0; q < 64; ++q) run += part[q * 8 + h];
    for (int q = 0; q <= i; ++q) run += part[512 + q * 8 + h];
    ((float*)(F.ws + WS_CUM))[((size_t)b * SEQ + 64 * seg + i) * 8 + h] = run * LOG2E;
    __syncthreads();
}
__device__ __forceinline__ void conv_out_job(Frame& F) {
    const bf16* GQ = (const bf16*)(F.ws + WS_GQ);
    for (int e = F.vcu * (NWAVES * 64) + F.tid; e < (NB * 3 + DB * 3) * CCH; e += F.G * NWAVES * 64) {
        const int rr = e / CCH, c = e % CCH;
        if (rr < NB * 3) { const int b = rr / 3, i = rr % 3; F.out[OFF_CVP + (size_t)rr * CCH + c] = bf2f(GQ[((size_t)b * SEQ + SEQ - 3 + i) * CCH + c]); }
        else { const int r2 = rr - NB * 3, s = r2 / 3, i = r2 % 3; F.out[OFF_CVS + (size_t)r2 * CCH + c] = bf2f(GQ[(size_t)(MP + s * 4 + 1 + i) * CCH + c]); }
    }
}
__device__ __forceinline__ void gdn_outnorm_rows(Frame& F) {
    const float* OG = (const float*)(F.ws + WS_OG); const bf16* GZ = (const bf16*)(F.ws + WS_GZ); bf16* OAB = (bf16*)(F.ws + WS_OAB);
    const int gw = F.vcu * NWAVES + F.wave, NGW = F.G * NWAVES, lane = F.lane;
    const f32x4 g0 = *(const f32x4*)(F.in[18] + (lane & 15) * 8), g1 = *(const f32x4*)(F.in[18] + (lane & 15) * 8 + 4);
    for (int m0 = gw; m0 < MP; m0 += 4 * NGW) {
        f32x4 a[4], c[4]; v4u z[4];
#pragma unroll
        for (int k = 0; k < 4; ++k) { const size_t m = (size_t)m0 + (size_t)k * NGW; a[k] = *(const f32x4*)(OG + m * 512 + lane * 8); c[k] = *(const f32x4*)(OG + m * 512 + lane * 8 + 4); z[k] = *(const v4u*)(GZ + m * 512 + lane * 8); }
#pragma unroll
        for (int k = 0; k < 4; ++k) { const size_t m = (size_t)m0 + (size_t)k * NGW;
            float ss = (a[k][0] * a[k][0] + a[k][1] * a[k][1]) + (a[k][2] * a[k][2] + a[k][3] * a[k][3]) + (c[k][0] * c[k][0] + c[k][1] * c[k][1]) + (c[k][2] * c[k][2] + c[k][3] * c[k][3]);
            ss = red16(ss);
            const float rs = __builtin_amdgcn_rsqf(ss * (1.0f / 128.0f) + EPS);
            v4u o; o.x = pk2(a[k][0] * rs * g0[0] * bflo(z[k].x), a[k][1] * rs * g0[1] * bfhi(z[k].x)); o.y = pk2(a[k][2] * rs * g0[2] * bflo(z[k].y), a[k][3] * rs * g0[3] * bfhi(z[k].y));
            o.z = pk2(c[k][0] * rs * g1[0] * bflo(z[k].z), c[k][1] * rs * g1[1] * bfhi(z[k].z)); o.w = pk2(c[k][2] * rs * g1[2] * bflo(z[k].w), c[k][3] * rs * g1[3] * bfhi(z[k].w));
            *(v4u*)(OAB + m * D + 512 + lane * 8) = o; }
    }
}
template <bool AF32, bool SUMSQ>
__device__ __forceinline__ void skinny_tile(const void* A, int lda, const bf16* Bt, int ldb, int n0, int k0, int k1, int wave, int lane, f32x4s& acc, float& ssq) {
    const int fr = lane & 15, fq = lane >> 4;
    acc = (f32x4s){0.f, 0.f, 0.f, 0.f}; float s = 0.f;
    const bf16* bp = Bt + (size_t)(n0 + fr) * ldb + 8 * fq;
    const float* apf = (const float*)A + (size_t)(16 * wave + fr) * lda + 8 * fq;
    const bf16* aph = (const bf16*)A + (size_t)(16 * wave + fr) * lda + 8 * fq;
#pragma unroll 8
    for (int k = k0; k < k1; k += 32) {
        const bf16x8 b = *(const bf16x8*)(bp + k);
        bf16x8 a;
        if constexpr (AF32) { const f32x4 x0 = *(const f32x4*)(apf + k), x1 = *(const f32x4*)(apf + k + 4);
            if constexpr (SUMSQ) s += (x0[0] * x0[0] + x0[1] * x0[1]) + (x0[2] * x0[2] + x0[3] * x0[3]) + (x1[0] * x1[0] + x1[1] * x1[1]) + (x1[2] * x1[2] + x1[3] * x1[3]);
            v4u p; p.x = pk2(x0[0], x0[1]); p.y = pk2(x0[2], x0[3]); p.z = pk2(x1[0], x1[1]); p.w = pk2(x1[2], x1[3]); a = __builtin_bit_cast(bf16x8, p);
        } else { const v4u p = *(const v4u*)(aph + k); a = __builtin_bit_cast(bf16x8, p);
            if constexpr (SUMSQ) { float t0 = bflo(p.x), t1 = bfhi(p.x), t2 = bflo(p.y), t3 = bfhi(p.y), t4 = bflo(p.z), t5 = bfhi(p.z), t6 = bflo(p.w), t7 = bfhi(p.w);
                s += (t0 * t0 + t1 * t1) + (t2 * t2 + t3 * t3) + (t4 * t4 + t5 * t5) + (t6 * t6 + t7 * t7); } }
        acc = mfma16(a, b, acc);
    }
    if constexpr (SUMSQ) { s += __shfl_xor(s, 16); s += __shfl_xor(s, 32); }
    ssq = s;
}
template <bool AF32, bool SUMSQ>
__device__ __forceinline__ void skinny_half(const void* A, int lda, const bf16* Bt, int ldb, int n0, int k0, int k1, int mh, int wave, int lane, LAS unsigned char* scr, f32x4s& acc, float& ssq) {
    const int mt = wave & 3, kh = wave >> 2, kl = (k1 - k0) >> 1;
    const void* Ah = AF32 ? (const void*)((const float*)A + (size_t)(64 * mh) * lda) : (const void*)((const bf16*)A + (size_t)(64 * mh) * lda);
    skinny_tile<AF32, SUMSQ>(Ah, lda, Bt, ldb, n0, k0 + kh * kl, k0 + kh * kl + kl, mt, lane, acc, ssq);
    __syncthreads();
    if (kh == 1) { *(LAS f32x4s*)(scr + (mt * 64 + lane) * 16) = acc; if (SUMSQ) *(LAS float*)(scr + 4096 + (mt * 64 + lane) * 4) = ssq; }
    __syncthreads();
    if (kh == 0) { acc += *(const LAS f32x4s*)(scr + (mt * 64 + lane) * 16); if (SUMSQ) ssq += *(const LAS float*)(scr + 4096 + (mt * 64 + lane) * 4); }
}
__device__ __forceinline__ void sample_p5(Frame& F, int u) {
    int tid_o = threadIdx.x; asm volatile("" : "+v"(tid_o));
    const int lane = tid_o & 63, wave = __builtin_amdgcn_readfirstlane(tid_o >> 6), fr = lane & 15, fq = lane >> 4;
    LAS unsigned char* scr = F.lds + RING_OFF;
    const bf16* OAB = (const bf16*)(F.ws + WS_OAB) + (size_t)MP * D; const bf16* GT = (const bf16*)(F.ws + WS_GT) + (size_t)MP * 2048;
    if (u < 128) {
        const int cu = u >> 1, mh = u & 1; f32x4s aa, ab; float d;
        skinny_half<false, false>(OAB, D, (const bf16*)(F.ws + WS_WAB), D, 16 * cu, 0, 512, mh, wave, lane, scr, aa, d);
        __syncthreads();
        skinny_half<false, false>(OAB, D, (const bf16*)(F.ws + WS_WAB), D, 16 * cu, 512, 1024, mh, wave, lane, scr, ab, d);
        if (wave < 4) { bf16* MRG = (bf16*)(F.ws + WS_MRG) + (size_t)MP * D;
#pragma unroll
            for (int i = 0; i < 4; ++i) { const int row = 64 * mh + 16 * wave + 4 * fq + i, col = 16 * cu + fr;
                const float ga = bf2f(GT[(size_t)row * 2048 + col]), gb = bf2f(GT[(size_t)row * 2048 + 1024 + col]);
                MRG[(size_t)row * D + col] = (bf16)f2bf(ga * aa[i] + gb * ab[i]); } }
    } else if (u < 256) {
        const int cu = (u - 128) >> 1, mh = u & 1; f32x4s a; float d;
        skinny_half<false, false>((const bf16*)(F.ws + WS_PLB) + (size_t)MP * PLE, PLE, (const bf16*)(F.ws + WS_WPL), PLE, 16 * cu, 0, PLE, mh, wave, lane, scr, a, d);
        if (wave < 4) { bf16* PL = (bf16*)(F.ws + WS_PL) + (size_t)MP * D;
#pragma unroll
            for (int i = 0; i < 4; ++i) PL[(size_t)(64 * mh + 16 * wave + 4 * fq + i) * D + 16 * cu + fr] = (bf16)f2bf(a[i]); }
    }
}
__device__ __forceinline__ void sample_zero_x2(Frame& F, int q) {
    float* X2 = (float*)(F.ws + WS_X2) + (size_t)MP * D + (size_t)q * 32 * D;
    for (int e = F.tid; e < 32 * D / 4; e += NWAVES * 64) ((f32x4*)X2)[e] = (f32x4){0.f, 0.f, 0.f, 0.f};
}
__device__ __forceinline__ void sample_p6(Frame& F, int u) {
    int tid_o = threadIdx.x; asm volatile("" : "+v"(tid_o));
    const int lane = tid_o & 63, wave = __builtin_amdgcn_readfirstlane(tid_o >> 6), fr = lane & 15, fq = lane >> 4;
    if (u >= 128) return;
    const int cu = u >> 1, mh = u & 1; f32x4s a; float d;
    skinny_half<false, false>((const bf16*)(F.ws + WS_MRG) + (size_t)MP * D, D, (const bf16*)(F.ws + WS_WOUT), D, 16 * cu, 0, D, mh, wave, lane, F.lds + RING_OFF, a, d);
    if (wave < 4) { float* X1 = (float*)(F.ws + WS_X1) + (size_t)MP * D; bf16* X1B = (bf16*)(F.ws + WS_X1B) + (size_t)MP * D;
#pragma unroll
        for (int i = 0; i < 4; ++i) { const int row = 64 * mh + 16 * wave + 4 * fq + i, col = 16 * cu + fr; const float v = a[i] + F.in[1][(size_t)row * D + col];
            X1[(size_t)row * D + col] = v; X1B[(size_t)row * D + col] = (bf16)f2bf(v); } }
}
template <bool SUMSQ>
__device__ __forceinline__ void skinny_half2(const bf16* A, int lda, const bf16* Bt, int ldb, int n0, int k0, int k1, int mh, int wave, int lane, LAS unsigned char* scr, f32x4s (&acc)[2], float& ssq) {
    const int mt = wave & 3, kh = wave >> 2, kl = (k1 - k0) >> 1, fr = lane & 15, fq = lane >> 4;
    acc[0] = (f32x4s){0.f, 0.f, 0.f, 0.f}; acc[1] = (f32x4s){0.f, 0.f, 0.f, 0.f}; float s = 0.f;
    const bf16* ap = A + (size_t)(64 * mh + 16 * mt + fr) * lda + 8 * fq; const bf16* bp0 = Bt + (size_t)(n0 + fr) * ldb + 8 * fq; const bf16* bp1 = bp0 + (size_t)16 * ldb;
    const int ka = k0 + kh * kl;
#pragma unroll 8
    for (int ks = 0; ks < 16; ++ks) { const int k = ka + 32 * ks;
        const v4u p = *(const v4u*)(ap + k); const bf16x8 a = __builtin_bit_cast(bf16x8, p); const bf16x8 b0 = *(const bf16x8*)(bp0 + k), b1 = *(const bf16x8*)(bp1 + k);
        if constexpr (SUMSQ) { float t0 = bflo(p.x), t1 = bfhi(p.x), t2 = bflo(p.y), t3 = bfhi(p.y), t4 = bflo(p.z), t5 = bfhi(p.z), t6 = bflo(p.w), t7 = bfhi(p.w);
            s += (t0 * t0 + t1 * t1) + (t2 * t2 + t3 * t3) + (t4 * t4 + t5 * t5) + (t6 * t6 + t7 * t7); }
        acc[0] = mfma16(a, b0, acc[0]); acc[1] = mfma16(a, b1, acc[1]);
    }
    if constexpr (SUMSQ) { s += __shfl_xor(s, 16); s += __shfl_xor(s, 32); }
    __syncthreads();
    if (kh == 1) { *(LAS f32x4s*)(scr + (mt * 64 + lane) * 32) = acc[0]; *(LAS f32x4s*)(scr + (mt * 64 + lane) * 32 + 16) = acc[1]; if (SUMSQ) *(LAS float*)(scr + 8192 + (mt * 64 + lane) * 4) = s; }
    __syncthreads();
    if (kh == 0) { acc[0] += *(const LAS f32x4s*)(scr + (mt * 64 + lane) * 32); acc[1] += *(const LAS f32x4s*)(scr + (mt * 64 + lane) * 32 + 16); if (SUMSQ) s += *(const LAS float*)(scr + 8192 + (mt * 64 + lane) * 4); }
    ssq = s;
}
__device__ __forceinline__ void sample_p7(Frame& F, int u) {
    int tid_o = threadIdx.x; asm volatile("" : "+v"(tid_o));
    const int lane = tid_o & 63, wave = __builtin_amdgcn_readfirstlane(tid_o >> 6), fr = lane & 15, fq = lane >> 4;
    if (u >= 256) return;
    const int cu = u >> 1, mh = u & 1; f32x4s a[2]; float ss;
    skinny_half2<true>((const bf16*)(F.ws + WS_X1B) + (size_t)MP * D, D, (const bf16*)(F.ws + WS_WUP), D, 32 * cu, 0, D, mh, wave, lane, F.lds + RING_OFF, a, ss);
    if (wave < 4) { const float rs = __builtin_amdgcn_rsqf(ss * (1.0f / D) + EPS); bf16* HB = (bf16*)(F.ws + WS_HB) + (size_t)MP * DFF;
#pragma unroll
        for (int i = 0; i < 4; ++i) { const float r = __shfl(rs, 4 * fq + i);
#pragma unroll
            for (int nt = 0; nt < 2; ++nt) { const float v = fmaxf(a[nt][i] * r, 0.f); HB[(size_t)(64 * mh + 16 * wave + 4 * fq + i) * DFF + 32 * cu + 16 * nt + fr] = (bf16)f2bf(v * v); } } }
}
__device__ __forceinline__ void sample_p8(Frame& F, int u) {
    int tid_o = threadIdx.x; asm volatile("" : "+v"(tid_o));
    const int lane = tid_o & 63, wave = __builtin_amdgcn_readfirstlane(tid_o >> 6), fr = lane & 15, fq = lane >> 4;
    if (u >= 256) return;
    const int cu = u & 31, mh = (u >> 5) & 1, kq = u >> 6; f32x4s a[2]; float d;
    skinny_half2<false>((const bf16*)(F.ws + WS_HB) + (size_t)MP * DFF, DFF, (const bf16*)(F.ws + WS_WDN), DFF, 32 * cu, 1024 * kq, 1024 * kq + 1024, mh, wave, lane, F.lds + RING_OFF, a, d);
    if (wave < 4) { float* X2 = (float*)(F.ws + WS_X2) + (size_t)MP * D; const float* X1 = (const float*)(F.ws + WS_X1) + (size_t)MP * D;
#pragma unroll
        for (int i = 0; i < 4; ++i)
#pragma unroll
            for (int nt = 0; nt < 2; ++nt) { const int row = 64 * mh + 16 * wave + 4 * fq + i, col = 32 * cu + 16 * nt + fr; float v = a[nt][i]; if (kq == 0) v += X1[(size_t)row * D + col]; atomicAdd(X2 + (size_t)row * D + col, v); } }
}
__device__ __forceinline__ void sample_p9(Frame& F, int u) {
    int tid_o = threadIdx.x; asm volatile("" : "+v"(tid_o));
    const int lane = tid_o & 63, wave = __builtin_amdgcn_readfirstlane(tid_o >> 6), fr = lane & 15, fq = lane >> 4;
    if (u >= 128) return;
    const int cu = u >> 1, mh = u & 1;
    const float* X2 = (const float*)(F.ws + WS_X2) + (size_t)MP * D; const bf16* PL = (const bf16*)(F.ws + WS_PL) + (size_t)MP * D;
    f32x4s a; float ss;
    skinny_half<true, true>(X2, D, (const bf16*)(F.ws + WS_WGT), D, 16 * cu, 0, D, mh, wave, lane, F.lds + RING_OFF, a, ss);
    if (wave < 4) { const float rs = __builtin_amdgcn_rsqf(ss * (1.0f / D) + EPS);
#pragma unroll
        for (int i = 0; i < 4; ++i) { const int row = 64 * mh + 16 * wave + 4 * fq + i, col = 16 * cu + fr; const float r = __shfl(rs, 4 * fq + i);
            F.out[OFF_YS + (size_t)row * D + col] = X2[(size_t)row * D + col] + bf2f(PL[(size_t)row * D + col]) * __builtin_amdgcn_rcpf(1.0f + __expf(-a[i] * r)); } }
}
#ifndef MK_N_LAUNCHES
#define MK_N_LAUNCHES 1
#endif
constexpr int N_PHASES = 10;
__device__ __forceinline__ int q_fetch(Frame& F, int qi) {
    __syncthreads();
    if (F.tid == 0) F.MISC[16] = __hip_atomic_fetch_add((unsigned*)(F.ctl + CW_Q + 64 * qi), 1u, __ATOMIC_RELAXED, __HIP_MEMORY_SCOPE_AGENT);
    __syncthreads();
    return (int)F.MISC[16];
}
__device__ __forceinline__ void p2_publish(Frame& F) {
    asm volatile("s_waitcnt vmcnt(0)" ::: "memory"); __syncthreads();
    if (F.tid == 0) { __builtin_amdgcn_fence(__ATOMIC_RELEASE, "agent"); asm volatile("s_waitcnt vmcnt(0)" ::: "memory");
        (void)__hip_atomic_fetch_add((unsigned*)(F.ctl + CW_PROG + 64 * 16), 1u, __ATOMIC_RELAXED, __HIP_MEMORY_SCOPE_AGENT); }
}
__device__ __forceinline__ void p2_wait(Frame& F, unsigned* tmo) {
    if (F.tid == 0) { unsigned sp = 0;
        while (__hip_atomic_load((unsigned*)(F.ctl + CW_PROG + 64 * 16), __ATOMIC_RELAXED, __HIP_MEMORY_SCOPE_AGENT) < (unsigned)F.G) { __builtin_amdgcn_s_sleep(2);
            if ((++sp & 255u) == 0u) { if (__hip_atomic_load(tmo, __ATOMIC_RELAXED, __HIP_MEMORY_SCOPE_AGENT)) break; if (sp > (1u << 20)) { atomicAdd(tmo, 1u); break; } } }
        __builtin_amdgcn_fence(__ATOMIC_ACQUIRE, "agent"); asm volatile("s_waitcnt vmcnt(0)" ::: "memory"); }
    __syncthreads();
}
__global__ void __launch_bounds__(NWAVES * 64, 2) mk_fwd(Args args) {
    extern __shared__ __attribute__((aligned(16))) unsigned char lds[];
    Frame F;
    F.lds = (LAS unsigned char*)lds;
    F.MISC = (volatile LAS unsigned*)(F.lds + MISC_OFF);
    F.tid = threadIdx.x; F.lane = F.tid & 63; F.wave = __builtin_amdgcn_readfirstlane(F.tid >> 6);
    F.G = gridDim.x; { const int bx = blockIdx.x; F.vcu = (F.G % 8 == 0) ? (bx % 8) * (F.G / 8) + bx / 8 : bx; }
    F.ws = args.ws; F.out = args.out; F.ctl = (gu32*)(args.ws + WS_CTL);
#pragma unroll
    for (int i = 0; i < 28; ++i) F.in[i] = (const float*)args.in[i];
    F.page_table = (const int*)args.in[9];
    for (int u = F.tid; u < (LDS_BYTES - LDSCTL_OFF) / 4; u += NWAVES * 64) ((LAS unsigned*)(F.lds + LDSCTL_OFF))[u] = 0u;
    __syncthreads();
    XcdBarrier bar; bar.bar = (unsigned*)(F.ctl + CW_BAR); bar.x = 0; bar.st = nullptr;
    if (MK_N_LAUNCHES == 1) bar = xcd_barrier_post((unsigned*)(F.ctl + CW_BAR), F.MISC + 8);
#define GRID_BAR() do { if (MK_N_LAUNCHES == 1) xcd_barrier(bar); } while (0)
    const int lo = args.ph_lo, hi = args.ph_hi;
#ifndef PH_MASK
#define PH_MASK 0x3ff
#endif
#define IN(k) (((PH_MASK >> (k)) & 1) && lo <= (k) && (k) < hi)
#define BOTH(k) (IN(k) && IN((k) + 1))
    unsigned char* ws = args.ws;
    bf16* XN = (bf16*)(ws + WS_XN); bf16* QB = (bf16*)(ws + WS_QB); bf16* KB = (bf16*)(ws + WS_KB); bf16* VB = (bf16*)(ws + WS_VB);
    bf16* GQ = (bf16*)(ws + WS_GQ); bf16* GZ = (bf16*)(ws + WS_GZ); bf16* GT = (bf16*)(ws + WS_GT);
    float* GAB = (float*)(ws + WS_GAB); float* LGF = (float*)(ws + WS_LGF);
    bf16* OAB = (bf16*)(ws + WS_OAB); bf16* MRG = (bf16*)(ws + WS_MRG); float* X1 = (float*)(ws + WS_X1); bf16* X1B = (bf16*)(ws + WS_X1B);
    bf16* HB = (bf16*)(ws + WS_HB); float* X2 = (float*)(ws + WS_X2); bf16* X2B = (bf16*)(ws + WS_X2B); bf16* PL = (bf16*)(ws + WS_PL);
    float* SS1 = (float*)(F.ctl + CW_SS1); float* SS2 = (float*)(F.ctl + CW_SS2);

    if (IN(0)) { p0_prologue(F); if (BOTH(0)) GRID_BAR(); }
    if (IN(1)) {
        pg8::Gemm g{XN, (const bf16*)(ws + WS_WIN), MPAD, NIN, D}; pg8::QueueOrder S; S.init(MPAD, NIN, (unsigned*)(F.ctl + CW_Q + 64 * 6), F.MISC + 12);
        { LAS float* par = (LAS float*)(F.lds + MISC_OFF + 256);
          if (F.tid < 64) { par[F.tid] = F.in[13][F.tid]; par[64 + F.tid] = F.in[14][F.tid]; }
          if (F.tid < 8) par[128 + F.tid] = F.in[12][F.tid];
          if (F.tid < 4) { par[136 + F.tid] = -__expf(F.in[16][F.tid]); par[140 + F.tid] = F.in[17][F.tid]; }
          __syncthreads(); }
        pg8::EpiIn E{QB, KB, VB, GQ, GZ, GT, GAB, LGF, F.out, (const LAS float*)(F.lds + MISC_OFF + 256)};
        pg8::gemm_phase<pg8::EpiIn, pg8::QueueOrder, true, true>(F.lds + RING_OFF, g, S, E);
        if (BOTH(1)) GRID_BAR();
    }
    if (IN(2)) {
        for (int u = F.vcu; u < 1024; u += F.G) gdn_prep_unit<0>(F, u);
        if (F.vcu < NB * 128) fox_cumsum_seg(F, F.vcu);
        conv_out_job(F);
        if (BOTH(2)) p2_publish(F);
    }
    if (IN(3)) {
        { const int su = (F.G == 256) ? (((F.vcu & 31) < 4) ? (F.vcu >> 5) * 4 + (F.vcu & 31) : -1) : (F.vcu < 32 ? F.vcu : -1);
          if (su >= 0) { if (lo <= 2) p2_wait(F, (unsigned*)(F.ctl + CW_BAR) + XB_TMO); gdn_scan_unit<0>(F, su); } }
        for (;;) { const int u = q_fetch(F, 0); if (u >= DB * GH) break; gdn_sample_unit(F, u); }
        float qkb;
        { const float a = fabsf(F.in[13][F.lane]), c = fabsf(F.in[14][F.lane]); float ma = a, mc = c;
#pragma unroll
          for (int o = 1; o < 64; o <<= 1) { ma = fmaxf(ma, __shfl_xor(ma, o)); mc = fmaxf(mc, __shfl_xor(mc, o)); }
          qkb = 64.0f * ma * mc * C2 * 1.02f; }
        const int attn_first = F.vcu & 1;
#pragma unroll 1
        for (int pass = 0; pass < 2; ++pass) {
            if ((pass ^ attn_first) & 1) {
                if (lo <= 2) p2_wait(F, (unsigned*)(F.ctl + CW_BAR) + XB_TMO);
                for (;;) { const int u = q_fetch(F, 2); if (u >= NB * FH * 32) break; attn_unit(F, ((u & 15) << 5) | (31 - (u >> 4)), qkb); }
            } else {
                for (;;) { const int u2 = q_fetch(F, 1); if (u2 >= DB * NPAGES / 2) break; decode_unit<false>(F, 2 * u2, F.wave); decode_unit<false>(F, 2 * u2 + 1, F.wave); }
            }
        }
        if (BOTH(3)) GRID_BAR();
    }
    if (IN(4)) {
        for (int r = F.vcu * NWAVES + F.wave; r < DB * FH * DS; r += F.G * NWAVES) decode_combine_row(F, r);
        gdn_outnorm_rows(F);
        if (F.vcu >= F.G - 4) sample_zero_x2(F, F.vcu - (F.G - 4));
        if (BOTH(4)) GRID_BAR();
    }
    if (IN(5)) {
        { pg8::Gemm g{OAB, (const bf16*)(ws + WS_WAB), MP, D, D}; pg8::StaticOrder S; S.init(MP, D, F.G, (int)blockIdx.x);
          pg8::EpiMerge E{MRG, GT};
          pg8::gemm_phase<pg8::EpiMerge, pg8::StaticOrder, true, true>(F.lds + RING_OFF, g, S, E); }
        __syncthreads();
        { pg8::Gemm g{(const bf16*)(ws + WS_PLB), (const bf16*)(ws + WS_WPL), MP, D, PLE}; pg8::StaticOrder S; S.init(MP, D, F.G, (int)blockIdx.x);
          pg8::EpiBf<0> E{PL, D, nullptr};
          pg8::gemm_phase<pg8::EpiBf<0>, pg8::StaticOrder, true, true>(F.lds + RING_OFF, g, S, E); }
        sample_p5(F, (F.G == 256) ? (F.vcu & 31) * 8 + (F.vcu >> 5) : F.vcu);
        if (BOTH(5)) GRID_BAR();
    }
    if (IN(6)) {
        pg8::Gemm g{MRG, (const bf16*)(ws + WS_WOUT), MP, D, D}; pg8::StaticOrder S; S.init(MP, D, F.G, (int)blockIdx.x);
        pg8::EpiRes<false, false> E{F.in[0], X1B, SS1, nullptr};
        pg8::gemm_phase<pg8::EpiRes<false, false>, pg8::StaticOrder, true, true>(F.lds + RING_OFF, g, S, E);
        sample_p6(F, (F.G == 256) ? (((F.vcu & 31) < 16) ? (F.vcu & 31) * 8 + (F.vcu >> 5) : 1000) : F.vcu);
        if (BOTH(6)) GRID_BAR();
    }
    if (IN(7)) {
        pg8::Gemm g{X1B, (const bf16*)(ws + WS_WUP), MP, DFF, D}; pg8::StaticOrder S; S.init(MP, DFF, F.G, (int)blockIdx.x);
        pg8::EpiBf<2> E{HB, DFF, nullptr};
        pg8::gemm_phase<pg8::EpiBf<2>, pg8::StaticOrder, true, true>(F.lds + RING_OFF, g, S, E);
        sample_p7(F, F.vcu);
        if (BOTH(7)) GRID_BAR();
    }
    if (IN(8)) {
        { pg8::Gemm g{HB, (const bf16*)(ws + WS_WDN), MP, D, DFF}; pg8::StaticOrder S; S.init(MP, D, F.G, (int)blockIdx.x);
          pg8::EpiRes<true, true> E{X1B, X2B, SS2, SS1};
          pg8::gemm_phase<pg8::EpiRes<true, true>, pg8::StaticOrder, true, true>(F.lds + RING_OFF, g, S, E); }
        sample_p8(F, F.vcu);
        if (BOTH(8)) GRID_BAR();
    }
    if (IN(9)) {
        pg8::Gemm g{X2B, (const bf16*)(ws + WS_WGT), MP, D, D}; pg8::StaticOrder S; S.init(MP, D, F.G, (int)blockIdx.x);
        pg8::EpiFinal E{X2B, PL, SS2, F.out};
        pg8::gemm_phase<pg8::EpiFinal, pg8::StaticOrder, true, true>(F.lds + RING_OFF, g, S, E);
        sample_p9(F, (F.G == 256) ? (((F.vcu & 31) < 16) ? (F.vcu & 31) * 8 + (F.vcu >> 5) : 1000) : F.vcu);
    }
#undef IN
#undef BOTH
}

extern "C" void kernel_launch(void* const* d_in, const int* in_sizes, int n_in, void* d_out, int out_size, void* d_ws, size_t ws_size, hipStream_t stream) {
    static int grid = 0;
    if (grid == 0) {
        if (n_in != 28 || out_size != (int)OUT_TOTAL || ws_size < WS_END) { fprintf(stderr, "kernel_launch: unexpected shapes (n_in %d out %d ws %zu)\n", n_in, out_size, ws_size); grid = -1; return; }
        int dev = 0, cus = 0, per_cu = 0;
        if (hipGetDevice(&dev) != hipSuccess || hipDeviceGetAttribute(&cus, hipDeviceAttributeMultiprocessorCount, dev) != hipSuccess) { grid = -1; return; }
        if (hipFuncSetAttribute((const void*)mk_fwd, hipFuncAttributeMaxDynamicSharedMemorySize, LDS_BYTES) != hipSuccess) { fprintf(stderr, "kernel_launch: hipFuncSetAttribute failed\n"); grid = -1; return; }
        if (hipOccupancyMaxActiveBlocksPerMultiprocessor(&per_cu, (const void*)mk_fwd, NWAVES * 64, LDS_BYTES) != hipSuccess || per_cu < 1)
            fprintf(stderr, "kernel_launch: occupancy query reports %d workgroups per CU\n", per_cu);
        (void)hipGetLastError();
        grid = cus;
        if (cus != 256) fprintf(stderr, "kernel_launch: built for a 256-CU device (unit-to-workgroup maps assume 256 workgroups); this one reports %d\n", cus);
    }
    if (grid < 0) return;
    if (hipMemsetAsync((char*)d_ws + WS_CTL, 0, CTL_ZERO_BYTES, stream) != hipSuccess) return;
    Args a{};
    for (int i = 0; i < 28; ++i) a.in[i] = d_in[i];
    a.out = (float*)d_out; a.ws = (unsigned char*)d_ws;
    if (MK_N_LAUNCHES == 1) { a.ph_lo = 0; a.ph_hi = N_PHASES; a.li = 0; hipLaunchKernelGGL(mk_fwd, dim3(grid), dim3(NWAVES * 64), LDS_BYTES, stream, a); }
    else for (int li = 0; li < N_PHASES; ++li) { a.ph_lo = li; a.ph_hi = li + 1; a.li = li; hipLaunchKernelGGL(mk_fwd, dim3(grid), dim3(NWAVES * 64), LDS_BYTES, stream, a); }
}
```

```cpp
#include <hip/hip_runtime.h>
#include <cstdio>
#include <cstdint>
#include <cmath>

constexpr int D = 1024, SEQ = 8192, NB = 2, MP = NB * SEQ;
constexpr int DB = 32, DS = 4, MS = DB * DS;
constexpr int MT = MP + MS, MPAD = 16640;
constexpr int FH = 8, FD = 64, FW = 512;
constexpr int GH = 4, GK = 128, GV = 128, CCH = 1536, CW = 4;
constexpr int DFF = 4096, PLE = 256, DIN = 5648;
constexpr int PAST = 8192, PAGE = 128, NPAGES = 64;
constexpr int NIN = 5888;
constexpr float EPS = 1e-6f;
constexpr float C2 = 0.125f * 1.4426950408889634f;
constexpr float LOG2E = 1.4426950408889634f;

constexpr size_t OFF_YP = 0, OFF_YS = 16777216, OFF_KP = 16908288, OFF_VP = 25296896, OFF_LFP = 33685504, OFF_CVP = 33816576,
                 OFF_SSP = 33825792, OFF_KS = 33956864, OFF_VS = 34022400, OFF_LFS = 34087936, OFF_CVS = 34088960, OFF_SSS = 34236416, OUT_TOTAL = 36333568;

constexpr size_t MiB = 1u << 20;
constexpr size_t WS_CTL = 0, CTL_ZERO_BYTES = 1 * MiB;
constexpr size_t WS_WIN = 2 * MiB, WS_WAB = 14 * MiB, WS_WOUT = 16 * MiB, WS_WUP = 18 * MiB, WS_WDN = 26 * MiB, WS_WGT = 34 * MiB, WS_WPL = 36 * MiB;
constexpr size_t WS_XN = 40 * MiB, WS_QB = 74 * MiB, WS_KB = 91 * MiB, WS_VB = 108 * MiB, WS_GQ = 126 * MiB, WS_GZ = 176 * MiB, WS_GT = 194 * MiB;
constexpr size_t WS_GAB = 260 * MiB, WS_LGF = 261 * MiB, WS_CUM = 262 * MiB, WS_OAB = 264 * MiB, WS_MRG = 298 * MiB, WS_X1 = 332 * MiB, WS_X1B = 398 * MiB;
constexpr size_t WS_HB = 432 * MiB, WS_X2 = 563 * MiB, WS_X2B = 629 * MiB, WS_PL = 663 * MiB, WS_GDN = 700 * MiB, WS_OG = 790 * MiB, WS_SFX = 824 * MiB, WS_DPART = 834 * MiB;
constexpr size_t WS_PLB = 856 * MiB;
constexpr size_t WS_END = 880 * MiB;
constexpr int CW_TMO = 0, CW_CODE = 1;
constexpr int CW_BAR = 4096;
constexpr int CW_Q = 8192;
constexpr int CW_PROG = 12288;
constexpr int CW_SS1 = 65536, CW_SS2 = 65536 + 16640 + 64;
static_assert((CW_SS2 + 16640) * 4 <= (int)CTL_ZERO_BYTES, "ctl");

constexpr int RING_OFF = 0, RING_BYTES = 131072;
constexpr int LDSCTL_OFF = RING_BYTES, MISC_OFF = LDSCTL_OFF + 320;
constexpr int LDS_BYTES = 147456;
constexpr int NWAVES = 8;

#define GAS __attribute__((address_space(1)))
#define LAS __attribute__((address_space(3)))
typedef unsigned short bf16;
typedef unsigned v4u __attribute__((ext_vector_type(4)));
typedef unsigned v2u __attribute__((ext_vector_type(2)));
typedef float f32x4 __attribute__((ext_vector_type(4)));
typedef float f32x16 __attribute__((ext_vector_type(16)));
typedef float f32x4s __attribute__((ext_vector_type(4)));
typedef short bf16x8 __attribute__((ext_vector_type(8)));
typedef short s16x4 __attribute__((ext_vector_type(4)));
typedef GAS unsigned gu32;
#define RLX_AGENT __ATOMIC_RELAXED, __HIP_MEMORY_SCOPE_AGENT
#define LDS_WAIT() asm volatile("s_waitcnt lgkmcnt(0)" ::: "memory")
#define VM_WAIT() asm volatile("s_waitcnt vmcnt(0)" ::: "memory")
typedef float f32x2_t __attribute__((ext_vector_type(2))); typedef __bf16 bf16x2_t __attribute__((ext_vector_type(2)));
__device__ __forceinline__ unsigned pk2(float lo, float hi) { const f32x2_t v = {lo, hi}; return __builtin_bit_cast(unsigned, __builtin_convertvector(v, bf16x2_t)); }
__device__ __forceinline__ unsigned f2bf(float f) { return pk2(f, 0.f) & 0xffffu; }
__device__ __forceinline__ float bf2f(unsigned short b) { return __builtin_bit_cast(float, (unsigned)b << 16); }
__device__ __forceinline__ float bflo(unsigned w) { return __builtin_bit_cast(float, w << 16); }
__device__ __forceinline__ float bfhi(unsigned w) { return __builtin_bit_cast(float, w & 0xffff0000u); }
__device__ __forceinline__ float sigmoidf_(float x) { return 1.0f / (1.0f + __expf(-x)); }
__device__ __forceinline__ float siluf_(float x) { return x / (1.0f + __expf(-x)); }
__device__ __forceinline__ float log_sigmoidf_(float z) { return fminf(z, 0.f) - __logf(1.0f + __expf(-fabsf(z))); }
__device__ __forceinline__ float softplusf_(float z) { return fmaxf(z, 0.f) + __logf(1.0f + __expf(-fabsf(z))); }
__device__ __forceinline__ float wave_sum(float v) {
#pragma unroll
    for (int o = 1; o < 64; o <<= 1) v += __shfl_xor(v, o);
    return v;
}
namespace pg8 {
#define PG8_LAS __attribute__((address_space(3)))
typedef unsigned short bf16_t;
typedef short bf16x8 __attribute__((ext_vector_type(8)));
typedef float f32x4 __attribute__((ext_vector_type(4)));
typedef unsigned u32x4 __attribute__((ext_vector_type(4)));
constexpr int BM = 256, BK = 64, HALF = 128, HTB = HALF * BK * 2  , STAGE_BYTES = 8 * HTB, NXCD = 8, WGM = 8;

__host__ __device__ __forceinline__ int lds_byte(int r, int c) { const int st = (r >> 4) * 2 + (c >> 5), rr = r & 15, cc = c & 31, ob = rr * 64 + cc * 2; return st * 1024 + (ob ^ (((ob >> 9) & 1) << 5)); }
__host__ __device__ __forceinline__ void stage_rc(int b, int& R, int& C) { const int st = b / 1024, sb = b % 1024, swz = sb ^ (((sb >> 9) & 1) << 5); R = (st >> 1) * 16 + swz / 64; C = (st & 1) * 32 + (swz % 64) / 2; }
__host__ __device__ __forceinline__ int perm32(int rho) { const int n = rho >> 4, i = rho & 15; return 8 * (i >> 2) + 4 * n + (i & 3); }

struct Unit { int pm, pn; };
struct Gemm { const bf16_t* A; const bf16_t* Bt; int M, N, K; };

struct StaticOrder {
    int nM, nN, nwg, G, c;
    __host__ __device__ void init(int M, int N, int G_, int c_) { nM = M / BM; nN = N / BM; nwg = nM * nN; G = G_; c = c_; }
    __host__ __device__ bool next(int i, Unit& u) const {
        const long L = (long)i * G + c; if (L >= nwg) return false;
        int wgid = (int)L; { const int q = nwg / NXCD, r = nwg % NXCD, xcd = wgid % NXCD, off = wgid / NXCD; wgid = (xcd < r ? xcd * (q + 1) : r * (q + 1) + (xcd - r) * q) + off; }
        const int nig = WGM * nN, gid = wgid / nig, fm = gid * WGM, gsz = (nM - fm) < WGM ? (nM - fm) : WGM;
        u.pm = fm + ((wgid % nig) % gsz); u.pn = (wgid % nig) / gsz; return true;
    }
    __device__ __forceinline__ void prefetch(int) const {}
    __device__ __forceinline__ void a_ready(const Unit&) const {}
    __device__ __forceinline__ void done(const Unit&) const {}
};
struct QueueOrder {
    unsigned* head; volatile PG8_LAS unsigned* slot; int nM, nN, nwg;
    __device__ __forceinline__ void init(int M, int N, unsigned* h, volatile PG8_LAS unsigned* s) { nM = M / BM; nN = N / BM; nwg = nM * nN; head = h; slot = s; }
    __device__ __forceinline__ void prefetch(int i) const { if (threadIdx.x == 0) slot[i & 1] = __hip_atomic_fetch_add(head, 1u, __ATOMIC_RELAXED, __HIP_MEMORY_SCOPE_AGENT); }
    __device__ __forceinline__ bool next(int i, Unit& u) const {
        if (i == 0) { __syncthreads(); prefetch(0); __syncthreads(); }
        const int idx = (int)slot[i & 1]; if (idx >= nwg) return false;
        const int nig = WGM * nN, gid = idx / nig, fm = gid * WGM, gsz = (nM - fm) < WGM ? (nM - fm) : WGM;
        u.pm = fm + ((idx % nig) % gsz); u.pn = (idx % nig) / gsz; return true;
    }
    __device__ __forceinline__ void a_ready(const Unit&) const {}
    __device__ __forceinline__ void done(const Unit&) const {}
};

__device__ __forceinline__ unsigned cvt_pk_bf16(float lo, float hi) { unsigned r; asm volatile("v_cvt_pk_bf16_f32 %0, %1, %2" : "=v"(r) : "v"(lo), "v"(hi)); return r; }
#define EPI_GEOM int t_ = threadIdx.x; asm volatile("" : "+v"(t_)); const int wid_ = t_ >> 6, wr = wid_ >> 2, wc = wid_ & 3, fr = t_ & 15, fq = (t_ & 63) >> 4;
__device__ __forceinline__ u32x4 pack8(const f32x4 v0, const f32x4 v1) { u32x4 w; w.x = cvt_pk_bf16(v0[0], v0[1]); w.y = cvt_pk_bf16(v0[2], v0[3]); w.z = cvt_pk_bf16(v1[0], v1[1]); w.w = cvt_pk_bf16(v1[2], v1[3]); return w; }
__device__ __forceinline__ float* out_row(float* out, size_t offp, size_t offs, int row, int width) {
    if (row < MP) return out + offp + (size_t)row * width;
    if (row < MT) return out + offs + (size_t)(row - MP) * width;
    return nullptr;
}
struct EpiIn {
    static constexpr bool PERM = true, AFTER_DRAIN = false, MIDK = false;
    bf16_t *QB, *KB, *VB, *GQ, *GZ, *GT; float *GAB, *LGF; float* out;
    const PG8_LAS float* par;
    __device__ __forceinline__ void operator()(const f32x4 (&acc)[2][2][4][2], const Unit& u, int, int, int, int) const {
        EPI_GEOM
        const int pn = u.pn; const int row0 = u.pm * BM + wr * 64 + fr;
        if (pn < 4) {
            const bool isk = pn >= 2; const int head = 4 * (pn & 1) + wc; const PG8_LAS float* gv = par + (isk ? 64 : 0);
            f32x4 g[2][2];
#pragma unroll
            for (int bj = 0; bj < 2; ++bj)
#pragma unroll
                for (int n = 0; n < 2; ++n) g[bj][n] = *(const PG8_LAS f32x4*)(gv + 32 * bj + 8 * fq + 4 * n);
#pragma unroll
            for (int ai = 0; ai < 2; ++ai)
#pragma unroll
                for (int m = 0; m < 4; ++m) {
                    float ss = 0.f;
#pragma unroll
                    for (int bj = 0; bj < 2; ++bj)
#pragma unroll
                        for (int n = 0; n < 2; ++n) { const f32x4 x = acc[ai][bj][m][n]; ss += (x[0] * x[0] + x[1] * x[1]) + (x[2] * x[2] + x[3] * x[3]); }
                    ss += __shfl_xor(ss, 16); ss += __shfl_xor(ss, 32);
                    float rs = __builtin_amdgcn_rsqf(ss * (1.0f / 64.0f) + EPS); if (!isk) rs *= C2;
                    const int row = row0 + ai * HALF + m * 16;
                    float* orow = isk ? out_row(out, OFF_KP, OFF_KS, row, FW) : nullptr;
#pragma unroll
                    for (int bj = 0; bj < 2; ++bj) {
                        const f32x4 v0 = acc[ai][bj][m][0] * rs * g[bj][0], v1 = acc[ai][bj][m][1] * rs * g[bj][1];
                        const int col = head * 64 + 32 * bj + 8 * fq;
                        *(u32x4*)((isk ? KB : QB) + (size_t)row * FW + col) = pack8(v0, v1);
                        if (orow) { *(f32x4*)(orow + col) = v0; *(f32x4*)(orow + col + 4) = v1; }
                    }
                }
        } else if (pn < 6) {
#pragma unroll
            for (int ai = 0; ai < 2; ++ai)
#pragma unroll
                for (int m = 0; m < 4; ++m) { const int row = row0 + ai * HALF + m * 16; float* orow = out_row(out, OFF_VP, OFF_VS, row, FW);
#pragma unroll
                    for (int bj = 0; bj < 2; ++bj) { const int col = 256 * (pn - 4) + 128 * bj + 32 * wc + 8 * fq; const f32x4 v0 = acc[ai][bj][m][0], v1 = acc[ai][bj][m][1];
                        *(u32x4*)(VB + (size_t)row * FW + col) = pack8(v0, v1);
                        if (orow) { *(f32x4*)(orow + col) = v0; *(f32x4*)(orow + col + 4) = v1; } } }
        } else if (pn < 12) {
#pragma unroll
            for (int ai = 0; ai < 2; ++ai)
#pragma unroll
                for (int m = 0; m < 4; ++m) { const int row = row0 + ai * HALF + m * 16;
#pragma unroll
                    for (int bj = 0; bj < 2; ++bj) { const int col = 256 * (pn - 6) + 128 * bj + 32 * wc + 8 * fq;
                        *(u32x4*)(GQ + (size_t)row * CCH + col) = pack8(acc[ai][bj][m][0], acc[ai][bj][m][1]); } }
        } else if (pn < 14) {
#pragma unroll
            for (int ai = 0; ai < 2; ++ai)
#pragma unroll
                for (int m = 0; m < 4; ++m) { const int row = row0 + ai * HALF + m * 16;
#pragma unroll
                    for (int bj = 0; bj < 2; ++bj) { const int col = 256 * (pn - 12) + 128 * bj + 32 * wc + 8 * fq; f32x4 v0 = acc[ai][bj][m][0], v1 = acc[ai][bj][m][1];
#pragma unroll
                        for (int i = 0; i < 4; ++i) { v0[i] = v0[i] * __builtin_amdgcn_rcpf(1.0f + __expf(-v0[i])); v1[i] = v1[i] * __builtin_amdgcn_rcpf(1.0f + __expf(-v1[i])); }
                        *(u32x4*)(GZ + (size_t)row * 512 + col) = pack8(v0, v1); } }
        } else if (pn < 22) {
#pragma unroll
            for (int ai = 0; ai < 2; ++ai)
#pragma unroll
                for (int m = 0; m < 4; ++m) { const int row = row0 + ai * HALF + m * 16;
#pragma unroll
                    for (int bj = 0; bj < 2; ++bj) { const int col = 256 * (pn - 14) + 128 * bj + 32 * wc + 8 * fq; f32x4 v0 = acc[ai][bj][m][0], v1 = acc[ai][bj][m][1];
#pragma unroll
                        for (int i = 0; i < 4; ++i) { v0[i] = __builtin_amdgcn_rcpf(1.0f + __expf(-v0[i])); v1[i] = __builtin_amdgcn_rcpf(1.0f + __expf(-v1[i])); }
                        *(u32x4*)(GT + (size_t)row * 2048 + col) = pack8(v0, v1); } }
        } else {
            if (wc == 0 && fq < 2) {
#pragma unroll
                for (int ai = 0; ai < 2; ++ai)
#pragma unroll
                    for (int m = 0; m < 4; ++m) { const int row = row0 + ai * HALF + m * 16; const f32x4 a0 = acc[ai][0][m][0], a1 = acc[ai][0][m][1];
                        if (fq == 0) { f32x4 l0, l1;
#pragma unroll
                            for (int i = 0; i < 4; ++i) { l0[i] = log_sigmoidf_(a0[i] + par[128 + i]); l1[i] = log_sigmoidf_(a1[i] + par[132 + i]); }
                            *(f32x4*)(LGF + (size_t)row * 8) = l0; *(f32x4*)(LGF + (size_t)row * 8 + 4) = l1;
                            float* orow = out_row(out, OFF_LFP, OFF_LFS, row, 8); if (orow) { *(f32x4*)orow = l0; *(f32x4*)(orow + 4) = l1; }
                        } else { f32x4 ld, be;
#pragma unroll
                            for (int i = 0; i < 4; ++i) { ld[i] = par[136 + i] * softplusf_(a0[i] + par[140 + i]); be[i] = __builtin_amdgcn_rcpf(1.0f + __expf(-a1[i])); }
                            *(f32x4*)(GAB + (size_t)row * 8) = ld; *(f32x4*)(GAB + (size_t)row * 8 + 4) = be; } }
            }
        }
    }
};
template <int ACT> struct EpiBf {
    static constexpr bool PERM = true, AFTER_DRAIN = false, MIDK = false;
    bf16_t* O; int ldc; const float* ss;
    __device__ __forceinline__ void operator()(const f32x4 (&acc)[2][2][4][2], const Unit& u, int, int, int, int) const {
        EPI_GEOM
        const int row0 = u.pm * BM + wr * 64 + fr, col0 = u.pn * BM + wc * 32 + 8 * fq;
        float rsv[8];
        if (ACT == 1) {
#pragma unroll
            for (int g = 0; g < 8; ++g) rsv[g] = ss[row0 + (g >> 2) * HALF + (g & 3) * 16];
#pragma unroll
            for (int g = 0; g < 8; ++g) rsv[g] = __builtin_amdgcn_rsqf(rsv[g] * (1.0f / D) + EPS);
        }
#pragma unroll
        for (int ai = 0; ai < 2; ++ai)
#pragma unroll
            for (int m = 0; m < 4; ++m) { const int row = row0 + ai * HALF + m * 16; const float rs = (ACT == 1) ? rsv[ai * 4 + m] : 1.f;
#pragma unroll
                for (int bj = 0; bj < 2; ++bj) { f32x4 v0 = acc[ai][bj][m][0], v1 = acc[ai][bj][m][1];
                    if (ACT == 1 || ACT == 2) {
#pragma unroll
                        for (int i = 0; i < 4; ++i) { float a = fmaxf(v0[i] * rs, 0.f), b = fmaxf(v1[i] * rs, 0.f); v0[i] = a * a; v1[i] = b * b; } }
                    *(u32x4*)(O + (size_t)row * ldc + col0 + bj * HALF) = pack8(v0, v1); } }
    }
};
struct EpiMerge {
    static constexpr bool PERM = true, AFTER_DRAIN = false, MIDK = true;
    bf16_t* O; const bf16_t* GT;
    __device__ __forceinline__ void mid(f32x4 (&acc)[2][2][4][2], const Unit& u, int, int, int, int) const {
        int t_ = threadIdx.x; asm volatile("" : "+v"(t_));
        const int wid_ = t_ >> 6, wr = wid_ >> 2, wc = wid_ & 3, fr = t_ & 15, fq = (t_ & 63) >> 4;
        const int row0 = u.pm * BM + wr * 64 + fr, col0 = u.pn * BM + wc * 32 + 8 * fq;
        u32x4 ga[2], gb[2], na[2], nb[2];
        { const bf16_t* gp = GT + (size_t)row0 * 2048 + col0; ga[0] = *(const u32x4*)gp; ga[1] = *(const u32x4*)(gp + HALF); gb[0] = *(const u32x4*)(gp + 1024); gb[1] = *(const u32x4*)(gp + 1024 + HALF); }
#pragma unroll
        for (int g = 0; g < 8; ++g) { const int ai = g >> 2, m = g & 3;
            if (g < 7) { const bf16_t* gp = GT + (size_t)(row0 + ((g + 1) >> 2) * HALF + ((g + 1) & 3) * 16) * 2048 + col0; na[0] = *(const u32x4*)gp; na[1] = *(const u32x4*)(gp + HALF); nb[0] = *(const u32x4*)(gp + 1024); nb[1] = *(const u32x4*)(gp + 1024 + HALF); }
#pragma unroll
            for (int bj = 0; bj < 2; ++bj)
#pragma unroll
                for (int w = 0; w < 4; ++w) { const float a0 = bflo(ga[bj][w]), a1 = bfhi(ga[bj][w]), b0 = fmaxf(bflo(gb[bj][w]), 1e-30f), b1 = fmaxf(bfhi(gb[bj][w]), 1e-30f);
                    acc[ai][bj][m][w >> 1][(w & 1) * 2] *= a0 * __builtin_amdgcn_rcpf(b0); acc[ai][bj][m][w >> 1][(w & 1) * 2 + 1] *= a1 * __builtin_amdgcn_rcpf(b1); }
            asm volatile("" : "+v"(acc[ai][0][m][0]), "+v"(acc[ai][0][m][1]), "+v"(acc[ai][1][m][0]), "+v"(acc[ai][1][m][1]) :: "memory");
            ga[0] = na[0]; ga[1] = na[1]; gb[0] = nb[0]; gb[1] = nb[1]; }
    }
    __device__ __forceinline__ void operator()(const f32x4 (&acc)[2][2][4][2], const Unit& u, int, int, int, int) const {
        EPI_GEOM
        const int row0 = u.pm * BM + wr * 64 + fr, col0 = u.pn * BM + wc * 32 + 8 * fq;
        u32x4 gb[2], nb[2];
        { const bf16_t* gp = GT + (size_t)row0 * 2048 + 1024 + col0; gb[0] = *(const u32x4*)gp; gb[1] = *(const u32x4*)(gp + HALF); }
#pragma unroll
        for (int g = 0; g < 8; ++g) { const int ai = g >> 2, m = g & 3; const int row = row0 + ai * HALF + m * 16;
            if (g < 7) { const bf16_t* gp = GT + (size_t)(row0 + ((g + 1) >> 2) * HALF + ((g + 1) & 3) * 16) * 2048 + 1024 + col0; nb[0] = *(const u32x4*)gp; nb[1] = *(const u32x4*)(gp + HALF); }
#pragma unroll
            for (int bj = 0; bj < 2; ++bj) { f32x4 v0 = acc[ai][bj][m][0], v1 = acc[ai][bj][m][1]; const u32x4 q = gb[bj];
                v0[0] *= fmaxf(bflo(q[0]), 1e-30f); v0[1] *= fmaxf(bfhi(q[0]), 1e-30f); v0[2] *= fmaxf(bflo(q[1]), 1e-30f); v0[3] *= fmaxf(bfhi(q[1]), 1e-30f);
                v1[0] *= fmaxf(bflo(q[2]), 1e-30f); v1[1] *= fmaxf(bfhi(q[2]), 1e-30f); v1[2] *= fmaxf(bflo(q[3]), 1e-30f); v1[3] *= fmaxf(bfhi(q[3]), 1e-30f);
                *(u32x4*)(O + (size_t)row * D + col0 + bj * HALF) = pack8(v0, v1); }
            gb[0] = nb[0]; gb[1] = nb[1]; }
    }
};
template <bool BASE16, bool SCALE> struct EpiRes {
    static constexpr bool PERM = false, AFTER_DRAIN = false, MIDK = false;
    const void* base; bf16_t* XB; float* ss; const float* ss_in;
    __device__ __forceinline__ void operator()(const f32x4 (&acc)[2][2][4][2], const Unit& u, int, int, int, int) const {
        EPI_GEOM
        const int row0 = u.pm * BM + wr * 64 + fr, col0 = u.pn * BM + wc * 32 + 4 * fq;
        f32x4 cur[2][2], nxt[2][2];
        auto ld = [&](int g, f32x4 (&d)[2][2]) { const size_t o = (size_t)(row0 + (g >> 2) * HALF + (g & 3) * 16) * D + col0;
#pragma unroll
            for (int bj = 0; bj < 2; ++bj)
#pragma unroll
                for (int n = 0; n < 2; ++n) {
                    if constexpr (BASE16) { const v2u w = *(const v2u*)((const bf16_t*)base + o + bj * HALF + n * 16); d[bj][n] = (f32x4){bflo(w.x), bfhi(w.x), bflo(w.y), bfhi(w.y)}; }
                    else d[bj][n] = *(const f32x4*)((const float*)base + o + bj * HALF + n * 16); } };
        float r2[8];
        if constexpr (SCALE) {
#pragma unroll
            for (int g = 0; g < 8; ++g) r2[g] = ss_in[row0 + (g >> 2) * HALF + (g & 3) * 16];
        }
        ld(0, cur);
#pragma unroll
        for (int g = 0; g < 8; ++g) { const int ai = g >> 2, m = g & 3; const int row = row0 + ai * HALF + m * 16;
            if (g < 7) ld(g + 1, nxt);
            float sc = 1.f; if constexpr (SCALE) sc = __builtin_amdgcn_rcpf(r2[g] * (1.0f / D) + EPS);
            float s = 0.f;
#pragma unroll
            for (int bj = 0; bj < 2; ++bj)
#pragma unroll
                for (int n = 0; n < 2; ++n) { const int col = col0 + bj * HALF + n * 16; const f32x4 v = acc[ai][bj][m][n] * sc + cur[bj][n];
                    s += (v[0] * v[0] + v[1] * v[1]) + (v[2] * v[2] + v[3] * v[3]);
                    v2u w; w.x = cvt_pk_bf16(v[0], v[1]); w.y = cvt_pk_bf16(v[2], v[3]); *(v2u*)(XB + (size_t)row * D + col) = w; }
            s += __shfl_xor(s, 16); s += __shfl_xor(s, 32);
            if (fq == 0) atomicAdd(ss + row, s);
#pragma unroll
            for (int bj = 0; bj < 2; ++bj)
#pragma unroll
                for (int n = 0; n < 2; ++n) cur[bj][n] = nxt[bj][n]; }
    }
};
struct EpiFinal {
    static constexpr bool PERM = false, AFTER_DRAIN = false, MIDK = false;
    const bf16_t* X2B; const bf16_t* PL; const float* ss; float* out;
    __device__ __forceinline__ void operator()(const f32x4 (&acc)[2][2][4][2], const Unit& u, int, int, int, int) const {
        EPI_GEOM
        const int row0 = u.pm * BM + wr * 64 + fr, col0 = u.pn * BM + wc * 32 + 4 * fq;
        float rsv[8];
#pragma unroll
        for (int g = 0; g < 8; ++g) rsv[g] = ss[row0 + (g >> 2) * HALF + (g & 3) * 16];
        v2u cx[2][2], nx[2][2], cp[2][2], np[2][2];
        { const size_t o = (size_t)row0 * D + col0;
#pragma unroll
          for (int bj = 0; bj < 2; ++bj)
#pragma unroll
            for (int n = 0; n < 2; ++n) { cx[bj][n] = *(const v2u*)(X2B + o + bj * HALF + n * 16); cp[bj][n] = *(const v2u*)(PL + o + bj * HALF + n * 16); } }
#pragma unroll
        for (int g = 0; g < 8; ++g) { const int ai = g >> 2, m = g & 3; const int row = row0 + ai * HALF + m * 16;
            if (g < 7) { const size_t o = (size_t)(row0 + ((g + 1) >> 2) * HALF + ((g + 1) & 3) * 16) * D + col0;
#pragma unroll
                for (int bj = 0; bj < 2; ++bj)
#pragma unroll
                    for (int n = 0; n < 2; ++n) { nx[bj][n] = *(const v2u*)(X2B + o + bj * HALF + n * 16); np[bj][n] = *(const v2u*)(PL + o + bj * HALF + n * 16); } }
            const float rs = __builtin_amdgcn_rsqf(rsv[g] * (1.0f / D) + EPS);
#pragma unroll
            for (int bj = 0; bj < 2; ++bj)
#pragma unroll
                for (int n = 0; n < 2; ++n) { const int col = col0 + bj * HALF + n * 16; const f32x4 a = acc[ai][bj][m][n]; const v2u x = cx[bj][n]; const v2u p = cp[bj][n]; f32x4 y;
                    y[0] = bflo(x.x) + bflo(p.x) * __builtin_amdgcn_rcpf(1.0f + __expf(-a[0] * rs)); y[1] = bfhi(x.x) + bfhi(p.x) * __builtin_amdgcn_rcpf(1.0f + __expf(-a[1] * rs));
                    y[2] = bflo(x.y) + bflo(p.y) * __builtin_amdgcn_rcpf(1.0f + __expf(-a[2] * rs)); y[3] = bfhi(x.y) + bfhi(p.y) * __builtin_amdgcn_rcpf(1.0f + __expf(-a[3] * rs));
                    *(f32x4*)(out + (size_t)row * D + col) = y; }
#pragma unroll
            for (int bj = 0; bj < 2; ++bj)
#pragma unroll
                for (int n = 0; n < 2; ++n) { cx[bj][n] = nx[bj][n]; cp[bj][n] = np[bj][n]; } }
    }
};
template <class Epi, class Sched, bool ALIGN_EPI = false, bool SP2 = false>
__device__ __forceinline__ void gemm_phase(PG8_LAS unsigned char* lds, const Gemm g, const Sched& S, const Epi& E) {
    int tid_ = threadIdx.x; asm volatile("" : "+v"(tid_));
    const int tid = tid_, wid = __builtin_amdgcn_readfirstlane(tid >> 6), lane = tid & 63, wr = wid >> 2, wc = wid & 3, fr = lane & 15, fq = lane >> 4;
    const int K = g.K, nt = K / BK;
    unsigned voffA[2], voffB[2];
#pragma unroll
    for (int i = 0; i < 2; ++i) { int R, C; stage_rc(tid * 16 + i * 8192, R, C); const int Rb = Epi::PERM ? ((R & ~31) + perm32(R & 31)) : R;
        voffA[i] = (unsigned)(R * K + C) * 2u; voffB[i] = (unsigned)(Rb * K + C) * 2u; }
    const size_t kstep = (size_t)(BK * 2);
    const size_t hstep = (size_t)HALF * K * 2;
    const size_t tstep = 2 * hstep;
    const unsigned ldsw = (unsigned)wid * 1024u;
    const int aoff = lds_byte(wr * 64 + fr, fq * 8), boff = lds_byte(wc * 32 + fr, fq * 8);
#define PG8_SA(b, h) (((b) * 2 + (h)) * HTB)
#define PG8_SB(b, h) ((4 + (b) * 2 + (h)) * HTB)
#define PG8_STAGE(bufoff, gbase, voff) do { _Pragma("unroll") for (int _i = 0; _i < 2; ++_i) \
        __builtin_amdgcn_global_load_lds((const unsigned*)((const char*)(gbase) + (voff)[_i]), (PG8_LAS unsigned*)(lds + (bufoff) + ldsw + _i * 8192), 16, 0, 0); } while (0)
#define PG8_LDA(dst, b, h) do { _Pragma("unroll") for (int m = 0; m < 4; ++m) _Pragma("unroll") for (int k = 0; k < 2; ++k) dst[m][k] = *(const PG8_LAS bf16x8*)(lds + PG8_SA(b, h) + aoff + m * 2048 + k * 1024); } while (0)
#define PG8_LDB(dst, b, h) do { _Pragma("unroll") for (int n = 0; n < 2; ++n) _Pragma("unroll") for (int k = 0; k < 2; ++k) dst[n][k] = *(const PG8_LAS bf16x8*)(lds + PG8_SB(b, h) + boff + n * 2048 + k * 1024); } while (0)
#define PG8_MMA(ai, bj, At, Bt) do { __builtin_amdgcn_s_setprio(1); _Pragma("unroll") for (int m = 0; m < 4; ++m) _Pragma("unroll") for (int n = 0; n < 2; ++n) _Pragma("unroll") for (int k = 0; k < 2; ++k) \
        acc[ai][bj][m][n] = __builtin_amdgcn_mfma_f32_16x16x32_bf16(Bt[n][k], At[m][k], acc[ai][bj][m][n], 0, 0, 0); __builtin_amdgcn_s_setprio(0); } while (0)
#define PG8_WAIT_V(n) asm volatile("s_waitcnt vmcnt(" #n ")" ::: "memory")
#define PG8_WAIT_L(n) asm volatile("s_waitcnt lgkmcnt(" #n ")" ::: "memory")
#define PG8_BAR __builtin_amdgcn_s_barrier()
#define PG8_SCHED __builtin_amdgcn_sched_barrier(0)
    Unit cur, nxt; int ui = 0;
    if (!S.next(0, cur)) return;
    f32x4 acc[2][2][4][2];
#pragma unroll
    for (int a = 0; a < 2; ++a)
#pragma unroll
        for (int b = 0; b < 2; ++b)
#pragma unroll
            for (int m = 0; m < 4; ++m)
#pragma unroll
                for (int n = 0; n < 2; ++n) acc[a][b][m][n] = (f32x4){0.f, 0.f, 0.f, 0.f};
    bf16x8 At[4][2], B0[2][2], B1[2][2];
    const char* cA = (const char*)g.A + (size_t)cur.pm * tstep; const char* cB = (const char*)g.Bt + (size_t)cur.pn * tstep;
    S.a_ready(cur);
    if constexpr (SP2) {
        PG8_STAGE(PG8_SB(0, 0), cB, voffB); PG8_STAGE(PG8_SB(0, 1), cB + hstep, voffB); PG8_STAGE(PG8_SA(0, 0), cA, voffA); PG8_STAGE(PG8_SA(0, 1), cA + hstep, voffA);
        if (wr == 1) PG8_BAR;
        PG8_WAIT_V(2); PG8_BAR;
        PG8_STAGE(PG8_SB(1, 0), cB + kstep, voffB); PG8_STAGE(PG8_SA(1, 0), cA + kstep, voffA); PG8_STAGE(PG8_SB(1, 1), cB + hstep + kstep, voffB);
        PG8_WAIT_V(6); PG8_BAR;
    } else {
        PG8_STAGE(PG8_SB(0, 0), cB, voffB); PG8_STAGE(PG8_SA(0, 0), cA, voffA); PG8_STAGE(PG8_SB(0, 1), cB + hstep, voffB); PG8_STAGE(PG8_SA(0, 1), cA + hstep, voffA);
        if (wr == 1) PG8_BAR;
        PG8_WAIT_V(4); PG8_BAR;
        PG8_STAGE(PG8_SB(1, 0), cB + kstep, voffB); PG8_STAGE(PG8_SA(1, 0), cA + kstep, voffA); PG8_STAGE(PG8_SB(1, 1), cB + hstep + kstep, voffB);
        PG8_WAIT_V(6); PG8_BAR;
    }
    for (;;) {
        S.prefetch(ui + 1);
        bool has_next = false; const char* nA = cA; const char* nB = cB;
#pragma unroll 1
        for (int t = 0; t < nt; t += 2) {
            if constexpr (Epi::MIDK) { if (t == (nt >> 1)) E.mid(acc, cur, wr, wc, fr, fq); }
            const bool last = (t == nt - 2);
            if (last) { has_next = S.next(ui + 1, nxt); if (has_next) { nA = (const char*)g.A + (size_t)nxt.pm * tstep; nB = (const char*)g.Bt + (size_t)nxt.pn * tstep; } }
            const char* a1 = cA + (size_t)(t + 1) * kstep;
            const char* a2 = last ? nA : cA + (size_t)(t + 2) * kstep; const char* b2 = last ? nB : cB + (size_t)(t + 2) * kstep;
            const char* a3 = a2 + kstep; const char* b3 = b2 + kstep;
            if (last && has_next) S.a_ready(nxt);
            if constexpr (SP2) {
            PG8_LDB(B0, 0, 0); PG8_LDB(B1, 0, 1); PG8_SCHED; PG8_LDA(At, 0, 0); PG8_STAGE(PG8_SA(1, 1), a1 + hstep, voffA);
            PG8_WAIT_V(8); PG8_WAIT_L(0); PG8_BAR; PG8_MMA(0, 0, At, B0); PG8_MMA(0, 1, At, B1); PG8_BAR; PG8_SCHED;
            PG8_LDA(At, 0, 1); PG8_STAGE(PG8_SB(0, 0), b2, voffB); PG8_STAGE(PG8_SB(0, 1), b2 + hstep, voffB); PG8_STAGE(PG8_SA(0, 0), a2, voffA);
            PG8_WAIT_V(8); PG8_WAIT_L(0); PG8_BAR; PG8_MMA(1, 0, At, B0); PG8_MMA(1, 1, At, B1); PG8_BAR; PG8_SCHED;
            PG8_LDB(B0, 1, 0); PG8_LDB(B1, 1, 1); PG8_SCHED; PG8_LDA(At, 1, 0); PG8_STAGE(PG8_SA(0, 1), a2 + hstep, voffA);
            PG8_WAIT_V(8); PG8_WAIT_L(0); PG8_BAR; PG8_MMA(0, 0, At, B0); PG8_MMA(0, 1, At, B1); PG8_BAR; PG8_SCHED;
            PG8_LDA(At, 1, 1); PG8_STAGE(PG8_SB(1, 0), b3, voffB); PG8_STAGE(PG8_SB(1, 1), b3 + hstep, voffB); PG8_STAGE(PG8_SA(1, 0), a3, voffA);
            PG8_WAIT_V(8); PG8_WAIT_L(0); PG8_BAR; PG8_MMA(1, 0, At, B0); PG8_MMA(1, 1, At, B1); PG8_BAR; PG8_SCHED;
            } else {
            PG8_LDB(B0, 0, 0); PG8_SCHED; PG8_LDA(At, 0, 0); PG8_STAGE(PG8_SA(1, 1), a1 + hstep, voffA);
            PG8_WAIT_L(8); PG8_BAR; PG8_WAIT_L(0); PG8_MMA(0, 0, At, B0); PG8_BAR; PG8_SCHED;
            PG8_LDB(B1, 0, 1); PG8_STAGE(PG8_SB(0, 0), b2, voffB);
            PG8_BAR; PG8_WAIT_L(0); PG8_MMA(0, 1, At, B1); PG8_BAR;
            PG8_LDA(At, 0, 1); PG8_STAGE(PG8_SA(0, 0), a2, voffA);
            PG8_BAR; PG8_WAIT_L(0); PG8_MMA(1, 0, At, B0); PG8_BAR; PG8_SCHED;
            PG8_STAGE(PG8_SB(0, 1), b2 + hstep, voffB);
            PG8_WAIT_V(6); PG8_BAR; PG8_MMA(1, 1, At, B1); PG8_BAR;
            PG8_LDB(B0, 1, 0); PG8_SCHED; PG8_LDA(At, 1, 0); PG8_STAGE(PG8_SA(0, 1), a2 + hstep, voffA);
            PG8_WAIT_L(8); PG8_BAR; PG8_WAIT_L(0); PG8_MMA(0, 0, At, B0); PG8_BAR; PG8_SCHED;
            PG8_LDB(B1, 1, 1); PG8_STAGE(PG8_SB(1, 0), b3, voffB);
            PG8_BAR; PG8_WAIT_L(0); PG8_MMA(0, 1, At, B1); PG8_BAR;
            PG8_LDA(At, 1, 1); PG8_STAGE(PG8_SA(1, 0), a3, voffA);
            PG8_BAR; PG8_WAIT_L(0); PG8_MMA(1, 0, At, B0); PG8_BAR; PG8_SCHED;
            PG8_STAGE(PG8_SB(1, 1), b3 + hstep, voffB);
            PG8_WAIT_V(6); PG8_BAR; PG8_MMA(1, 1, At, B1); PG8_BAR;
            }
        }
        if constexpr (ALIGN_EPI) { if (wr == 0) PG8_BAR; }
        if constexpr (!Epi::AFTER_DRAIN) { E(acc, cur, wr, wc, fr, fq); S.done(cur); }
        if (!has_next) break;
#pragma unroll
        for (int a = 0; a < 2; ++a)
#pragma unroll
            for (int b = 0; b < 2; ++b)
#pragma unroll
                for (int m = 0; m < 4; ++m)
#pragma unroll
                    for (int n = 0; n < 2; ++n) acc[a][b][m][n] = (f32x4){0.f, 0.f, 0.f, 0.f};
        cur = nxt; cA = nA; cB = nB; ++ui;
        if constexpr (ALIGN_EPI) { if (wr == 1) PG8_BAR; }
    }
    PG8_WAIT_V(0);
    if constexpr (!ALIGN_EPI) { if (wr == 0) PG8_BAR; }
    PG8_BAR;
    if constexpr (Epi::AFTER_DRAIN) { E.fused(acc, cur, wr, wc, fr, fq, lds, wid, lane); S.done(cur); }
#undef PG8_SA
#undef PG8_SB
#undef PG8_STAGE
#undef PG8_LDA
#undef PG8_LDB
#undef PG8_MMA
#undef PG8_WAIT_V
#undef PG8_WAIT_L
#undef PG8_BAR
#undef PG8_SCHED
}
}
#define XB_TMO      128
#define XB_XCNT(j)  (256  + 64 * (j))
#define XB_XSUB(j)  (1280 + 64 * (j))
#define XB_XGEN(j)  (2304 + 64 * (j))
#define XB_TOP      3328
#define XB_TOPGEN   3392
#define XCD_BAR_WORDS 3456
#define XB_SPIN_CAP (1u << 18)

__device__ __forceinline__ unsigned xb_ld(unsigned* p)              { return __hip_atomic_load(p, __ATOMIC_RELAXED, __HIP_MEMORY_SCOPE_AGENT); }
__device__ __forceinline__ unsigned xb_add(unsigned* p, unsigned v) { return __hip_atomic_fetch_add(p, v, __ATOMIC_RELAXED, __HIP_MEMORY_SCOPE_AGENT); }
__device__ __forceinline__ unsigned xb_xcc_id() { return (unsigned)__builtin_amdgcn_s_getreg((3 << 11) | 20) & 0xFu; }
#define XB_SPIN(cond, bar) do { unsigned _sp = 0; while (cond) { __builtin_amdgcn_s_sleep(1); \
    if ((++_sp & 255u) == 0u) { if (xb_ld(&(bar)[XB_TMO])) break; if (_sp > XB_SPIN_CAP) { atomicAdd(&(bar)[XB_TMO], 1u); break; } } } } while (0)

struct XcdBarrier {
    unsigned* bar; unsigned x;
    volatile LAS unsigned* st;
};

__device__ __forceinline__ XcdBarrier xcd_barrier_post(unsigned* bar, volatile LAS unsigned* st) {
    XcdBarrier b; b.bar = bar; b.x = xb_xcc_id(); b.st = st;
    if (threadIdx.x == 0) (void)xb_add(&bar[XB_XCNT(b.x)], 1u);
    return b;
}
__device__ __forceinline__ void xcd_barrier_complete(unsigned* bar, unsigned x, unsigned& nloc, unsigned& nx) {
    const unsigned G = gridDim.x * gridDim.y * gridDim.z;
    unsigned sum, cnt, mine, sp = 0u;
    for (;;) {
        sum = 0u; cnt = 0u; mine = 0u;
#pragma unroll
        for (unsigned j = 0; j < 16; ++j) { const unsigned c = xb_ld(&bar[XB_XCNT(j)]); sum += c; cnt += (c > 0u) ? 1u : 0u; mine = (j == x) ? c : mine; }
        if (sum == G) break;
        __builtin_amdgcn_s_sleep(1);
        if ((++sp & 255u) == 0u) { if (xb_ld(&bar[XB_TMO])) break; if (sp > XB_SPIN_CAP) { atomicAdd(&bar[XB_TMO], 1u); break; } }
    }
    nloc = mine > 0u ? mine : 1u; nx = cnt > 0u ? cnt : 1u;
}

__device__ __forceinline__ void xcd_barrier(const XcdBarrier& b) {
    asm volatile("s_waitcnt vmcnt(0)" ::: "memory");
    __syncthreads();
    if (threadIdx.x == 0) {
        unsigned* bar = b.bar;
        __builtin_amdgcn_s_waitcnt(0);
        unsigned nloc = b.st[0], nx = b.st[1];
        if (nloc == 0u) { xcd_barrier_complete(bar, b.x, nloc, nx); b.st[0] = nloc; b.st[1] = nx; }
        const unsigned old = xb_add(&bar[XB_XSUB(b.x)], 1u);
        const unsigned gen = old / nloc;
        if (old + 1u == (gen + 1u) * nloc) {
            __builtin_amdgcn_fence(__ATOMIC_RELEASE, "agent");
            asm volatile("s_waitcnt vmcnt(0)" ::: "memory");
            const unsigned og = xb_add(&bar[XB_TOP], 1u);
            const unsigned tg = og / nx;
            if (og + 1u == (tg + 1u) * nx) xb_add(&bar[XB_TOPGEN], 1u);
            else XB_SPIN(xb_ld(&bar[XB_TOPGEN]) == tg, bar);
            __builtin_amdgcn_fence(__ATOMIC_ACQUIRE, "agent");
            xb_add(&bar[XB_XGEN(b.x)], 1u);
            asm volatile("s_waitcnt vmcnt(0)" ::: "memory");
        } else {
            XB_SPIN(xb_ld(&bar[XB_XGEN(b.x)]) == gen, bar);
            __builtin_amdgcn_fence(__ATOMIC_ACQUIRE, "agent");
            asm volatile("s_waitcnt vmcnt(0)" ::: "memory");
        }
    }
    __syncthreads();
}
struct Frame {
    LAS unsigned char* lds;
    volatile LAS unsigned* MISC;
    gu32* ctl;
    int tid, lane, wave;
    int vcu, G;
    unsigned char* ws; float* out;
    const float* in[28]; const int* page_table;
};
struct Args { const void* in[28]; float* out; unsigned char* ws; int ph_lo, ph_hi, li, pad; };

__device__ __forceinline__ int in_srccol(int n0) {
    if (n0 < 1024) { const int t = n0 >> 8, w = n0 & 255, bj = w >> 7, wc = (w & 127) >> 5; return 256 * t + 64 * wc + 32 * bj; }
    if (n0 < 1536) return n0;
    if (n0 < 3072) return n0 + 8;
    return n0 + 16;
}
__device__ __forceinline__ void p0_transpose_item(const float* W, int ldw, bf16* WT, int ldk, int koff, int k0, int n0dst, int n0src, const float* gain, LAS float* scr, int lane) {
    { float v[32];
#pragma unroll
      for (int i = 0; i < 32; ++i) v[i] = W[(size_t)(k0 + 2 * i + (lane >> 5)) * ldw + n0src + (lane & 31)];
      if (gain) {
#pragma unroll
          for (int i = 0; i < 32; ++i) v[i] *= gain[k0 + 2 * i + (lane >> 5)]; }
#pragma unroll
      for (int i = 0; i < 32; ++i) scr[(2 * i + (lane >> 5)) * 33 + (lane & 31)] = v[i]; }
    LDS_WAIT(); asm volatile("" ::: "memory");
    const int c = lane & 7;
#pragma unroll
    for (int j = 0; j < 4; ++j) { const int n = (lane >> 3) + 8 * j; const LAS float* s = scr + (8 * c) * 33 + n;
        v4u o; o.x = pk2(s[0 * 33], s[1 * 33]); o.y = pk2(s[2 * 33], s[3 * 33]); o.z = pk2(s[4 * 33], s[5 * 33]); o.w = pk2(s[6 * 33], s[7 * 33]);
        *(GAS v4u*)(WT + (size_t)(n0dst + n) * ldk + koff + k0 + 8 * c) = o; }
    LDS_WAIT(); asm volatile("" ::: "memory");
}
__device__ __forceinline__ void p0_prologue(Frame& F) {
    LAS float* scr = (LAS float*)(F.lds + RING_OFF + F.wave * 16384);
    const int gw = F.vcu * NWAVES + F.wave, NGW = F.G * NWAVES;
    bf16* WIN = (bf16*)(F.ws + WS_WIN); bf16* WAB = (bf16*)(F.ws + WS_WAB); bf16* WOUT = (bf16*)(F.ws + WS_WOUT); bf16* WUP = (bf16*)(F.ws + WS_WUP);
    bf16* WDN = (bf16*)(F.ws + WS_WDN); bf16* WGT = (bf16*)(F.ws + WS_WGT); bf16* WPL = (bf16*)(F.ws + WS_WPL);
    constexpr int I_IN = 16 * 176, I_A = 8 * 32, I_B = 8 * 32, I_O = 16 * 32, I_UP = 16 * 128, I_DN = 64 * 32, I_G = 16 * 32, I_P = 4 * 32;
    constexpr int NITEMS = I_IN + I_A + I_B + I_O + I_UP + I_DN + I_G + I_P;
    for (int it = gw; it < NITEMS; it += NGW) {
        int r = it;
        if (r < I_IN) { const int kb = r / 176, nb = r % 176; p0_transpose_item(F.in[11], DIN, WIN, D, 0, 64 * kb, 32 * nb, in_srccol(32 * nb), nullptr, scr, F.lane); continue; } r -= I_IN;
        if (r < I_A) { const int kb = r / 32, nb = r % 32; p0_transpose_item(F.in[19], D, WAB, D, 0, 64 * kb, 32 * nb, 32 * nb, nullptr, scr, F.lane); continue; } r -= I_A;
        if (r < I_B) { const int kb = r / 32, nb = r % 32; p0_transpose_item(F.in[20], D, WAB, D, 512, 64 * kb, 32 * nb, 32 * nb, nullptr, scr, F.lane); continue; } r -= I_B;
        if (r < I_O) { const int kb = r / 32, nb = r % 32; p0_transpose_item(F.in[21], D, WOUT, D, 0, 64 * kb, 32 * nb, 32 * nb, nullptr, scr, F.lane); continue; } r -= I_O;
        if (r < I_UP) { const int kb = r / 128, nb = r % 128; p0_transpose_item(F.in[23], DFF, WUP, D, 0, 64 * kb, 32 * nb, 32 * nb, F.in[22], scr, F.lane); continue; } r -= I_UP;
        if (r < I_DN) { const int kb = r / 32, nb = r % 32; p0_transpose_item(F.in[24], D, WDN, DFF, 0, 64 * kb, 32 * nb, 32 * nb, nullptr, scr, F.lane); continue; } r -= I_DN;
        if (r < I_G) { const int kb = r / 32, nb = r % 32; p0_transpose_item(F.in[26], D, WGT, D, 0, 64 * kb, 32 * nb, 32 * nb, F.in[25], scr, F.lane); continue; } r -= I_G;
        { const int kb = r / 32, nb = r % 32; p0_transpose_item(F.in[27], D, WPL, PLE, 0, 64 * kb, 32 * nb, 32 * nb, nullptr, scr, F.lane); }
    }
    { const int gt = F.vcu * (NWAVES * 64) + F.tid;
      if (gt < 16 * D) { const int r = gt / D, k = gt % D; const int col = r < 8 ? 1536 + r : (r < 12 ? 3080 + (r - 8) : 3084 + (r - 12));
          WIN[(size_t)(5632 + r) * D + k] = (bf16)f2bf(F.in[11][(size_t)k * DIN + col]); } }
    { bf16* XN = (bf16*)(F.ws + WS_XN); const GAS f32x4* gr = (const GAS f32x4*)F.in[10] + F.lane; f32x4 g[4];
#pragma unroll
      for (int j = 0; j < 4; ++j) g[j] = gr[64 * j];
      for (int m0 = gw; m0 < MT; m0 += 2 * NGW) {
          const int m1 = m0 + NGW; const bool two = m1 < MT;
          const float* x0 = m0 < MP ? F.in[0] + (size_t)m0 * D : F.in[1] + (size_t)(m0 - MP) * D;
          const float* x1 = !two ? x0 : (m1 < MP ? F.in[0] + (size_t)m1 * D : F.in[1] + (size_t)(m1 - MP) * D);
          const GAS f32x4* r0 = (const GAS f32x4*)x0 + F.lane; const GAS f32x4* r1 = (const GAS f32x4*)x1 + F.lane; f32x4 v0[4], v1[4]; float s0 = 0.f, s1 = 0.f;
#pragma unroll
          for (int j = 0; j < 4; ++j) { v0[j] = r0[64 * j]; v1[j] = r1[64 * j]; }
#pragma unroll
          for (int j = 0; j < 4; ++j) { s0 += (v0[j].x * v0[j].x + v0[j].y * v0[j].y) + (v0[j].z * v0[j].z + v0[j].w * v0[j].w); s1 += (v1[j].x * v1[j].x + v1[j].y * v1[j].y) + (v1[j].z * v1[j].z + v1[j].w * v1[j].w); }
          const float rs0 = __builtin_amdgcn_rsqf(wave_sum(s0) * (1.f / D) + EPS), rs1 = __builtin_amdgcn_rsqf(wave_sum(s1) * (1.f / D) + EPS);
          GAS unsigned long long* o0 = (GAS unsigned long long*)(XN + (size_t)m0 * D) + F.lane;
#pragma unroll
          for (int j = 0; j < 4; ++j) { const f32x4 y = v0[j] * rs0 * g[j]; o0[64 * j] = (unsigned long long)pk2(y.x, y.y) | ((unsigned long long)pk2(y.z, y.w) << 32); }
          if (two) { GAS unsigned long long* o1 = (GAS unsigned long long*)(XN + (size_t)m1 * D) + F.lane;
#pragma unroll
              for (int j = 0; j < 4; ++j) { const f32x4 y = v1[j] * rs1 * g[j]; o1[64 * j] = (unsigned long long)pk2(y.x, y.y) | ((unsigned long long)pk2(y.z, y.w) << 32); } }
      } }
    { bf16* PLB = (bf16*)(F.ws + WS_PLB);
      for (int m0 = gw; m0 < MT; m0 += 4 * NGW) { f32x4 v[4];
#pragma unroll
          for (int k = 0; k < 4; ++k) { const int m = m0 + k * NGW; if (m < MT) { const float* pr = m < MP ? F.in[2] + (size_t)m * PLE : F.in[3] + (size_t)(m - MP) * PLE; v[k] = *((const GAS f32x4*)pr + F.lane); } }
#pragma unroll
          for (int k = 0; k < 4; ++k) { const int m = m0 + k * NGW; if (m < MT) *((GAS unsigned long long*)(PLB + (size_t)m * PLE) + F.lane) = (unsigned long long)pk2(v[k].x, v[k].y) | ((unsigned long long)pk2(v[k].z, v[k].w) << 32); } } }
    { float* PT = (float*)(F.ws + WS_SFX);
      for (int u = gw; u < DB * NPAGES; u += NGW) { const int page = F.page_table[u]; const f32x4* src = (const f32x4*)(F.in[6] + (size_t)page * PAGE * FH) + F.lane * 4;
          const f32x4 a = src[0], b2 = src[1], c = src[2], d = src[3];
          f32x4 lo = a + c, hi = b2 + d;
#pragma unroll
          for (int o = 1; o < 64; o <<= 1) {
#pragma unroll
              for (int i = 0; i < 4; ++i) { lo[i] += __shfl_xor(lo[i], o); hi[i] += __shfl_xor(hi[i], o); } }
          if (F.lane == 0) { *(f32x4*)(PT + (size_t)u * FH) = lo; *(f32x4*)(PT + (size_t)u * FH + 4) = hi; } } }
}

constexpr float DC_T2 = 48.f;
constexpr int DP_STRIDE = 68;
#define DPPF(v, ctrl) __builtin_bit_cast(float, __builtin_amdgcn_update_dpp(0, __builtin_bit_cast(int, (v)), (ctrl), 0xf, 0xf, true))
__device__ __forceinline__ float red16(float v) { v += DPPF(v, 0xB1); v += DPPF(v, 0x4E); v += DPPF(v, 0x141); v += DPPF(v, 0x140); return v; }
__device__ __forceinline__ int wave_fetch(Frame& F, int qi, int lane) { unsigned v = 0; if (lane == 0) v = __hip_atomic_fetch_add((unsigned*)(F.ctl + CW_Q + 64 * qi), 1u, __ATOMIC_RELAXED, __HIP_MEMORY_SCOPE_AGENT); return (int)__builtin_amdgcn_readfirstlane(v); }
constexpr int DEC_XL_OFF = 110592, DEC_XL_WAVE = 640;
template <bool PF>
__device__ __forceinline__ void decode_unit(Frame& F, int unit, int h) {
    int tid_o = threadIdx.x; asm volatile("" : "+v"(tid_o));
    const int s = unit >> 6, pg = unit & 63, wv = __builtin_amdgcn_readfirstlane(tid_o >> 6), lane = tid_o & 63, dc = lane & 15, sub = lane >> 4;
    const bf16* QB = (const bf16*)(F.ws + WS_QB); const bf16* KB = (const bf16*)(F.ws + WS_KB); const float* LGF = (const float*)(F.ws + WS_LGF);
    const float* PT = (const float*)(F.ws + WS_SFX);
    const int page = F.page_table[s * NPAGES + pg];
    const float* kp = F.in[4] + (size_t)page * PAGE * FW + h * 64 + dc * 4; const float* vp = F.in[5] + (size_t)page * PAGE * FW + h * 64 + dc * 4;
    v2u qw[4], kw[4]; float lg[4];
#pragma unroll
    for (int j = 0; j < 4; ++j) { const size_t row = MP + s * 4 + j; qw[j] = *(const v2u*)(QB + row * FW + h * 64 + dc * 4); kw[j] = *(const v2u*)(KB + row * FW + h * 64 + dc * 4); lg[j] = LGF[row * 8 + h]; }
    const float pt = (lane > pg) ? PT[((size_t)s * NPAGES + lane) * FH + h] : 0.f;
    const float* lp = F.in[6] + (size_t)page * PAGE * FH + h; const float l0 = lp[(size_t)lane * FH], l1 = lp[(size_t)(64 + lane) * FH];
    f32x4 kx[32];
#pragma unroll
    for (int i = 0; i < 32; ++i) kx[i] = __builtin_nontemporal_load((const f32x4*)(kp + (size_t)(4 * i + sub) * FW));
    float tch[4] = {0.f, 0.f, 0.f, 0.f};
    if (PF) { const int pageN = F.page_table[s * NPAGES + pg + 1]; const float* kn = F.in[4] + (size_t)pageN * PAGE * FW + h * 64 + (lane & 3) * 16;
#pragma unroll
        for (int c = 0; c < 4; ++c) tch[c] = kn[(size_t)(16 * c + (lane >> 2)) * FW]; }
    float q[4][4], xself[4], cnew[4];
    { float run = 0.f;
#pragma unroll
      for (int j = 0; j < 4; ++j) {
          q[j][0] = bflo(qw[j].x); q[j][1] = bfhi(qw[j].x); q[j][2] = bflo(qw[j].y); q[j][3] = bfhi(qw[j].y);
          xself[j] = red16(q[j][0] * bflo(kw[j].x) + q[j][1] * bfhi(kw[j].x) + q[j][2] * bflo(kw[j].y) + q[j][3] * bfhi(kw[j].y));
          run += lg[j]; cnew[j] = run * LOG2E; } }
    LAS float* xl = (LAS float*)(F.lds + DEC_XL_OFF) + wv * DEC_XL_WAVE; LAS float* sfl = xl + 512;
    float pm[4] = {-INFINITY, -INFINITY, -INFINITY, -INFINITY};
    { const float off = wave_sum(pt);
      float s0 = l0, s1 = l1;
#pragma unroll
      for (int o = 1; o < 64; o <<= 1) { const float t0 = __shfl_down(s0, o), t1 = __shfl_down(s1, o); if (lane + o < 64) { s0 += t0; s1 += t1; } }
      const float tot1 = __shfl(s1, 0);
      sfl[64 + lane] = (off + s1 - l1) * LOG2E; sfl[lane] = (off + tot1 + s0 - l0) * LOG2E; }
    LDS_WAIT();
#pragma unroll
    for (int i = 0; i < 32; ++i) { float d[4]; const float sf = sfl[4 * i + sub];
#pragma unroll
        for (int j = 0; j < 4; ++j) { d[j] = red16(q[j][0] * kx[i][0] + q[j][1] * kx[i][1] + q[j][2] * kx[i][2] + q[j][3] * kx[i][3]) + sf + cnew[j]; pm[j] = fmaxf(pm[j], d[j]); }
        if (dc == 0) *(LAS f32x4*)(xl + (4 * i + sub) * 4) = (f32x4){d[0], d[1], d[2], d[3]}; }
    bool need = false;
#pragma unroll
    for (int j = 0; j < 4; ++j) { pm[j] = fmaxf(pm[j], __shfl_xor(pm[j], 16)); pm[j] = fmaxf(pm[j], __shfl_xor(pm[j], 32)); need = need || (pm[j] >= xself[j] - DC_T2); }
    float* dp = (float*)(F.ws + WS_DPART) + ((size_t)((s * FH + h) * NPAGES + pg) * 4) * DP_STRIDE;
    if (PF) asm volatile("" :: "v"(tch[0]), "v"(tch[1]), "v"(tch[2]), "v"(tch[3]));
    if (!need) { if (lane < 4) { dp[lane * DP_STRIDE] = -INFINITY; dp[lane * DP_STRIDE + 1] = 0.f; } return; }
    float o[4][4] = {}, l[4] = {0.f, 0.f, 0.f, 0.f};
    LDS_WAIT();
#pragma unroll 1
    for (int qt = 0; qt < 4; ++qt) {
        f32x4 vx[8];
#pragma unroll
        for (int i = 0; i < 8; ++i) { const int pos = 4 * (8 * qt + i) + sub; vx[i] = __builtin_nontemporal_load((const f32x4*)(vp + (size_t)pos * FW)); }
#pragma unroll
        for (int i = 0; i < 8; ++i) { const f32x4 xv = *(const LAS f32x4*)(xl + (4 * (8 * qt + i) + sub) * 4);
#pragma unroll
            for (int j = 0; j < 4; ++j) { const float p = __builtin_amdgcn_exp2f(xv[j] - pm[j]); l[j] += p;
                o[j][0] += p * vx[i][0]; o[j][1] += p * vx[i][1]; o[j][2] += p * vx[i][2]; o[j][3] += p * vx[i][3]; } }
    }
#pragma unroll
    for (int j = 0; j < 4; ++j) { l[j] += __shfl_xor(l[j], 16); l[j] += __shfl_xor(l[j], 32);
#pragma unroll
        for (int d = 0; d < 4; ++d) { o[j][d] += __shfl_xor(o[j][d], 16); o[j][d] += __shfl_xor(o[j][d], 32); }
        if (sub == 0) *(f32x4*)(dp + j * DP_STRIDE + 4 + dc * 4) = (f32x4){o[j][0], o[j][1], o[j][2], o[j][3]};
        if (lane == 0) { dp[j * DP_STRIDE] = pm[j]; dp[j * DP_STRIDE + 1] = l[j]; } }
}
__device__ __forceinline__ void decode_combine_row(Frame& F, int rowid) {
    const int s = rowid >> 5, h = (rowid >> 2) & 7, j = rowid & 3, lane = F.lane;
    const bf16* QB = (const bf16*)(F.ws + WS_QB); const float* LGF = (const float*)(F.ws + WS_LGF);
    const float* dp = (const float*)(F.ws + WS_DPART) + ((size_t)((s * FH + h) * NPAGES) * 4 + j) * DP_STRIDE;
    const size_t row = MP + s * 4 + j;
    const float qd = bf2f(QB[row * FW + h * 64 + lane]);
    float xn[4], cum[4]; { float run = 0.f;
#pragma unroll
      for (int i = 0; i < 4; ++i) { run += LGF[(MP + s * 4 + i) * 8 + h]; cum[i] = run * LOG2E; } }
    float m = -INFINITY;
#pragma unroll
    for (int i = 0; i < 4; ++i) { const float kd = F.out[OFF_KS + (size_t)(s * 4 + i) * FW + h * 64 + lane]; float d = wave_sum(qd * kd) + cum[j] - cum[i]; xn[i] = (i <= j) ? d : -INFINITY; m = fmaxf(m, xn[i]); }
    const float pmv = dp[(size_t)lane * 4 * DP_STRIDE], plv = dp[(size_t)lane * 4 * DP_STRIDE + 1];
    float mm = (plv > 0.f) ? pmv : -INFINITY;
#pragma unroll
    for (int o = 1; o < 64; o <<= 1) mm = fmaxf(mm, __shfl_xor(mm, o));
    m = fmaxf(m, mm);
    float acc = 0.f, l = 0.f;
#pragma unroll
    for (int i = 0; i < 4; ++i) { const float p = __builtin_amdgcn_exp2f(xn[i] - m); l += p; acc += p * F.out[OFF_VS + (size_t)(s * 4 + i) * FW + h * 64 + lane]; }
    for (int pg = 0; pg < NPAGES; ++pg) { const float pl = __shfl(plv, pg); if (pl > 0.f) { const float f = __builtin_amdgcn_exp2f(__shfl(pmv, pg) - m); l += pl * f; acc += f * dp[(size_t)pg * 4 * DP_STRIDE + 4 + lane]; } }
    ((bf16*)(F.ws + WS_OAB))[row * D + h * 64 + lane] = (bf16)f2bf(acc / l);
}
constexpr size_t GU_WF = 0, GU_QD = 16384, GU_KDT = 32768, GU_QKM = 49152, GU_U = 57344, GU_DEC = 90112, GU_BYTES = 90368;
static_assert(WS_GDN + (size_t)1024 * GU_BYTES <= WS_OG, "gdn ws");
constexpr int G1_QS = 0, G1_KS = 17408, G1_KB = 34816, G1_VB = 55296, G1_A = 75776, G1_T = 93184, G1_QK = 102400, G1_SC = 110592, G1_TF = 111616  , G1_WST = 0  ;
constexpr int G1_PQ = 272, G1_PX = 320, G1_PA = 272, G1_PT = 144;

__device__ __forceinline__ f32x16 mfma32(bf16x8 a, bf16x8 b, f32x16 c) { return __builtin_amdgcn_mfma_f32_32x32x16_bf16(a, b, c, 0, 0, 0); }
__device__ __forceinline__ int crow(int r, int hi) { return (r & 3) + 8 * (r >> 2) + 4 * hi; }
__device__ __forceinline__ s16x4 tr_read(unsigned lds_addr) { s16x4 r; asm volatile("ds_read_b64_tr_b16 %0, %1\n\ts_waitcnt lgkmcnt(0)" : "=&v"(r) : "v"(lds_addr) : "memory"); return r; }

template <int VAR>
__device__ __forceinline__ void gdn_prep_unit(Frame& F, int unit) {
    const int bh = unit >> 7, n = unit & 127, b = bh >> 2, h = bh & 3;
    int tid_o = threadIdx.x; asm volatile("" : "+v"(tid_o));
    const int tid = tid_o, lane = tid & 63, wave = __builtin_amdgcn_readfirstlane(tid >> 6);
    LAS unsigned char* L = F.lds + RING_OFF;
    LAS float* sc = (LAS float*)(L + G1_SC);
    const bf16* GQ = (const bf16*)(F.ws + WS_GQ); const float* GAB = (const float*)(F.ws + WS_GAB);
    const size_t row0 = (size_t)b * SEQ + (size_t)n * 64;
    unsigned char* gu = F.ws + WS_GDN + (size_t)unit * GU_BYTES;
    __syncthreads();
    if (wave == 0) {
        const float g = GAB[(row0 + lane) * 8 + h], be = GAB[(row0 + lane) * 8 + 4 + h];
        float c = g;
#pragma unroll
        for (int o = 1; o < 64; o <<= 1) { const float t = __shfl_up(c, o); if (lane >= o) c += t; }
        const float cl = __shfl(c, 63);
        sc[lane] = c; sc[64 + lane] = be; sc[128 + lane] = __expf(c); sc[192 + lane] = __expf(cl - c);
        if (lane == 0) *(float*)(gu + GU_DEC) = __expf(cl);
    } else if (tid < 64 + 384) {
        const int c = tid - 64, ch = (c >> 7) * 512 + h * 128 + (c & 127); const float* cw = F.in[15];
#pragma unroll
        for (int d = 0; d < 4; ++d) *(LAS float*)(L + G1_TF + (d * 384 + c) * 4) = cw[d * CCH + ch];
    }
    v4u xr[3][4][2];
    { const int i = tid >> 3, sg = tid & 7;
#pragma unroll
      for (int X = 0; X < 3; ++X)
#pragma unroll
        for (int d = 0; d < 4; ++d) { const int tok = n * 64 + i - 3 + d; const int cbase = X * 512 + h * 128 + sg * 16;
            if (tok >= 0) { xr[X][d][0] = *(const v4u*)(GQ + ((size_t)b * SEQ + tok) * CCH + cbase); xr[X][d][1] = *(const v4u*)(GQ + ((size_t)b * SEQ + tok) * CCH + cbase + 8); }
            else { xr[X][d][0] = (v4u){0u, 0u, 0u, 0u}; xr[X][d][1] = (v4u){0u, 0u, 0u, 0u}; } } }
    __syncthreads();
    {
        const int i = tid >> 3, sg = tid & 7;
        const float ecum = sc[128 + i], beta = sc[64 + i];
#pragma unroll
        for (int X = 0; X < 3; ++X) {
            float y[16];
#pragma unroll
            for (int c = 0; c < 16; ++c) y[c] = 0.f;
#pragma unroll
            for (int d = 0; d < 4; ++d) {
                const v4u x0 = xr[X][d][0], x1 = xr[X][d][1]; const LAS float* wl = (const LAS float*)(L + G1_TF) + d * 384 + X * 128 + sg * 16;
                const f32x4 w0 = *(const LAS f32x4*)(wl), w1 = *(const LAS f32x4*)(wl + 4), w2 = *(const LAS f32x4*)(wl + 8), w3 = *(const LAS f32x4*)(wl + 12);
                y[0] += w0[0] * bflo(x0.x); y[1] += w0[1] * bfhi(x0.x); y[2] += w0[2] * bflo(x0.y); y[3] += w0[3] * bfhi(x0.y);
                y[4] += w1[0] * bflo(x0.z); y[5] += w1[1] * bfhi(x0.z); y[6] += w1[2] * bflo(x0.w); y[7] += w1[3] * bfhi(x0.w);
                y[8] += w2[0] * bflo(x1.x); y[9] += w2[1] * bfhi(x1.x); y[10] += w2[2] * bflo(x1.y); y[11] += w2[3] * bfhi(x1.y);
                y[12] += w3[0] * bflo(x1.z); y[13] += w3[1] * bfhi(x1.z); y[14] += w3[2] * bflo(x1.w); y[15] += w3[3] * bfhi(x1.w);
            }
            float ss = 0.f;
#pragma unroll
            for (int c = 0; c < 16; ++c) { y[c] = y[c] * __builtin_amdgcn_rcpf(1.0f + __expf(-y[c])); ss += y[c] * y[c]; }
            if (X < 2) {
                ss += __shfl_xor(ss, 1); ss += __shfl_xor(ss, 2); ss += __shfl_xor(ss, 4);
                float rn = __builtin_amdgcn_rsqf(ss + EPS); if (X == 0) rn *= 0.08838834764831845f;
#pragma unroll
                for (int c = 0; c < 16; ++c) y[c] *= rn;
            }
            if (X == 0) {
                v4u a, c2; a.x = pk2(y[0], y[1]); a.y = pk2(y[2], y[3]); a.z = pk2(y[4], y[5]); a.w = pk2(y[6], y[7]); c2.x = pk2(y[8], y[9]); c2.y = pk2(y[10], y[11]); c2.z = pk2(y[12], y[13]); c2.w = pk2(y[14], y[15]);
                *(LAS v4u*)(L + G1_QS + i * G1_PQ + sg * 32) = a; *(LAS v4u*)(L + G1_QS + i * G1_PQ + sg * 32 + 16) = c2;
                v4u d0, d1; d0.x = pk2(y[0] * ecum, y[1] * ecum); d0.y = pk2(y[2] * ecum, y[3] * ecum); d0.z = pk2(y[4] * ecum, y[5] * ecum); d0.w = pk2(y[6] * ecum, y[7] * ecum);
                d1.x = pk2(y[8] * ecum, y[9] * ecum); d1.y = pk2(y[10] * ecum, y[11] * ecum); d1.z = pk2(y[12] * ecum, y[13] * ecum); d1.w = pk2(y[14] * ecum, y[15] * ecum);
                const int mt = i >> 4, fr = i & 15, s = sg >> 1, fq0 = (sg & 1) * 2;
                *(v4u*)(gu + GU_QD + ((size_t)((mt * 4 + s) * 64 + fq0 * 16 + fr)) * 16) = d0;
                *(v4u*)(gu + GU_QD + ((size_t)((mt * 4 + s) * 64 + (fq0 + 1) * 16 + fr)) * 16) = d1;
            } else if (X == 1) {
                v4u a, c2; a.x = pk2(y[0], y[1]); a.y = pk2(y[2], y[3]); a.z = pk2(y[4], y[5]); a.w = pk2(y[6], y[7]); c2.x = pk2(y[8], y[9]); c2.y = pk2(y[10], y[11]); c2.z = pk2(y[12], y[13]); c2.w = pk2(y[14], y[15]);
                *(LAS v4u*)(L + G1_KS + i * G1_PQ + sg * 32) = a; *(LAS v4u*)(L + G1_KS + i * G1_PQ + sg * 32 + 16) = c2;
                const float f = beta * ecum;
                a.x = pk2(y[0] * f, y[1] * f); a.y = pk2(y[2] * f, y[3] * f); a.z = pk2(y[4] * f, y[5] * f); a.w = pk2(y[6] * f, y[7] * f); c2.x = pk2(y[8] * f, y[9] * f); c2.y = pk2(y[10] * f, y[11] * f); c2.z = pk2(y[12] * f, y[13] * f); c2.w = pk2(y[14] * f, y[15] * f);
                *(LAS v4u*)(L + G1_KB + i * G1_PX + sg * 32) = a; *(LAS v4u*)(L + G1_KB + i * G1_PX + sg * 32 + 16) = c2;
            } else {
                v4u a, c2; a.x = pk2(y[0] * beta, y[1] * beta); a.y = pk2(y[2] * beta, y[3] * beta); a.z = pk2(y[4] * beta, y[5] * beta); a.w = pk2(y[6] * beta, y[7] * beta);
                c2.x = pk2(y[8] * beta, y[9] * beta); c2.y = pk2(y[10] * beta, y[11] * beta); c2.z = pk2(y[12] * beta, y[13] * beta); c2.w = pk2(y[14] * beta, y[15] * beta);
                *(LAS v4u*)(L + G1_VB + i * G1_PX + sg * 32) = a; *(LAS v4u*)(L + G1_VB + i * G1_PX + sg * 32 + 16) = c2;
            }
        }
    }
    __syncthreads();
    if (VAR == 2) return;
    {
        const int which = wave >> 2, ti = (wave >> 1) & 1, tj = wave & 1, r = lane & 31, hh = lane >> 5;
        const LAS unsigned char* Ap = L + (which ? G1_QS : G1_KS) + (32 * ti + r) * G1_PQ + hh * 16;
        const LAS unsigned char* Bp = L + G1_KS + (32 * tj + r) * G1_PQ + hh * 16;
        f32x16 acc = {};
#pragma unroll
        for (int s = 0; s < 8; ++s) acc = mfma32(*(const LAS bf16x8*)(Ap + s * 32), *(const LAS bf16x8*)(Bp + s * 32), acc);
        const int j = 32 * tj + r; const float cj = sc[j];
        if (which == 0) {
#pragma unroll
            for (int reg = 0; reg < 16; ++reg) { const int i = 32 * ti + crow(reg, hh); const float v = (i > j) ? sc[64 + i] * acc[reg] * __expf(sc[i] - cj) : 0.f;
                *(LAS float*)(L + G1_A + i * G1_PA + j * 4) = v; }
        } else {
#pragma unroll
            for (int reg = 0; reg < 16; ++reg) { const int i = 32 * ti + crow(reg, hh); const float v = (i >= j) ? acc[reg] * __expf(sc[i] - cj) : 0.f;
                *(LAS unsigned short*)(L + G1_QK + i * 128 + j * 2) = (unsigned short)f2bf(v); }
        }
    }
    __syncthreads();
    if (wave == 0 && VAR != 1) {
        const int bk = lane >> 4, c = lane & 15; float t[16];
#pragma unroll
        for (int i = 0; i < 16; ++i) {
            float a = (c == i) ? 1.f : 0.f;
#pragma unroll
            for (int j4 = 0; j4 < (i + 3) / 4; ++j4) { const f32x4 av = *(const LAS f32x4*)(L + G1_A + (16 * bk + i) * G1_PA + (16 * bk + 4 * j4) * 4);
#pragma unroll
                for (int q = 0; q < 4; ++q) { const int j = 4 * j4 + q; if (j < i) a -= av[q] * t[j]; } }
            t[i] = a;
            *(LAS float*)(L + G1_TF + (16 * bk + i) * G1_PA + (16 * bk + c) * 4) = a;
        }
    } else if (wave != 0) {
        const int t7 = tid - 64;
        for (int e = t7; e < 6 * 256; e += 448) { const int bq = e >> 8, w = e & 255; const int br = bq < 3 ? 0 : (bq < 5 ? 1 : 2), bc = bq < 3 ? bq + 1 : (bq < 5 ? bq - 1 : 3);
            *(LAS float*)(L + G1_TF + (16 * br + (w >> 4)) * G1_PA + (16 * bc + (w & 15)) * 4) = 0.f; }
        for (int e = t7; e < 512; e += 448) {
            const int i = e >> 3, j0 = (e & 7) * 8; const v4u v = *(const LAS v4u*)(L + G1_QK + i * 128 + j0 * 2);
            const int mt = i >> 4, fr = i & 15, s = j0 >> 5, fq = (j0 & 31) >> 3;
            *(v4u*)(gu + GU_QKM + (size_t)((mt * 2 + s) * 64 + fq * 16 + fr) * 16) = v; }
        for (int e = t7; e < 1024; e += 448) {
            const int dk = e & 127, i0 = (e >> 7) * 8; unsigned short v[8];
#pragma unroll
            for (int q = 0; q < 8; ++q) v[q] = (unsigned short)f2bf(bf2f(*(const LAS unsigned short*)(L + G1_KS + (i0 + q) * G1_PQ + dk * 2)) * sc[192 + i0 + q]);
            v4u o; o.x = v[0] | ((unsigned)v[1] << 16); o.y = v[2] | ((unsigned)v[3] << 16); o.z = v[4] | ((unsigned)v[5] << 16); o.w = v[6] | ((unsigned)v[7] << 16);
            const int mt = dk >> 4, fr = dk & 15, s = i0 >> 5, fq = (i0 & 31) >> 3;
            *(v4u*)(gu + GU_KDT + (size_t)((mt * 2 + s) * 64 + fq * 16 + fr) * 16) = o; }
    }
    __syncthreads();
    if (VAR != 1) {
        const int i16 = lane & 15, kk = lane >> 4;
        if (wave < 2) {
            const int r0 = 32 * wave; f32x4s x = {0.f, 0.f, 0.f, 0.f}, y = {0.f, 0.f, 0.f, 0.f};
#pragma unroll
            for (int s4 = 0; s4 < 4; ++s4) x = __builtin_amdgcn_mfma_f32_16x16x4f32(*(const LAS float*)(L + G1_A + (r0 + 16 + i16) * G1_PA + (r0 + 4 * s4 + kk) * 4),
                                                                                     *(const LAS float*)(L + G1_TF + (r0 + 4 * s4 + kk) * G1_PA + (r0 + i16) * 4), x, 0, 0, 0);
#pragma unroll
            for (int s4 = 0; s4 < 4; ++s4) y = __builtin_amdgcn_mfma_f32_16x16x4f32(*(const LAS float*)(L + G1_TF + (r0 + 16 + i16) * G1_PA + (r0 + 16 + 4 * kk + s4) * 4), x[s4], y, 0, 0, 0);
#pragma unroll
            for (int r = 0; r < 4; ++r) *(LAS float*)(L + G1_TF + (r0 + 16 + 4 * kk + r) * G1_PA + (r0 + i16) * 4) = -y[r];
        }
    }
    __syncthreads();
    if (VAR != 1) {
        const int i16 = lane & 15, kk = lane >> 4;
        if (wave < 4) {
            const int ti = wave >> 1, tj = wave & 1; f32x4s y0 = {0.f, 0.f, 0.f, 0.f}, y1 = {0.f, 0.f, 0.f, 0.f}, z = {0.f, 0.f, 0.f, 0.f};
#pragma unroll
            for (int s8 = 0; s8 < 8; ++s8) { const float bq = *(const LAS float*)(L + G1_TF + (4 * s8 + kk) * G1_PA + (16 * tj + i16) * 4);
                y0 = __builtin_amdgcn_mfma_f32_16x16x4f32(*(const LAS float*)(L + G1_A + (32 + i16) * G1_PA + (4 * s8 + kk) * 4), bq, y0, 0, 0, 0);
                y1 = __builtin_amdgcn_mfma_f32_16x16x4f32(*(const LAS float*)(L + G1_A + (48 + i16) * G1_PA + (4 * s8 + kk) * 4), bq, y1, 0, 0, 0); }
#pragma unroll
            for (int s4 = 0; s4 < 4; ++s4) z = __builtin_amdgcn_mfma_f32_16x16x4f32(*(const LAS float*)(L + G1_TF + (32 + 16 * ti + i16) * G1_PA + (32 + 4 * kk + s4) * 4), y0[s4], z, 0, 0, 0);
#pragma unroll
            for (int s4 = 0; s4 < 4; ++s4) z = __builtin_amdgcn_mfma_f32_16x16x4f32(*(const LAS float*)(L + G1_TF + (32 + 16 * ti + i16) * G1_PA + (48 + 4 * kk + s4) * 4), y1[s4], z, 0, 0, 0);
#pragma unroll
            for (int r = 0; r < 4; ++r) *(LAS float*)(L + G1_TF + (32 + 16 * ti + 4 * kk + r) * G1_PA + (16 * tj + i16) * 4) = -z[r];
        }
    }
    __syncthreads();
    { const int i = tid >> 3, c0 = (tid & 7) * 8;
      const f32x4 a = *(const LAS f32x4*)(L + G1_TF + i * G1_PA + c0 * 4), c = *(const LAS f32x4*)(L + G1_TF + i * G1_PA + c0 * 4 + 16);
      v4u o; o.x = pk2(a[0], a[1]); o.y = pk2(a[2], a[3]); o.z = pk2(c[0], c[1]); o.w = pk2(c[2], c[3]); *(LAS v4u*)(L + G1_T + i * G1_PT + c0 * 2) = o; }
    __syncthreads();
    {
        const int ti = wave >> 2, cb = wave & 3, r = lane & 31, hh = lane >> 5;
        const unsigned lbase = (unsigned)(uintptr_t)L;
        const int q = (lane & 15) >> 2, p = lane & 3, blk = (lane >> 4) & 1;
        f32x16 au = {}, aw = {};
        const unsigned rv = lbase + G1_VB + (unsigned)((8 * hh + q) * G1_PX + (32 * cb + 16 * blk + 4 * p) * 2), rk = rv + (G1_KB - G1_VB);
        s16x4 xv[8], xk[8];
#define G1_TR8(dst, base) asm volatile("ds_read_b64_tr_b16 %0, %8 offset:%c9\n\tds_read_b64_tr_b16 %1, %8 offset:%c10\n\tds_read_b64_tr_b16 %2, %8 offset:%c11\n\tds_read_b64_tr_b16 %3, %8 offset:%c12\n\t" \
            "ds_read_b64_tr_b16 %4, %8 offset:%c13\n\tds_read_b64_tr_b16 %5, %8 offset:%c14\n\tds_read_b64_tr_b16 %6, %8 offset:%c15\n\tds_read_b64_tr_b16 %7, %8 offset:%c16\n\ts_waitcnt lgkmcnt(0)" \
            : "=&v"(dst[0]), "=&v"(dst[1]), "=&v"(dst[2]), "=&v"(dst[3]), "=&v"(dst[4]), "=&v"(dst[5]), "=&v"(dst[6]), "=&v"(dst[7]) \
            : "v"(base), "i"(0), "i"(4 * G1_PX), "i"(16 * G1_PX), "i"(20 * G1_PX), "i"(32 * G1_PX), "i"(36 * G1_PX), "i"(48 * G1_PX), "i"(52 * G1_PX) : "memory")
        G1_TR8(xv, rv); G1_TR8(xk, rk);
#undef G1_TR8
#pragma unroll
        for (int s = 0; s < 4; ++s) {
            const bf16x8 ta = *(const LAS bf16x8*)(L + G1_T + (32 * ti + r) * G1_PT + (16 * s + 8 * hh) * 2);
            au = mfma32(ta, __builtin_shufflevector(xv[2 * s], xv[2 * s + 1], 0, 1, 2, 3, 4, 5, 6, 7), au);
            aw = mfma32(ta, __builtin_shufflevector(xk[2 * s], xk[2 * s + 1], 0, 1, 2, 3, 4, 5, 6, 7), aw);
        }
        const int c = 32 * cb + r, nt = c >> 4, fr = c & 15;
#pragma unroll
        for (int g = 0; g < 4; ++g) { const int rowb = 32 * ti + 8 * g + 4 * hh, mt = rowb >> 4, fq = (rowb & 15) >> 2;
            *(f32x4*)(gu + GU_U + (size_t)(((mt * 8 + nt) * 64) + fq * 16 + fr) * 16) = (f32x4){au[4 * g], au[4 * g + 1], au[4 * g + 2], au[4 * g + 3]}; }
        __syncthreads();
#pragma unroll
        for (int reg = 0; reg < 16; ++reg) { const int i = 32 * ti + crow(reg, hh); *(LAS unsigned short*)(L + G1_WST + i * 256 + c * 2) = (unsigned short)f2bf(aw[reg]); }
    }
    __syncthreads();
    for (int e = tid; e < 1024; e += 512) {
        const int i = e >> 4, dk0 = (e & 15) * 8; const v4u v = *(const LAS v4u*)(L + G1_WST + i * 256 + dk0 * 2);
        const int mt = i >> 4, fr = i & 15, s = dk0 >> 5, fq = (dk0 & 31) >> 3;
        *(v4u*)(gu + GU_WF + (size_t)((mt * 4 + s) * 64 + fq * 16 + fr) * 16) = v; }
}
constexpr int SC_SB = 0, SC_VN = 32 * 272, SC_AO = SC_VN + 32 * 144, SC_PS = 272, SC_PV = 144;
__device__ __forceinline__ f32x4s mfma16(bf16x8 a, bf16x8 b, f32x4s c) { return __builtin_amdgcn_mfma_f32_16x16x32_bf16(a, b, c, 0, 0, 0); }
struct ScanB { bf16x8 wf[4], qd[4]; f32x4s u[2]; };
struct ScanE { bf16x8 qk[2], kd[2][2]; float dec; };
__device__ __forceinline__ void scan_loadB(ScanB& f, const unsigned char* gu, int mp, int cq, int lane) {
#pragma unroll
    for (int s = 0; s < 4; ++s) { f.wf[s] = *(const bf16x8*)(gu + GU_WF + (size_t)((mp * 4 + s) * 64 + lane) * 16); f.qd[s] = *(const bf16x8*)(gu + GU_QD + (size_t)((mp * 4 + s) * 64 + lane) * 16); }
#pragma unroll
    for (int nt = 0; nt < 2; ++nt) f.u[nt] = *(const f32x4s*)(gu + GU_U + (size_t)(((mp * 8 + 2 * cq + nt) * 64) + lane) * 16);
}
__device__ __forceinline__ void scan_loadE(ScanE& f, const unsigned char* gu, int mp, int lane) {
#pragma unroll
    for (int s = 0; s < 2; ++s) { f.qk[s] = *(const bf16x8*)(gu + GU_QKM + (size_t)((mp * 2 + s) * 64 + lane) * 16);
        f.kd[0][s] = *(const bf16x8*)(gu + GU_KDT + (size_t)(((2 * mp) * 2 + s) * 64 + lane) * 16); f.kd[1][s] = *(const bf16x8*)(gu + GU_KDT + (size_t)(((2 * mp + 1) * 2 + s) * 64 + lane) * 16); }
    f.dec = *(const float*)(gu + GU_DEC);
}
__device__ __forceinline__ void scan_stepB(const ScanB& f, LAS unsigned char* L, int mp, int lane, int fr, int fq) {
    f32x4s av[2] = {{0.f, 0.f, 0.f, 0.f}, {0.f, 0.f, 0.f, 0.f}}, ao[2] = {{0.f, 0.f, 0.f, 0.f}, {0.f, 0.f, 0.f, 0.f}};
#pragma unroll
    for (int s = 0; s < 4; ++s)
#pragma unroll
        for (int nt = 0; nt < 2; ++nt) { const bf16x8 sb = *(const LAS bf16x8*)(L + SC_SB + (16 * nt + fr) * SC_PS + (32 * s + 8 * fq) * 2); av[nt] = mfma16(f.wf[s], sb, av[nt]); ao[nt] = mfma16(f.qd[s], sb, ao[nt]); }
#pragma unroll
    for (int nt = 0; nt < 2; ++nt) { const f32x4s vn = f.u[nt] - av[nt]; v2u w; w.x = pk2(vn[0], vn[1]); w.y = pk2(vn[2], vn[3]);
        *(LAS v2u*)(L + SC_VN + (16 * nt + fr) * SC_PV + (16 * mp + 4 * fq) * 2) = w; *(LAS f32x4s*)(L + SC_AO + ((mp * 2 + nt) * 64 + lane) * 16) = ao[nt]; }
    __syncthreads();
    __syncthreads();
}
__device__ __forceinline__ void scan_stepE(const ScanE& f, f32x4s (&S)[2][2], LAS unsigned char* L, float* og, int mp, int lane, int fr, int fq, unsigned* prog, unsigned stepno) {
    __syncthreads();
    bf16x8 vb[2][2];
#pragma unroll
    for (int nt = 0; nt < 2; ++nt)
#pragma unroll
        for (int s = 0; s < 2; ++s) vb[nt][s] = *(const LAS bf16x8*)(L + SC_VN + (16 * nt + fr) * SC_PV + (32 * s + 8 * fq) * 2);
#pragma unroll
    for (int nt = 0; nt < 2; ++nt) { f32x4s o = *(const LAS f32x4s*)(L + SC_AO + ((mp * 2 + nt) * 64 + lane) * 16);
#pragma unroll
        for (int s = 0; s < 2; ++s) o = mfma16(f.qk[s], vb[nt][s], o);
#pragma unroll
        for (int i = 0; i < 4; ++i) og[(size_t)(16 * mp + 4 * fq + i) * 512 + 16 * nt + fr] = o[i]; }
#pragma unroll
    for (int t = 0; t < 2; ++t)
#pragma unroll
        for (int nt = 0; nt < 2; ++nt) { S[t][nt] = S[t][nt] * f.dec;
#pragma unroll
            for (int s = 0; s < 2; ++s) S[t][nt] = mfma16(f.kd[t][s], vb[nt][s], S[t][nt]);
            v2u w; w.x = pk2(S[t][nt][0], S[t][nt][1]); w.y = pk2(S[t][nt][2], S[t][nt][3]); *(LAS v2u*)(L + SC_SB + (16 * nt + fr) * SC_PS + (16 * (2 * mp + t) + 4 * fq) * 2) = w; }
    if (prog && lane == 0) __hip_atomic_store(prog, stepno, __ATOMIC_RELAXED, __HIP_MEMORY_SCOPE_AGENT);
    __syncthreads();
}
template <int VAR>
__device__ __forceinline__ void gdn_scan_unit(Frame& F, int unit) {
    const int bh = unit >> 2, cq = unit & 3, b = bh >> 2, h = bh & 3;
    int tid_o = threadIdx.x; asm volatile("" : "+v"(tid_o));
    const int lane = tid_o & 63, wave = __builtin_amdgcn_readfirstlane(tid_o >> 6), mp = wave & 3, fr = lane & 15, fq = lane >> 4;
    LAS unsigned char* L = F.lds + RING_OFF;
    __syncthreads();
    for (int e = tid_o; e < (32 * 272) / 4; e += NWAVES * 64) ((LAS unsigned*)(L + SC_SB))[e] = 0u;
    __syncthreads();
    const unsigned char* gu0 = F.ws + WS_GDN + (size_t)(bh * 128) * GU_BYTES;
    if (wave < 4) {
        ScanB f0, f1, f2, f3;
        scan_loadB(f0, gu0, mp, cq, lane); scan_loadB(f1, gu0 + GU_BYTES, mp, cq, lane); scan_loadB(f2, gu0 + 2 * GU_BYTES, mp, cq, lane);
        for (int n = 0; n < 128; n += 4) {
            if (VAR != 1) scan_loadB(f3, gu0 + (size_t)(n + 3) * GU_BYTES, mp, cq, lane); if (VAR != 2) scan_stepB(f0, L, mp, lane, fr, fq); else asm volatile("" :: "v"(f0.wf[0]), "v"(f0.qd[3]), "v"(f0.u[1]));
            if (VAR != 1 && n + 4 < 128) scan_loadB(f0, gu0 + (size_t)(n + 4) * GU_BYTES, mp, cq, lane); if (VAR != 2) scan_stepB(VAR == 1 ? f0 : f1, L, mp, lane, fr, fq); else asm volatile("" :: "v"(f1.wf[0]), "v"(f1.qd[3]), "v"(f1.u[1]));
            if (VAR != 1 && n + 5 < 128) scan_loadB(f1, gu0 + (size_t)(n + 5) * GU_BYTES, mp, cq, lane); if (VAR != 2) scan_stepB(VAR == 1 ? f0 : f2, L, mp, lane, fr, fq); else asm volatile("" :: "v"(f2.wf[0]), "v"(f2.qd[3]), "v"(f2.u[1]));
            if (VAR != 1 && n + 6 < 128) scan_loadB(f2, gu0 + (size_t)(n + 6) * GU_BYTES, mp, cq, lane); if (VAR != 2) scan_stepB(VAR == 1 ? f0 : f3, L, mp, lane, fr, fq); else asm volatile("" :: "v"(f3.wf[0]), "v"(f3.qd[3]), "v"(f3.u[1]));
        }
    } else {
        f32x4s S[2][2] = {{{0.f, 0.f, 0.f, 0.f}, {0.f, 0.f, 0.f, 0.f}}, {{0.f, 0.f, 0.f, 0.f}, {0.f, 0.f, 0.f, 0.f}}};
        float* og0 = (float*)(F.ws + WS_OG) + (size_t)b * SEQ * 512 + h * 128 + 32 * cq;
        unsigned* prog = nullptr;
        ScanE f0, f1, f2, f3;
        scan_loadE(f0, gu0, mp, lane); scan_loadE(f1, gu0 + GU_BYTES, mp, lane); scan_loadE(f2, gu0 + 2 * GU_BYTES, mp, lane);
        for (int n = 0; n < 128; n += 4) {
            if (VAR != 1) scan_loadE(f3, gu0 + (size_t)(n + 3) * GU_BYTES, mp, lane); if (VAR != 2) scan_stepE(f0, S, L, og0 + (size_t)n * 64 * 512, mp, lane, fr, fq, prog, (unsigned)(n + 1)); else asm volatile("" :: "v"(f0.qk[0]), "v"(f0.kd[1][1]));
            if (VAR != 1 && n + 4 < 128) scan_loadE(f0, gu0 + (size_t)(n + 4) * GU_BYTES, mp, lane); if (VAR != 2) scan_stepE(VAR == 1 ? f0 : f1, S, L, og0 + (size_t)(n + 1) * 64 * 512, mp, lane, fr, fq, prog, (unsigned)(n + 2)); else asm volatile("" :: "v"(f1.qk[0]), "v"(f1.kd[1][1]));
            if (VAR != 1 && n + 5 < 128) scan_loadE(f1, gu0 + (size_t)(n + 5) * GU_BYTES, mp, lane); if (VAR != 2) scan_stepE(VAR == 1 ? f0 : f2, S, L, og0 + (size_t)(n + 2) * 64 * 512, mp, lane, fr, fq, prog, (unsigned)(n + 3)); else asm volatile("" :: "v"(f2.qk[0]), "v"(f2.kd[1][1]));
            if (VAR != 1 && n + 6 < 128) scan_loadE(f2, gu0 + (size_t)(n + 6) * GU_BYTES, mp, lane); if (VAR != 2) scan_stepE(VAR == 1 ? f0 : f3, S, L, og0 + (size_t)(n + 3) * 64 * 512, mp, lane, fr, fq, prog, (unsigned)(n + 4)); else asm volatile("" :: "v"(f3.qk[0]), "v"(f3.kd[1][1]));
        }
        float* so = F.out + OFF_SSP + ((size_t)bh * 128) * 128 + 32 * cq + fr;
#pragma unroll
        for (int t = 0; t < 2; ++t)
#pragma unroll
            for (int nt = 0; nt < 2; ++nt)
#pragma unroll
                for (int i = 0; i < 4; ++i) so[(size_t)(16 * (2 * mp + t) + 4 * fq + i) * 128 + 16 * nt] = S[t][nt][i];
    }
}

constexpr int AT_KP = 144, AT_VP = 192;
constexpr int AT_K0 = 0, AT_V0 = 2 * 64 * AT_KP, AT_CS = AT_V0 + 2 * 64 * AT_VP, AT_WS = AT_CS + 2 * 256, AT_RED = AT_WS + 8 * 256, AT_TOT = AT_RED + 32, AT_CQ = AT_RED + 64;
constexpr float AT_T2 = 48.f, AT_THR = 8.f;
__device__ __forceinline__ float rowmax32(const f32x16& p0, const f32x16& p1) {
    float a = fmaxf(fmaxf(p0[0], p0[1]), p1[0]), b2 = fmaxf(fmaxf(p0[2], p0[3]), p1[1]); a = fmaxf(fmaxf(a, p1[2]), p1[3]);
#pragma unroll
    for (int r = 4; r < 16; r += 4) { a = fmaxf(fmaxf(a, p0[r]), p0[r + 1]); b2 = fmaxf(fmaxf(b2, p0[r + 2]), p0[r + 3]); a = fmaxf(fmaxf(a, p1[r]), p1[r + 1]); b2 = fmaxf(fmaxf(b2, p1[r + 2]), p1[r + 3]); }
    const float m = fmaxf(a, b2);
    return fmaxf(m, __shfl_xor(m, 32));
}
__device__ __forceinline__ bf16x8 pack_frag(const f32x16& x, int s) {
    v4u p; p.x = pk2(x[8 * s], x[8 * s + 1]); p.y = pk2(x[8 * s + 2], x[8 * s + 3]); p.z = pk2(x[8 * s + 4], x[8 * s + 5]); p.w = pk2(x[8 * s + 6], x[8 * s + 7]);
    return __builtin_bit_cast(bf16x8, p);
}
__device__ __forceinline__ void attn_unit(Frame& F, int unit, float qkb) {
    const int b = unit >> 8, h = (unit >> 5) & 7, qb = unit & 31;
    int tid_o = threadIdx.x; asm volatile("" : "+v"(tid_o));
    const int tid = tid_o, lane = tid & 63, wave = __builtin_amdgcn_readfirstlane(tid >> 6), r = lane & 31, hh = lane >> 5;
    LAS unsigned char* L = F.lds + RING_OFF;
    const bf16* QB = (const bf16*)(F.ws + WS_QB); const bf16* KB = (const bf16*)(F.ws + WS_KB); const bf16* VB = (const bf16*)(F.ws + WS_VB);
    const float* CUM = (const float*)(F.ws + WS_CUM);
    bf16* OAB = (bf16*)(F.ws + WS_OAB);
    const size_t rowb = (size_t)b * SEQ; const int q0 = qb * 256, qrow = q0 + 32 * wave + r;
    LAS float* wsf = (LAS float*)(L + AT_WS) + wave * 64; LAS float* red = (LAS float*)(L + AT_RED);
    bf16x8 qr[4];
#pragma unroll
    for (int s = 0; s < 4; ++s) qr[s] = *(const bf16x8*)(QB + (rowb + qrow) * FW + h * 64 + 16 * s + 8 * hh);
    const float cq = CUM[(rowb + qrow) * 8 + h];
    float aq = cq;
    float l_run = 0.f; f32x16 o0 = {}, o1 = {};
    const int tdiag = (q0 + 255) >> 6;
    const int srow = tid >> 3, sch = tid & 7;
    __syncthreads();
    v4u kreg = *(const v4u*)(KB + (rowb + 64 * tdiag + srow) * FW + h * 64 + sch * 8), vreg = *(const v4u*)(VB + (rowb + 64 * tdiag + srow) * FW + h * 64 + sch * 8);
    float creg = (tid < 64) ? CUM[(rowb + 64 * tdiag + tid) * 8 + h] : 0.f;
    *(LAS v4u*)(L + AT_K0 + srow * AT_KP + sch * 16) = kreg; *(LAS v4u*)(L + AT_V0 + srow * AT_VP + sch * 16) = vreg; if (tid < 64) *(LAS float*)(L + AT_CS + tid * 4) = creg;
    __syncthreads();
    const unsigned lbase = (unsigned)(uintptr_t)L;
    const int tq = (lane & 15) >> 2, tp = lane & 3, tblk = (lane >> 4) & 1;
    float G = 0.f, Gw = 0.f; bool first = true; int buf = 0;
    for (int t = tdiag; t >= 0; --t) {
        if (t == tdiag - 4) {
            float a = aq;
#pragma unroll
            for (int o = 1; o < 64; o <<= 1) a = fmaxf(a, __shfl_xor(a, o));
            Gw = a;
            if (lane == 0) red[wave] = a;
            __syncthreads();
            G = fmaxf(fmaxf(fmaxf(red[0], red[1]), fmaxf(red[2], red[3])), fmaxf(fmaxf(red[4], red[5]), fmaxf(red[6], red[7])));
        }
        bool wskip = false;
        if (t <= tdiag - 4) { const float cl = *(const LAS float*)(L + AT_CS + buf * 256 + 63 * 4); if (qkb + G - cl < -AT_T2) break; wskip = (qkb + Gw - cl < -AT_T2); }
        const bool more = (t > 0);
        if (more) { kreg = *(const v4u*)(KB + (rowb + 64 * (t - 1) + srow) * FW + h * 64 + sch * 8); vreg = *(const v4u*)(VB + (rowb + 64 * (t - 1) + srow) * FW + h * 64 + sch * 8);
            creg = (tid < 64) ? CUM[(rowb + 64 * (t - 1) + tid) * 8 + h] : 0.f; }
        const LAS unsigned char* Kt = L + AT_K0 + buf * (64 * AT_KP); const unsigned Vt = lbase + AT_V0 + buf * (64 * AT_VP); const LAS float* cs = (const LAS float*)(L + AT_CS + buf * 256);
        if (!wskip && 64 * t <= q0 + 32 * wave + 31) {
            f32x16 p0, p1;
#pragma unroll
            for (int g = 0; g < 4; ++g) { const f32x4 c0 = *(const LAS f32x4*)(cs + 8 * g + 4 * hh), c1 = *(const LAS f32x4*)(cs + 32 + 8 * g + 4 * hh);
#pragma unroll
                for (int i = 0; i < 4; ++i) { p0[4 * g + i] = aq - c0[i]; p1[4 * g + i] = aq - c1[i]; } }
#pragma unroll
            for (int s = 0; s < 4; ++s) { const bf16x8 k0 = *(const LAS bf16x8*)(Kt + r * AT_KP + (16 * s + 8 * hh) * 2), k1 = *(const LAS bf16x8*)(Kt + (32 + r) * AT_KP + (16 * s + 8 * hh) * 2);
                p0 = mfma32(k0, qr[s], p0); p1 = mfma32(k1, qr[s], p1); }
            if (64 * t + 63 > q0 + 32 * wave) {
#pragma unroll
                for (int reg = 0; reg < 16; ++reg) { const int kv = 64 * t + crow(reg, hh); if (kv > qrow) p0[reg] = -INFINITY; if (kv + 32 > qrow) p1[reg] = -INFINITY; }
            }
            const float rm = rowmax32(p0, p1);
            if (first) {
                aq -= rm;
#pragma unroll
                for (int reg = 0; reg < 16; ++reg) { p0[reg] -= rm; p1[reg] -= rm; }
                first = false;
            } else if (__any(rm > AT_THR)) {
                const float dl = fmaxf(rm, 0.f); aq -= dl; const float f = __builtin_amdgcn_exp2f(-dl); l_run *= f;
#pragma unroll
                for (int reg = 0; reg < 16; ++reg) { p0[reg] -= dl; p1[reg] -= dl; }
                if (hh == 0) wsf[r] = f;
                LDS_WAIT();
#pragma unroll
                for (int g = 0; g < 4; ++g) { const f32x4 fv = *(const LAS f32x4*)(wsf + 8 * g + 4 * hh);
#pragma unroll
                    for (int i = 0; i < 4; ++i) { o0[4 * g + i] *= fv[i]; o1[4 * g + i] *= fv[i]; } }
            }
            float rs = 0.f;
#pragma unroll
            for (int reg = 0; reg < 16; ++reg) { p0[reg] = __builtin_amdgcn_exp2f(p0[reg]); p1[reg] = __builtin_amdgcn_exp2f(p1[reg]); rs += p0[reg] + p1[reg]; }
            l_run += rs;
#pragma unroll
            for (int blk = 0; blk < 2; ++blk) {
                const unsigned ad = Vt + (unsigned)((32 * blk + 4 * hh + tq) * AT_VP + (16 * tblk + 4 * tp) * 2);
                s16x4 v[8];
                asm volatile("ds_read_b64_tr_b16 %0, %8 offset:%c9\n\tds_read_b64_tr_b16 %1, %8 offset:%c10\n\tds_read_b64_tr_b16 %2, %8 offset:%c11\n\tds_read_b64_tr_b16 %3, %8 offset:%c12\n\t"
                             "ds_read_b64_tr_b16 %4, %8 offset:%c13\n\tds_read_b64_tr_b16 %5, %8 offset:%c14\n\tds_read_b64_tr_b16 %6, %8 offset:%c15\n\tds_read_b64_tr_b16 %7, %8 offset:%c16\n\ts_waitcnt lgkmcnt(0)"
                             : "=&v"(v[0]), "=&v"(v[1]), "=&v"(v[2]), "=&v"(v[3]), "=&v"(v[4]), "=&v"(v[5]), "=&v"(v[6]), "=&v"(v[7])
                             : "v"(ad), "i"(0), "i"(8 * AT_VP), "i"(64), "i"(8 * AT_VP + 64), "i"(16 * AT_VP), "i"(24 * AT_VP), "i"(16 * AT_VP + 64), "i"(24 * AT_VP + 64) : "memory");
                const bf16x8 pa0 = pack_frag(blk ? p1 : p0, 0), pa1 = pack_frag(blk ? p1 : p0, 1);
                o0 = mfma32(pa0, __builtin_shufflevector(v[0], v[1], 0, 1, 2, 3, 4, 5, 6, 7), o0);
                o1 = mfma32(pa0, __builtin_shufflevector(v[2], v[3], 0, 1, 2, 3, 4, 5, 6, 7), o1);
                o0 = mfma32(pa1, __builtin_shufflevector(v[4], v[5], 0, 1, 2, 3, 4, 5, 6, 7), o0);
                o1 = mfma32(pa1, __builtin_shufflevector(v[6], v[7], 0, 1, 2, 3, 4, 5, 6, 7), o1);
            }
        }
        if (more) { const int nb = buf ^ 1; *(LAS v4u*)(L + AT_K0 + nb * (64 * AT_KP) + srow * AT_KP + sch * 16) = kreg; *(LAS v4u*)(L + AT_V0 + nb * (64 * AT_VP) + srow * AT_VP + sch * 16) = vreg;
            if (tid < 64) *(LAS float*)(L + AT_CS + nb * 256 + tid * 4) = creg; }
        __syncthreads();
        buf ^= 1;
    }
    l_run += __shfl_xor(l_run, 32);
    if (hh == 0) wsf[32 + r] = 1.0f / l_run;
    LDS_WAIT();
#pragma unroll
    for (int g = 0; g < 4; ++g) { const f32x4 iv = *(const LAS f32x4*)(wsf + 32 + 8 * g + 4 * hh);
#pragma unroll
        for (int i = 0; i < 4; ++i) { const int q = q0 + 32 * wave + 8 * g + 4 * hh + i; bf16* op = OAB + (rowb + q) * D + h * 64;
            op[r] = (bf16)f2bf(o0[4 * g + i] * iv[i]); op[32 + r] = (bf16)f2bf(o1[4 * g + i] * iv[i]); } }
}

__device__ __forceinline__ void gdn_sample_unit(Frame& F, int unit) {
    int tid_o = threadIdx.x; asm volatile("" : "+v"(tid_o));
    const int s = unit >> 2, h = unit & 3, tid = tid_o;
    LAS float* L = (LAS float*)(F.lds + RING_OFF);
    LAS float* qkv = L; LAS float* red = L + 1536; LAS float* scal = L + 2048 + 64;
    const bf16* GQ = (const bf16*)(F.ws + WS_GQ); const float* GAB = (const float*)(F.ws + WS_GAB); const float* cw = F.in[15];
    __syncthreads();
    if (tid < 384) {
        const int X = tid >> 7, c = tid & 127, ch = X * 512 + h * 128 + c;
        float xp[7];
#pragma unroll
        for (int i = 0; i < 3; ++i) xp[i] = F.in[7][((size_t)s * 3 + i) * CCH + ch];
#pragma unroll
        for (int j = 0; j < 4; ++j) xp[3 + j] = bf2f(GQ[(size_t)(MP + s * 4 + j) * CCH + ch]);
        const float w0 = cw[ch], w1 = cw[CCH + ch], w2 = cw[2 * CCH + ch], w3 = cw[3 * CCH + ch];
#pragma unroll
        for (int j = 0; j < 4; ++j) { const float y = w0 * xp[j] + w1 * xp[j + 1] + w2 * xp[j + 2] + w3 * xp[j + 3]; qkv[(X * 4 + j) * 128 + c] = y * __builtin_amdgcn_rcpf(1.0f + __expf(-y)); }
    }
    if (tid >= 448 && tid < 452) { const int j = tid - 448; scal[j] = __expf(GAB[(size_t)(MP + s * 4 + j) * 8 + h]); scal[4 + j] = GAB[(size_t)(MP + s * 4 + j) * 8 + 4 + h]; }
    __syncthreads();
    { const int w = F.wave, X = w >> 2, j = w & 3; LAS float* v = qkv + (X * 4 + j) * 128; const float a = v[F.lane], b2 = v[64 + F.lane];
      const float ss = wave_sum(a * a + b2 * b2); float rn = __builtin_amdgcn_rsqf(ss + EPS); if (X == 0) rn *= 0.08838834764831845f;
      v[F.lane] = a * rn; v[64 + F.lane] = b2 * rn; }
    __syncthreads();
    const int dv = tid & 127, rg = tid >> 7;
    float S[32];
    const float* sp = F.in[8] + ((size_t)(s * 4 + h) * 128 + rg * 32) * 128 + dv;
#pragma unroll
    for (int i = 0; i < 32; ++i) S[i] = sp[(size_t)i * 128];
    float ov[4];
#pragma unroll
    for (int j = 0; j < 4; ++j) {
        const float a = scal[j], be = scal[4 + j]; const LAS float* qj = qkv + (0 * 4 + j) * 128 + rg * 32; const LAS float* kj = qkv + (1 * 4 + j) * 128 + rg * 32;
        float ks = 0.f;
#pragma unroll
        for (int i = 0; i < 32; ++i) { S[i] *= a; ks += kj[i] * S[i]; }
        red[rg * 128 + dv] = ks; __syncthreads();
        const float kS = red[dv] + red[128 + dv] + red[256 + dv] + red[384 + dv];
        const float vn = be * (qkv[(2 * 4 + j) * 128 + dv] - kS);
        float os = 0.f;
#pragma unroll
        for (int i = 0; i < 32; ++i) { S[i] += kj[i] * vn; os += qj[i] * S[i]; }
        __syncthreads();
        red[rg * 128 + dv] = os; __syncthreads();
        ov[j] = red[dv] + red[128 + dv] + red[256 + dv] + red[384 + dv];
        __syncthreads();
    }
    float* so = F.out + OFF_SSS + ((size_t)(s * 4 + h) * 128 + rg * 32) * 128 + dv;
#pragma unroll
    for (int i = 0; i < 32; ++i) so[(size_t)i * 128] = S[i];
    {
        float ssj[4];
#pragma unroll
        for (int j = 0; j < 4; ++j) { const float v = wave_sum(ov[j] * ov[j]); if (F.lane == 0) red[j * 8 + F.wave] = v; }
        __syncthreads();
#pragma unroll
        for (int j = 0; j < 4; ++j) ssj[j] = red[j * 8] + red[j * 8 + 1];
        if (rg == 0) {
            const bf16* GZ = (const bf16*)(F.ws + WS_GZ); bf16* OAB = (bf16*)(F.ws + WS_OAB); const float gn = F.in[18][dv];
#pragma unroll
            for (int j = 0; j < 4; ++j) { const size_t row = MP + s * 4 + j; const float y = ov[j] * __builtin_amdgcn_rsqf(ssj[j] * (1.0f / 128.0f) + EPS) * gn * bf2f(GZ[row * 512 + h * 128 + dv]);
                OAB[row * D + 512 + h * 128 + dv] = (bf16)f2bf(y); }
        }
    }
    __syncthreads();
}
__device__ __forceinline__ void fox_cumsum_seg(Frame& F, int w) {
    int tid_o = threadIdx.x; asm volatile("" : "+v"(tid_o));
    const int b = w >> 7, seg = w & 127, i = tid_o >> 3, h = tid_o & 7;
    LAS float* part = (LAS float*)(F.lds + RING_OFF);
    const float* src = (const float*)(F.ws + WS_LGF) + (size_t)b * SEQ * 8;
    __syncthreads();
    float a = 0.f;
    { float a0 = 0.f, a1 = 0.f, a2 = 0.f, a3 = 0.f; int sgi = 0;
      for (; sgi + 8 <= seg; sgi += 8) { float v[8];
#pragma unroll
          for (int q = 0; q < 8; ++q) v[q] = src[(size_t)(64 * (sgi + q) + i) * 8 + h];
          a0 += v[0] + v[4]; a1 += v[1] + v[5]; a2 += v[2] + v[6]; a3 += v[3] + v[7]; }
      for (; sgi < seg; ++sgi) a0 += src[(size_t)(64 * sgi + i) * 8 + h];
      a = (a0 + a1) + (a2 + a3); }
    const float mine = src[(size_t)(64 * seg + i) * 8 + h];
    part[i * 8 + h] = a; part[512 + i * 8 + h] = mine;
    __syncthreads();
    float run = 0.f;
#pragma unroll 8
    for (int q = 0; q < 64; ++q) run += part[q * 8 + h];
    for (int q = 0; q <= i; ++q) run += part[512 + q * 8 + h];
    ((float*)(F.ws + WS_CUM))[((size_t)b * SEQ + 64 * seg + i) * 8 + h] = run * LOG2E;
    __syncthreads();
}
__device__ __forceinline__ void conv_out_job(Frame& F) {
    const bf16* GQ = (const bf16*)(F.ws + WS_GQ);
    for (int e = F.vcu * (NWAVES * 64) + F.tid; e < (NB * 3 + DB * 3) * CCH; e += F.G * NWAVES * 64) {
        const int rr = e / CCH, c = e % CCH;
        if (rr < NB * 3) { const int b = rr / 3, i = rr % 3; F.out[OFF_CVP + (size_t)rr * CCH + c] = bf2f(GQ[((size_t)b * SEQ + SEQ - 3 + i) * CCH + c]); }
        else { const int r2 = rr - NB * 3, s = r2 / 3, i = r2 % 3; F.out[OFF_CVS + (size_t)r2 * CCH + c] = bf2f(GQ[(size_t)(MP + s * 4 + 1 + i) * CCH + c]); }
    }
}
__device__ __forceinline__ void gdn_outnorm_rows(Frame& F) {
    const float* OG = (const float*)(F.ws + WS_OG); const bf16* GZ = (const bf16*)(F.ws + WS_GZ); bf16* OAB = (bf16*)(F.ws + WS_OAB);
    const int gw = F.vcu * NWAVES + F.wave, NGW = F.G * NWAVES, lane = F.lane;
    const f32x4 g0 = *(const f32x4*)(F.in[18] + (lane & 15) * 8), g1 = *(const f32x4*)(F.in[18] + (lane & 15) * 8 + 4);
    for (int m0 = gw; m0 < MP; m0 += 4 * NGW) {
        f32x4 a[4], c[4]; v4u z[4];
#pragma unroll
        for (int k = 0; k < 4; ++k) { const size_t m = (size_t)m0 + (size_t)k * NGW; a[k] = *(const f32x4*)(OG + m * 512 + lane * 8); c[k] = *(const f32x4*)(OG + m * 512 + lane * 8 + 4); z[k] = *(const v4u*)(GZ + m * 512 + lane * 8); }
#pragma unroll
        for (int k = 0; k < 4; ++k) { const size_t m = (size_t)m0 + (size_t)k * NGW;
            float ss = (a[k][0] * a[k][0] + a[k][1] * a[k][1]) + (a[k][2] * a[k][2] + a[k][3] * a[k][3]) + (c[k][0] * c[k][0] + c[k][1] * c[k][1]) + (c[k][2] * c[k][2] + c[k][3] * c[k][3]);
            ss = red16(ss);
            const float rs = __builtin_amdgcn_rsqf(ss * (1.0f / 128.0f) + EPS);
            v4u o; o.x = pk2(a[k][0] * rs * g0[0] * bflo(z[k].x), a[k][1] * rs * g0[1] * bfhi(z[k].x)); o.y = pk2(a[k][2] * rs * g0[2] * bflo(z[k].y), a[k][3] * rs * g0[3] * bfhi(z[k].y));
            o.z = pk2(c[k][0] * rs * g1[0] * bflo(z[k].z), c[k][1] * rs * g1[1] * bfhi(z[k].z)); o.w = pk2(c[k][2] * rs * g1[2] * bflo(z[k].w), c[k][3] * rs * g1[3] * bfhi(z[k].w));
            *(v4u*)(OAB + m * D + 512 + lane * 8) = o; }
    }
}
template <bool AF32, bool SUMSQ>
__device__ __forceinline__ void skinny_tile(const void* A, int lda, const bf16* Bt, int ldb, int n0, int k0, int k1, int wave, int lane, f32x4s& acc, float& ssq) {
    const int fr = lane & 15, fq = lane >> 4;
    acc = (f32x4s){0.f, 0.f, 0.f, 0.f}; float s = 0.f;
    const bf16* bp = Bt + (size_t)(n0 + fr) * ldb + 8 * fq;
    const float* apf = (const float*)A + (size_t)(16 * wave + fr) * lda + 8 * fq;
    const bf16* aph = (const bf16*)A + (size_t)(16 * wave + fr) * lda + 8 * fq;
#pragma unroll 8
    for (int k = k0; k < k1; k += 32) {
        const bf16x8 b = *(const bf16x8*)(bp + k);
        bf16x8 a;
        if constexpr (AF32) { const f32x4 x0 = *(const f32x4*)(apf + k), x1 = *(const f32x4*)(apf + k + 4);
            if constexpr (SUMSQ) s += (x0[0] * x0[0] + x0[1] * x0[1]) + (x0[2] * x0[2] + x0[3] * x0[3]) + (x1[0] * x1[0] + x1[1] * x1[1]) + (x1[2] * x1[2] + x1[3] * x1[3]);
            v4u p; p.x = pk2(x0[0], x0[1]); p.y = pk2(x0[2], x0[3]); p.z = pk2(x1[0], x1[1]); p.w = pk2(x1[2], x1[3]); a = __builtin_bit_cast(bf16x8, p);
        } else { const v4u p = *(const v4u*)(aph + k); a = __builtin_bit_cast(bf16x8, p);
            if constexpr (SUMSQ) { float t0 = bflo(p.x), t1 = bfhi(p.x), t2 = bflo(p.y), t3 = bfhi(p.y), t4 = bflo(p.z), t5 = bfhi(p.z), t6 = bflo(p.w), t7 = bfhi(p.w);
                s += (t0 * t0 + t1 * t1) + (t2 * t2 + t3 * t3) + (t4 * t4 + t5 * t5) + (t6 * t6 + t7 * t7); } }
        acc = mfma16(a, b, acc);
    }
    if constexpr (SUMSQ) { s += __shfl_xor(s, 16); s += __shfl_xor(s, 32); }
    ssq = s;
}
template <bool AF32, bool SUMSQ>
__device__ __forceinline__ void skinny_half(const void* A, int lda, const bf16* Bt, int ldb, int n0, int k0, int k1, int mh, int wave, int lane, LAS unsigned char* scr, f32x4s& acc, float& ssq) {
    const int mt = wave & 3, kh = wave >> 2, kl = (k1 - k0) >> 1;
    const void* Ah = AF32 ? (const void*)((const float*)A + (size_t)(64 * mh) * lda) : (const void*)((const bf16*)A + (size_t)(64 * mh) * lda);
    skinny_tile<AF32, SUMSQ>(Ah, lda, Bt, ldb, n0, k0 + kh * kl, k0 + kh * kl + kl, mt, lane, acc, ssq);
    __syncthreads();
    if (kh == 1) { *(LAS f32x4s*)(scr + (mt * 64 + lane) * 16) = acc; if (SUMSQ) *(LAS float*)(scr + 4096 + (mt * 64 + lane) * 4) = ssq; }
    __syncthreads();
    if (kh == 0) { acc += *(const LAS f32x4s*)(scr + (mt * 64 + lane) * 16); if (SUMSQ) ssq += *(const LAS float*)(scr + 4096 + (mt * 64 + lane) * 4); }
}
__device__ __forceinline__ void sample_p5(Frame& F, int u) {
    int tid_o = threadIdx.x; asm volatile("" : "+v"(tid_o));
    const int lane = tid_o & 63, wave = __builtin_amdgcn_readfirstlane(tid_o >> 6), fr = lane & 15, fq = lane >> 4;
    LAS unsigned char* scr = F.lds + RING_OFF;
    const bf16* OAB = (const bf16*)(F.ws + WS_OAB) + (size_t)MP * D; const bf16* GT = (const bf16*)(F.ws + WS_GT) + (size_t)MP * 2048;
    if (u < 128) {
        const int cu = u >> 1, mh = u & 1; f32x4s aa, ab; float d;
        skinny_half<false, false>(OAB, D, (const bf16*)(F.ws + WS_WAB), D, 16 * cu, 0, 512, mh, wave, lane, scr, aa, d);
        __syncthreads();
        skinny_half<false, false>(OAB, D, (const bf16*)(F.ws + WS_WAB), D, 16 * cu, 512, 1024, mh, wave, lane, scr, ab, d);
        if (wave < 4) { bf16* MRG = (bf16*)(F.ws + WS_MRG) + (size_t)MP * D;
#pragma unroll
            for (int i = 0; i < 4; ++i) { const int row = 64 * mh + 16 * wave + 4 * fq + i, col = 16 * cu + fr;
                const float ga = bf2f(GT[(size_t)row * 2048 + col]), gb = bf2f(GT[(size_t)row * 2048 + 1024 + col]);
                MRG[(size_t)row * D + col] = (bf16)f2bf(ga * aa[i] + gb * ab[i]); } }
    } else if (u < 256) {
        const int cu = (u - 128) >> 1, mh = u & 1; f32x4s a; float d;
        skinny_half<false, false>((const bf16*)(F.ws + WS_PLB) + (size_t)MP * PLE, PLE, (const bf16*)(F.ws + WS_WPL), PLE, 16 * cu, 0, PLE, mh, wave, lane, scr, a, d);
        if (wave < 4) { bf16* PL = (bf16*)(F.ws + WS_PL) + (size_t)MP * D;
#pragma unroll
            for (int i = 0; i < 4; ++i) PL[(size_t)(64 * mh + 16 * wave + 4 * fq + i) * D + 16 * cu + fr] = (bf16)f2bf(a[i]); }
    }
}
__device__ __forceinline__ void sample_zero_x2(Frame& F, int q) {
    float* X2 = (float*)(F.ws + WS_X2) + (size_t)MP * D + (size_t)q * 32 * D;
    for (int e = F.tid; e < 32 * D / 4; e += NWAVES * 64) ((f32x4*)X2)[e] = (f32x4){0.f, 0.f, 0.f, 0.f};
}
__device__ __forceinline__ void sample_p6(Frame& F, int u) {
    int tid_o = threadIdx.x; asm volatile("" : "+v"(tid_o));
    const int lane = tid_o & 63, wave = __builtin_amdgcn_readfirstlane(tid_o >> 6), fr = lane & 15, fq = lane >> 4;
    if (u >= 128) return;
    const int cu = u >> 1, mh = u & 1; f32x4s a; float d;
    skinny_half<false, false>((const bf16*)(F.ws + WS_MRG) + (size_t)MP * D, D, (const bf16*)(F.ws + WS_WOUT), D, 16 * cu, 0, D, mh, wave, lane, F.lds + RING_OFF, a, d);
    if (wave < 4) { float* X1 = (float*)(F.ws + WS_X1) + (size_t)MP * D; bf16* X1B = (bf16*)(F.ws + WS_X1B) + (size_t)MP * D;
#pragma unroll
        for (int i = 0; i < 4; ++i) { const int row = 64 * mh + 16 * wave + 4 * fq + i, col = 16 * cu + fr; const float v = a[i] + F.in[1][(size_t)row * D + col];
            X1[(size_t)row * D + col] = v; X1B[(size_t)row * D + col] = (bf16)f2bf(v); } }
}
template <bool SUMSQ>
__device__ __forceinline__ void skinny_half2(const bf16* A, int lda, const bf16* Bt, int ldb, int n0, int k0, int k1, int mh, int wave, int lane, LAS unsigned char* scr, f32x4s (&acc)[2], float& ssq) {
    const int mt = wave & 3, kh = wave >> 2, kl = (k1 - k0) >> 1, fr = lane & 15, fq = lane >> 4;
    acc[0] = (f32x4s){0.f, 0.f, 0.f, 0.f}; acc[1] = (f32x4s){0.f, 0.f, 0.f, 0.f}; float s = 0.f;
    const bf16* ap = A + (size_t)(64 * mh + 16 * mt + fr) * lda + 8 * fq; const bf16* bp0 = Bt + (size_t)(n0 + fr) * ldb + 8 * fq; const bf16* bp1 = bp0 + (size_t)16 * ldb;
    const int ka = k0 + kh * kl;
#pragma unroll 8
    for (int ks = 0; ks < 16; ++ks) { const int k = ka + 32 * ks;
        const v4u p = *(const v4u*)(ap + k); const bf16x8 a = __builtin_bit_cast(bf16x8, p); const bf16x8 b0 = *(const bf16x8*)(bp0 + k), b1 = *(const bf16x8*)(bp1 + k);
        if constexpr (SUMSQ) { float t0 = bflo(p.x), t1 = bfhi(p.x), t2 = bflo(p.y), t3 = bfhi(p.y), t4 = bflo(p.z), t5 = bfhi(p.z), t6 = bflo(p.w), t7 = bfhi(p.w);
            s += (t0 * t0 + t1 * t1) + (t2 * t2 + t3 * t3) + (t4 * t4 + t5 * t5) + (t6 * t6 + t7 * t7); }
        acc[0] = mfma16(a, b0, acc[0]); acc[1] = mfma16(a, b1, acc[1]);
    }
    if constexpr (SUMSQ) { s += __shfl_xor(s, 16); s += __shfl_xor(s, 32); }
    __syncthreads();
    if (kh == 1) { *(LAS f32x4s*)(scr + (mt * 64 + lane) * 32) = acc[0]; *(LAS f32x4s*)(scr + (mt * 64 + lane) * 32 + 16) = acc[1]; if (SUMSQ) *(LAS float*)(scr + 8192 + (mt * 64 + lane) * 4) = s; }
    __syncthreads();
    if (kh == 0) { acc[0] += *(const LAS f32x4s*)(scr + (mt * 64 + lane) * 32); acc[1] += *(const LAS f32x4s*)(scr + (mt * 64 + lane) * 32 + 16); if (SUMSQ) s += *(const LAS float*)(scr + 8192 + (mt * 64 + lane) * 4); }
    ssq = s;
}
__device__ __forceinline__ void sample_p7(Frame& F, int u) {
    int tid_o = threadIdx.x; asm volatile("" : "+v"(tid_o));
    const int lane = tid_o & 63, wave = __builtin_amdgcn_readfirstlane(tid_o >> 6), fr = lane & 15, fq = lane >> 4;
    if (u >= 256) return;
    const int cu = u >> 1, mh = u & 1; f32x4s a[2]; float ss;
    skinny_half2<true>((const bf16*)(F.ws + WS_X1B) + (size_t)MP * D, D, (const bf16*)(F.ws + WS_WUP), D, 32 * cu, 0, D, mh, wave, lane, F.lds + RING_OFF, a, ss);
    if (wave < 4) { const float rs = __builtin_amdgcn_rsqf(ss * (1.0f / D) + EPS); bf16* HB = (bf16*)(F.ws + WS_HB) + (size_t)MP * DFF;
#pragma unroll
        for (int i = 0; i < 4; ++i) { const float r = __shfl(rs, 4 * fq + i);
#pragma unroll
            for (int nt = 0; nt < 2; ++nt) { const float v = fmaxf(a[nt][i] * r, 0.f); HB[(size_t)(64 * mh + 16 * wave + 4 * fq + i) * DFF + 32 * cu + 16 * nt + fr] = (bf16)f2bf(v * v); } } }
}
__device__ __forceinline__ void sample_p8(Frame& F, int u) {
    int tid_o = threadIdx.x; asm volatile("" : "+v"(tid_o));
    const int lane = tid_o & 63, wave = __builtin_amdgcn_readfirstlane(tid_o >> 6), fr = lane & 15, fq = lane >> 4;
    if (u >= 256) return;
    const int cu = u & 31, mh = (u >> 5) & 1, kq = u >> 6; f32x4s a[2]; float d;
    skinny_half2<false>((const bf16*)(F.ws + WS_HB) + (size_t)MP * DFF, DFF, (const bf16*)(F.ws + WS_WDN), DFF, 32 * cu, 1024 * kq, 1024 * kq + 1024, mh, wave, lane, F.lds + RING_OFF, a, d);
    if (wave < 4) { float* X2 = (float*)(F.ws + WS_X2) + (size_t)MP * D; const float* X1 = (const float*)(F.ws + WS_X1) + (size_t)MP * D;
#pragma unroll
        for (int i = 0; i < 4; ++i)
#pragma unroll
            for (int nt = 0; nt < 2; ++nt) { const int row = 64 * mh + 16 * wave + 4 * fq + i, col = 32 * cu + 16 * nt + fr; float v = a[nt][i]; if (kq == 0) v += X1[(size_t)row * D + col]; atomicAdd(X2 + (size_t)row * D + col, v); } }
}
__device__ __forceinline__ void sample_p9(Frame& F, int u) {
    int tid_o = threadIdx.x; asm volatile("" : "+v"(tid_o));
    const int lane = tid_o & 63, wave = __builtin_amdgcn_readfirstlane(tid_o >> 6), fr = lane & 15, fq = lane >> 4;
    if (u >= 128) return;
    const int cu = u >> 1, mh = u & 1;
    const float* X2 = (const float*)(F.ws + WS_X2) + (size_t)MP * D; const bf16* PL = (const bf16*)(F.ws + WS_PL) + (size_t)MP * D;
    f32x4s a; float ss;
    skinny_half<true, true>(X2, D, (const bf16*)(F.ws + WS_WGT), D, 16 * cu, 0, D, mh, wave, lane, F.lds + RING_OFF, a, ss);
    if (wave < 4) { const float rs = __builtin_amdgcn_rsqf(ss * (1.0f / D) + EPS);
#pragma unroll
        for (int i = 0; i < 4; ++i) { const int row = 64 * mh + 16 * wave + 4 * fq + i, col = 16 * cu + fr; const float r = __shfl(rs, 4 * fq + i);
            F.out[OFF_YS + (size_t)row * D + col] = X2[(size_t)row * D + col] + bf2f(PL[(size_t)row * D + col]) * __builtin_amdgcn_rcpf(1.0f + __expf(-a[i] * r)); } }
}
#ifndef MK_N_LAUNCHES
#define MK_N_LAUNCHES 1
#endif
constexpr int N_PHASES = 10;
__device__ __forceinline__ int q_fetch(Frame& F, int qi) {
    __syncthreads();
    if (F.tid == 0) F.MISC[16] = __hip_atomic_fetch_add((unsigned*)(F.ctl + CW_Q + 64 * qi), 1u, __ATOMIC_RELAXED, __HIP_MEMORY_SCOPE_AGENT);
    __syncthreads();
    return (int)F.MISC[16];
}
__device__ __forceinline__ void p2_publish(Frame& F) {
    asm volatile("s_waitcnt vmcnt(0)" ::: "memory"); __syncthreads();
    if (F.tid == 0) { __builtin_amdgcn_fence(__ATOMIC_RELEASE, "agent"); asm volatile("s_waitcnt vmcnt(0)" ::: "memory");
        (void)__hip_atomic_fetch_add((unsigned*)(F.ctl + CW_PROG + 64 * 16), 1u, __ATOMIC_RELAXED, __HIP_MEMORY_SCOPE_AGENT); }
}
__device__ __forceinline__ void p2_wait(Frame& F, unsigned* tmo) {
    if (F.tid == 0) { unsigned sp = 0;
        while (__hip_atomic_load((unsigned*)(F.ctl + CW_PROG + 64 * 16), __ATOMIC_RELAXED, __HIP_MEMORY_SCOPE_AGENT) < (unsigned)F.G) { __builtin_amdgcn_s_sleep(2);
            if ((++sp & 255u) == 0u) { if (__hip_atomic_load(tmo, __ATOMIC_RELAXED, __HIP_MEMORY_SCOPE_AGENT)) break; if (sp > (1u << 20)) { atomicAdd(tmo, 1u); break; } } }
        __builtin_amdgcn_fence(__ATOMIC_ACQUIRE, "agent"); asm volatile("s_waitcnt vmcnt(0)" ::: "memory"); }
    __syncthreads();
}
__global__ void __launch_bounds__(NWAVES * 64, 2) mk_fwd(Args args) {
    extern __shared__ __attribute__((aligned(16))) unsigned char lds[];
    Frame F;
    F.lds = (LAS unsigned char*)lds;
    F.MISC = (volatile LAS unsigned*)(F.lds + MISC_OFF);
    F.tid = threadIdx.x; F.lane = F.tid & 63; F.wave = __builtin_amdgcn_readfirstlane(F.tid >> 6);
    F.G = gridDim.x; { const int bx = blockIdx.x; F.vcu = (F.G % 8 == 0) ? (bx % 8) * (F.G / 8) + bx / 8 : bx; }
    F.ws = args.ws; F.out = args.out; F.ctl = (gu32*)(args.ws + WS_CTL);
#pragma unroll
    for (int i = 0; i < 28; ++i) F.in[i] = (const float*)args.in[i];
    F.page_table = (const int*)args.in[9];
    for (int u = F.tid; u < (LDS_BYTES - LDSCTL_OFF) / 4; u += NWAVES * 64) ((LAS unsigned*)(F.lds + LDSCTL_OFF))[u] = 0u;
    __syncthreads();
    XcdBarrier bar; bar.bar = (unsigned*)(F.ctl + CW_BAR); bar.x = 0; bar.st = nullptr;
    if (MK_N_LAUNCHES == 1) bar = xcd_barrier_post((unsigned*)(F.ctl + CW_BAR), F.MISC + 8);
#define GRID_BAR() do { if (MK_N_LAUNCHES == 1) xcd_barrier(bar); } while (0)
    const int lo = args.ph_lo, hi = args.ph_hi;
#ifndef PH_MASK
#define PH_MASK 0x3ff
#endif
#define IN(k) (((PH_MASK >> (k)) & 1) && lo <= (k) && (k) < hi)
#define BOTH(k) (IN(k) && IN((k) + 1))
    unsigned char* ws = args.ws;
    bf16* XN = (bf16*)(ws + WS_XN); bf16* QB = (bf16*)(ws + WS_QB); bf16* KB = (bf16*)(ws + WS_KB); bf16* VB = (bf16*)(ws + WS_VB);
    bf16* GQ = (bf16*)(ws + WS_GQ); bf16* GZ = (bf16*)(ws + WS_GZ); bf16* GT = (bf16*)(ws + WS_GT);
    float* GAB = (float*)(ws + WS_GAB); float* LGF = (float*)(ws + WS_LGF);
    bf16* OAB = (bf16*)(ws + WS_OAB); bf16* MRG = (bf16*)(ws + WS_MRG); float* X1 = (float*)(ws + WS_X1); bf16* X1B = (bf16*)(ws + WS_X1B);
    bf16* HB = (bf16*)(ws + WS_HB); float* X2 = (float*)(ws + WS_X2); bf16* X2B = (bf16*)(ws + WS_X2B); bf16* PL = (bf16*)(ws + WS_PL);
    float* SS1 = (float*)(F.ctl + CW_SS1); float* SS2 = (float*)(F.ctl + CW_SS2);

    if (IN(0)) { p0_prologue(F); if (BOTH(0)) GRID_BAR(); }
    if (IN(1)) {
        pg8::Gemm g{XN, (const bf16*)(ws + WS_WIN), MPAD, NIN, D}; pg8::QueueOrder S; S.init(MPAD, NIN, (unsigned*)(F.ctl + CW_Q + 64 * 6), F.MISC + 12);
        { LAS float* par = (LAS float*)(F.lds + MISC_OFF + 256);
          if (F.tid < 64) { par[F.tid] = F.in[13][F.tid]; par[64 + F.tid] = F.in[14][F.tid]; }
          if (F.tid < 8) par[128 + F.tid] = F.in[12][F.tid];
          if (F.tid < 4) { par[136 + F.tid] = -__expf(F.in[16][F.tid]); par[140 + F.tid] = F.in[17][F.tid]; }
          __syncthreads(); }
        pg8::EpiIn E{QB, KB, VB, GQ, GZ, GT, GAB, LGF, F.out, (const LAS float*)(F.lds + MISC_OFF + 256)};
        pg8::gemm_phase<pg8::EpiIn, pg8::QueueOrder, true, true>(F.lds + RING_OFF, g, S, E);
        if (BOTH(1)) GRID_BAR();
    }
    if (IN(2)) {
        for (int u = F.vcu; u < 1024; u += F.G) gdn_prep_unit<0>(F, u);
        if (F.vcu < NB * 128) fox_cumsum_seg(F, F.vcu);
        conv_out_job(F);
        if (BOTH(2)) p2_publish(F);
    }
    if (IN(3)) {
        { const int su = (F.G == 256) ? (((F.vcu & 31) < 4) ? (F.vcu >> 5) * 4 + (F.vcu & 31) : -1) : (F.vcu < 32 ? F.vcu : -1);
          if (su >= 0) { if (lo <= 2) p2_wait(F, (unsigned*)(F.ctl + CW_BAR) + XB_TMO); gdn_scan_unit<0>(F, su); } }
        for (;;) { const int u = q_fetch(F, 0); if (u >= DB * GH) break; gdn_sample_unit(F, u); }
        float qkb;
        { const float a = fabsf(F.in[13][F.lane]), c = fabsf(F.in[14][F.lane]); float ma = a, mc = c;
#pragma unroll
          for (int o = 1; o < 64; o <<= 1) { ma = fmaxf(ma, __shfl_xor(ma, o)); mc = fmaxf(mc, __shfl_xor(mc, o)); }
          qkb = 64.0f * ma * mc * C2 * 1.02f; }
        const int attn_first = F.vcu & 1;
#pragma unroll 1
        for (int pass = 0; pass < 2; ++pass) {
            if ((pass ^ attn_first) & 1) {
                if (lo <= 2) p2_wait(F, (unsigned*)(F.ctl + CW_BAR) + XB_TMO);
                for (;;) { const int u = q_fetch(F, 2); if (u >= NB * FH * 32) break; attn_unit(F, ((u & 15) << 5) | (31 - (u >> 4)), qkb); }
            } else {
                for (;;) { const int u2 = q_fetch(F, 1); if (u2 >= DB * NPAGES / 2) break; decode_unit<false>(F, 2 * u2, F.wave); decode_unit<false>(F, 2 * u2 + 1, F.wave); }
            }
        }
        if (BOTH(3)) GRID_BAR();
    }
    if (IN(4)) {
        for (int r = F.vcu * NWAVES + F.wave; r < DB * FH * DS; r += F.G * NWAVES) decode_combine_row(F, r);
        gdn_outnorm_rows(F);
        if (F.vcu >= F.G - 4) sample_zero_x2(F, F.vcu - (F.G - 4));
        if (BOTH(4)) GRID_BAR();
    }
    if (IN(5)) {
        { pg8::Gemm g{OAB, (const bf16*)(ws + WS_WAB), MP, D, D}; pg8::StaticOrder S; S.init(MP, D, F.G, (int)blockIdx.x);
          pg8::EpiMerge E{MRG, GT};
          pg8::gemm_phase<pg8::EpiMerge, pg8::StaticOrder, true, true>(F.lds + RING_OFF, g, S, E); }
        __syncthreads();
        { pg8::Gemm g{(const bf16*)(ws + WS_PLB), (const bf16*)(ws + WS_WPL), MP, D, PLE}; pg8::StaticOrder S; S.init(MP, D, F.G, (int)blockIdx.x);
          pg8::EpiBf<0> E{PL, D, nullptr};
          pg8::gemm_phase<pg8::EpiBf<0>, pg8::StaticOrder, true, true>(F.lds + RING_OFF, g, S, E); }
        sample_p5(F, (F.G == 256) ? (F.vcu & 31) * 8 + (F.vcu >> 5) : F.vcu);
        if (BOTH(5)) GRID_BAR();
    }
    if (IN(6)) {
        pg8::Gemm g{MRG, (const bf16*)(ws + WS_WOUT), MP, D, D}; pg8::StaticOrder S; S.init(MP, D, F.G, (int)blockIdx.x);
        pg8::EpiRes<false, false> E{F.in[0], X1B, SS1, nullptr};
        pg8::gemm_phase<pg8::EpiRes<false, false>, pg8::StaticOrder, true, true>(F.lds + RING_OFF, g, S, E);
        sample_p6(F, (F.G == 256) ? (((F.vcu & 31) < 16) ? (F.vcu & 31) * 8 + (F.vcu >> 5) : 1000) : F.vcu);
        if (BOTH(6)) GRID_BAR();
    }
    if (IN(7)) {
        pg8::Gemm g{X1B, (const bf16*)(ws + WS_WUP), MP, DFF, D}; pg8::StaticOrder S; S.init(MP, DFF, F.G, (int)blockIdx.x);
        pg8::EpiBf<2> E{HB, DFF, nullptr};
        pg8::gemm_phase<pg8::EpiBf<2>, pg8::StaticOrder, true, true>(F.lds + RING_OFF, g, S, E);
        sample_p7(F, F.vcu);
        if (BOTH(7)) GRID_BAR();
    }
    if (IN(8)) {
        { pg8::Gemm g{HB, (const bf16*)(ws + WS_WDN), MP, D, DFF}; pg8::StaticOrder S; S.init(MP, D, F.G, (int)blockIdx.x);
          pg8::EpiRes<true, true> E{X1B, X2B, SS2, SS1};
          pg8::gemm_phase<pg8::EpiRes<true, true>, pg8::StaticOrder, true, true>(F.lds + RING_OFF, g, S, E); }
        sample_p8(F, F.vcu);
        if (BOTH(8)) GRID_BAR();
    }
    if (IN(9)) {
        pg8::Gemm g{X2B, (const bf16*)(ws + WS_WGT), MP, D, D}; pg8::StaticOrder S; S.init(MP, D, F.G, (int)blockIdx.x);
        pg8::EpiFinal E{X2B, PL, SS2, F.out};
        pg8::gemm_phase<pg8::EpiFinal, pg8::StaticOrder, true, true>(F.lds + RING_OFF, g, S, E);
        sample_p9(F, (F.G == 256) ? (((F.vcu & 31) < 16) ? (F.vcu & 31) * 8 + (F.vcu >> 5) : 1000) : F.vcu);
    }
#undef IN
#undef BOTH
}

extern "C" void kernel_launch(void* const* d_in, const int* in_sizes, int n_in, void* d_out, int out_size, void* d_ws, size_t ws_size, hipStream_t stream) {
    static int grid = 0;
    if (grid == 0) {
        if (n_in != 28 || out_size != (int)OUT_TOTAL || ws_size < WS_END) { fprintf(stderr, "kernel_launch: unexpected shapes (n_in %d out %d ws %zu)\n", n_in, out_size, ws_size); grid = -1; return; }
        int dev = 0, cus = 0, per_cu = 0;
        if (hipGetDevice(&dev) != hipSuccess || hipDeviceGetAttribute(&cus, hipDeviceAttributeMultiprocessorCount, dev) != hipSuccess) { grid = -1; return; }
        if (hipFuncSetAttribute((const void*)mk_fwd, hipFuncAttributeMaxDynamicSharedMemorySize, LDS_BYTES) != hipSuccess) { fprintf(stderr, "kernel_launch: hipFuncSetAttribute failed\n"); grid = -1; return; }
        if (hipOccupancyMaxActiveBlocksPerMultiprocessor(&per_cu, (const void*)mk_fwd, NWAVES * 64, LDS_BYTES) != hipSuccess || per_cu < 1)
            fprintf(stderr, "kernel_launch: occupancy query reports %d workgroups per CU\n", per_cu);
        (void)hipGetLastError();
        grid = cus;
        if (cus != 256) fprintf(stderr, "kernel_launch: built for a 256-CU device (unit-to-workgroup maps assume 256 workgroups); this one reports %d\n", cus);
    }
    if (grid < 0) return;
    if (hipMemsetAsync((char*)d_ws + WS_CTL, 0, CTL_ZERO_BYTES, stream) != hipSuccess) return;
    Args a{};
    for (int i = 0; i < 28; ++i) a.in[i] = d_in[i];
    a.out = (float*)d_out; a.ws = (unsigned char*)d_ws;
    if (MK_N_LAUNCHES == 1) { a.ph_lo = 0; a.ph_hi = N_PHASES; a.li = 0; hipLaunchKernelGGL(mk_fwd, dim3(grid), dim3(NWAVES * 64), LDS_BYTES, stream, a); }
    else for (int li = 0; li < N_PHASES; ++li) { a.ph_lo = li; a.ph_hi = li + 1; a.li = li; hipLaunchKernelGGL(mk_fwd, dim3(grid), dim3(NWAVES * 64), LDS_BYTES, stream, a); }
}
```

```cpp
#include <hip/hip_runtime.h>
#include <cstdio>
#include <cstdint>
#include <cmath>

constexpr int D = 1024, SEQ = 8192, NB = 2, MP = NB * SEQ;
constexpr int DB = 32, DS = 4, MS = DB * DS;
constexpr int MT = MP + MS, MPAD = 16640;
constexpr int FH = 8, FD = 64, FW = 512;
constexpr int GH = 4, GK = 128, GV = 128, CCH = 1536, CW = 4;
constexpr int DFF = 4096, PLE = 256, DIN = 5648;
constexpr int PAST = 8192, PAGE = 128, NPAGES = 64;
constexpr int NIN = 5888;
constexpr float EPS = 1e-6f;
constexpr float C2 = 0.125f * 1.4426950408889634f;
constexpr float LOG2E = 1.4426950408889634f;

constexpr size_t OFF_YP = 0, OFF_YS = 16777216, OFF_KP = 16908288, OFF_VP = 25296896, OFF_LFP = 33685504, OFF_CVP = 33816576,
                 OFF_SSP = 33825792, OFF_KS = 33956864, OFF_VS = 34022400, OFF_LFS = 34087936, OFF_CVS = 34088960, OFF_SSS = 34236416, OUT_TOTAL = 36333568;

constexpr size_t MiB = 1u << 20;
constexpr size_t WS_CTL = 0, CTL_ZERO_BYTES = 1 * MiB;
constexpr size_t WS_WIN = 2 * MiB, WS_WAB = 14 * MiB, WS_WOUT = 16 * MiB, WS_WUP = 18 * MiB, WS_WDN = 26 * MiB, WS_WGT = 34 * MiB, WS_WPL = 36 * MiB;
constexpr size_t WS_XN = 40 * MiB, WS_QB = 74 * MiB, WS_KB = 91 * MiB, WS_VB = 108 * MiB, WS_GQ = 126 * MiB, WS_GZ = 176 * MiB, WS_GT = 194 * MiB;
constexpr size_t WS_GAB = 260 * MiB, WS_LGF = 261 * MiB, WS_CUM = 262 * MiB, WS_OAB = 264 * MiB, WS_MRG = 298 * MiB, WS_X1 = 332 * MiB, WS_X1B = 398 * MiB;
constexpr size_t WS_HB = 432 * MiB, WS_X2 = 563 * MiB, WS_X2B = 629 * MiB, WS_PL = 663 * MiB, WS_GDN = 700 * MiB, WS_OG = 790 * MiB, WS_SFX = 824 * MiB, WS_DPART = 834 * MiB;
constexpr size_t WS_PLB = 856 * MiB;
constexpr size_t WS_END = 880 * MiB;
constexpr int CW_TMO = 0, CW_CODE = 1;
constexpr int CW_BAR = 4096;
constexpr int CW_Q = 8192;
constexpr int CW_PROG = 12288;
constexpr int CW_SS1 = 65536, CW_SS2 = 65536 + 16640 + 64;
static_assert((CW_SS2 + 16640) * 4 <= (int)CTL_ZERO_BYTES, "ctl");

constexpr int RING_OFF = 0, RING_BYTES = 131072;
constexpr int LDSCTL_OFF = RING_BYTES, MISC_OFF = LDSCTL_OFF + 320;
constexpr int LDS_BYTES = 147456;
constexpr int NWAVES = 8;

#define GAS __attribute__((address_space(1)))
#define LAS __attribute__((address_space(3)))
typedef unsigned short bf16;
typedef unsigned v4u __attribute__((ext_vector_type(4)));
typedef unsigned v2u __attribute__((ext_vector_type(2)));
typedef float f32x4 __attribute__((ext_vector_type(4)));
typedef float f32x16 __attribute__((ext_vector_type(16)));
typedef float f32x4s __attribute__((ext_vector_type(4)));
typedef short bf16x8 __attribute__((ext_vector_type(8)));
typedef short s16x4 __attribute__((ext_vector_type(4)));
typedef GAS unsigned gu32;
#define RLX_AGENT __ATOMIC_RELAXED, __HIP_MEMORY_SCOPE_AGENT
#define LDS_WAIT() asm volatile("s_waitcnt lgkmcnt(0)" ::: "memory")
#define VM_WAIT() asm volatile("s_waitcnt vmcnt(0)" ::: "memory")
typedef float f32x2_t __attribute__((ext_vector_type(2))); typedef __bf16 bf16x2_t __attribute__((ext_vector_type(2)));
__device__ __forceinline__ unsigned pk2(float lo, float hi) { const f32x2_t v = {lo, hi}; return __builtin_bit_cast(unsigned, __builtin_convertvector(v, bf16x2_t)); }
__device__ __forceinline__ unsigned f2bf(float f) { return pk2(f, 0.f) & 0xffffu; }
__device__ __forceinline__ float bf2f(unsigned short b) { return __builtin_bit_cast(float, (unsigned)b << 16); }
__device__ __forceinline__ float bflo(unsigned w) { return __builtin_bit_cast(float, w << 16); }
__device__ __forceinline__ float bfhi(unsigned w) { return __builtin_bit_cast(float, w & 0xffff0000u); }
__device__ __forceinline__ float sigmoidf_(float x) { return 1.0f / (1.0f + __expf(-x)); }
__device__ __forceinline__ float siluf_(float x) { return x / (1.0f + __expf(-x)); }
__device__ __forceinline__ float log_sigmoidf_(float z) { return fminf(z, 0.f) - __logf(1.0f + __expf(-fabsf(z))); }
__device__ __forceinline__ float softplusf_(float z) { return fmaxf(z, 0.f) + __logf(1.0f + __expf(-fabsf(z))); }
__device__ __forceinline__ float wave_sum(float v) {
#pragma unroll
    for (int o = 1; o < 64; o <<= 1) v += __shfl_xor(v, o);
    return v;
}
namespace pg8 {
#define PG8_LAS __attribute__((address_space(3)))
typedef unsigned short bf16_t;
typedef short bf16x8 __attribute__((ext_vector_type(8)));
typedef float f32x4 __attribute__((ext_vector_type(4)));
typedef unsigned u32x4 __attribute__((ext_vector_type(4)));
constexpr int BM = 256, BK = 64, HALF = 128, HTB = HALF * BK * 2  , STAGE_BYTES = 8 * HTB, NXCD = 8, WGM = 8;

__host__ __device__ __forceinline__ int lds_byte(int r, int c) { const int st = (r >> 4) * 2 + (c >> 5), rr = r & 15, cc = c & 31, ob = rr * 64 + cc * 2; return st * 1024 + (ob ^ (((ob >> 9) & 1) << 5)); }
__host__ __device__ __forceinline__ void stage_rc(int b, int& R, int& C) { const int st = b / 1024, sb = b % 1024, swz = sb ^ (((sb >> 9) & 1) << 5); R = (st >> 1) * 16 + swz / 64; C = (st & 1) * 32 + (swz % 64) / 2; }
__host__ __device__ __forceinline__ int perm32(int rho) { const int n = rho >> 4, i = rho & 15; return 8 * (i >> 2) + 4 * n + (i & 3); }

struct Unit { int pm, pn; };
struct Gemm { const bf16_t* A; const bf16_t* Bt; int M, N, K; };

struct StaticOrder {
    int nM, nN, nwg, G, c;
    __host__ __device__ void init(int M, int N, int G_, int c_) { nM = M / BM; nN = N / BM; nwg = nM * nN; G = G_; c = c_; }
    __host__ __device__ bool next(int i, Unit& u) const {
        const long L = (long)i * G + c; if (L >= nwg) return false;
        int wgid = (int)L; { const int q = nwg / NXCD, r = nwg % NXCD, xcd = wgid % NXCD, off = wgid / NXCD; wgid = (xcd < r ? xcd * (q + 1) : r * (q + 1) + (xcd - r) * q) + off; }
        const int nig = WGM * nN, gid = wgid / nig, fm = gid * WGM, gsz = (nM - fm) < WGM ? (nM - fm) : WGM;
        u.pm = fm + ((wgid % nig) % gsz); u.pn = (wgid % nig) / gsz; return true;
    }
    __device__ __forceinline__ void prefetch(int) const {}
    __device__ __forceinline__ void commit(int) const {}
    __device__ __forceinline__ void a_ready(const Unit&) const {}
    __device__ __forceinline__ void done(const Unit&) const {}
};
struct QueueOrder {
    unsigned* head; volatile PG8_LAS unsigned* slot; int nM, nN, nwg; mutable unsigned pend;
    __device__ __forceinline__ void init(int M, int N, unsigned* h, volatile PG8_LAS unsigned* s) { nM = M / BM; nN = N / BM; nwg = nM * nN; head = h; slot = s; }
    __device__ __forceinline__ void prefetch(int i) const { if (threadIdx.x == 0) pend = __hip_atomic_fetch_add(head, 1u, __ATOMIC_RELAXED, __HIP_MEMORY_SCOPE_AGENT); }
    __device__ __forceinline__ void commit(int i) const { if (threadIdx.x == 0) slot[i & 1] = pend; }
    __device__ __forceinline__ bool next(int i, Unit& u) const {
        if (i == 0) { __syncthreads(); prefetch(0); commit(0); __syncthreads(); }
        const int idx = (int)slot[i & 1]; if (idx >= nwg) return false;
        const int nig = WGM * nN, gid = idx / nig, fm = gid * WGM, gsz = (nM - fm) < WGM ? (nM - fm) : WGM;
        u.pm = fm + ((idx % nig) % gsz); u.pn = (idx % nig) / gsz; return true;
    }
    __device__ __forceinline__ void a_ready(const Unit&) const {}
    __device__ __forceinline__ void done(const Unit&) const {}
};

__device__ __forceinline__ unsigned cvt_pk_bf16(float lo, float hi) { unsigned r; asm volatile("v_cvt_pk_bf16_f32 %0, %1, %2" : "=v"(r) : "v"(lo), "v"(hi)); return r; }
#define EPI_GEOM int t_ = threadIdx.x; asm volatile("" : "+v"(t_)); const int wid_ = t_ >> 6, wr = wid_ >> 2, wc = wid_ & 3, fr = t_ & 15, fq = (t_ & 63) >> 4;
__device__ __forceinline__ u32x4 pack8(const f32x4 v0, const f32x4 v1) { u32x4 w; w.x = cvt_pk_bf16(v0[0], v0[1]); w.y = cvt_pk_bf16(v0[2], v0[3]); w.z = cvt_pk_bf16(v1[0], v1[1]); w.w = cvt_pk_bf16(v1[2], v1[3]); return w; }
__device__ __forceinline__ float* out_row(float* out, size_t offp, size_t offs, int row, int width) {
    if (row < MP) return out + offp + (size_t)row * width;
    if (row < MT) return out + offs + (size_t)(row - MP) * width;
    return nullptr;
}
struct EpiIn {
    static constexpr bool PERM = true, AFTER_DRAIN = false, MIDK = false;
    bf16_t *QB, *KB, *VB, *GQ, *GZ, *GT; float *GAB, *LGF; float* out;
    const PG8_LAS float* par;
    __device__ __forceinline__ void operator()(const f32x4 (&acc)[2][2][4][2], const Unit& u, int, int, int, int) const {
        EPI_GEOM
        const int pn = u.pn; const int row0 = u.pm * BM + wr * 64 + fr;
        if (pn < 4) {
            const bool isk = pn >= 2; const int head = 4 * (pn & 1) + wc; const PG8_LAS float* gv = par + (isk ? 64 : 0);
            f32x4 g[2][2];
#pragma unroll
            for (int bj = 0; bj < 2; ++bj)
#pragma unroll
                for (int n = 0; n < 2; ++n) g[bj][n] = *(const PG8_LAS f32x4*)(gv + 32 * bj + 8 * fq + 4 * n);
#pragma unroll
            for (int ai = 0; ai < 2; ++ai)
#pragma unroll
                for (int m = 0; m < 4; ++m) {
                    float ss = 0.f;
#pragma unroll
                    for (int bj = 0; bj < 2; ++bj)
#pragma unroll
                        for (int n = 0; n < 2; ++n) { const f32x4 x = acc[ai][bj][m][n]; ss += (x[0] * x[0] + x[1] * x[1]) + (x[2] * x[2] + x[3] * x[3]); }
                    ss += __shfl_xor(ss, 16); ss += __shfl_xor(ss, 32);
                    float rs = __builtin_amdgcn_rsqf(ss * (1.0f / 64.0f) + EPS); if (!isk) rs *= C2;
                    const int row = row0 + ai * HALF + m * 16;
                    float* orow = isk ? out_row(out, OFF_KP, OFF_KS, row, FW) : nullptr;
#pragma unroll
                    for (int bj = 0; bj < 2; ++bj) {
                        const f32x4 v0 = acc[ai][bj][m][0] * rs * g[bj][0], v1 = acc[ai][bj][m][1] * rs * g[bj][1];
                        const int col = head * 64 + 32 * bj + 8 * fq;
                        *(u32x4*)((isk ? KB : QB) + (size_t)row * FW + col) = pack8(v0, v1);
                        if (orow) { *(f32x4*)(orow + col) = v0; *(f32x4*)(orow + col + 4) = v1; }
                    }
                }
        } else if (pn < 6) {
#pragma unroll
            for (int ai = 0; ai < 2; ++ai)
#pragma unroll
                for (int m = 0; m < 4; ++m) { const int row = row0 + ai * HALF + m * 16; float* orow = out_row(out, OFF_VP, OFF_VS, row, FW);
#pragma unroll
                    for (int bj = 0; bj < 2; ++bj) { const int col = 256 * (pn - 4) + 128 * bj + 32 * wc + 8 * fq; const f32x4 v0 = acc[ai][bj][m][0], v1 = acc[ai][bj][m][1];
                        *(u32x4*)(VB + (size_t)row * FW + col) = pack8(v0, v1);
                        if (orow) { *(f32x4*)(orow + col) = v0; *(f32x4*)(orow + col + 4) = v1; } } }
        } else if (pn < 12) {
#pragma unroll
            for (int ai = 0; ai < 2; ++ai)
#pragma unroll
                for (int m = 0; m < 4; ++m) { const int row = row0 + ai * HALF + m * 16;
#pragma unroll
                    for (int bj = 0; bj < 2; ++bj) { const int col = 256 * (pn - 6) + 128 * bj + 32 * wc + 8 * fq;
                        *(u32x4*)(GQ + (size_t)row * CCH + col) = pack8(acc[ai][bj][m][0], acc[ai][bj][m][1]); } }
        } else if (pn < 14) {
#pragma unroll
            for (int ai = 0; ai < 2; ++ai)
#pragma unroll
                for (int m = 0; m < 4; ++m) { const int row = row0 + ai * HALF + m * 16;
#pragma unroll
                    for (int bj = 0; bj < 2; ++bj) { const int col = 256 * (pn - 12) + 128 * bj + 32 * wc + 8 * fq; f32x4 v0 = acc[ai][bj][m][0], v1 = acc[ai][bj][m][1];
#pragma unroll
                        for (int i = 0; i < 4; ++i) { v0[i] = v0[i] * __builtin_amdgcn_rcpf(1.0f + __expf(-v0[i])); v1[i] = v1[i] * __builtin_amdgcn_rcpf(1.0f + __expf(-v1[i])); }
                        *(u32x4*)(GZ + (size_t)row * 512 + col) = pack8(v0, v1); } }
        } else if (pn < 22) {
#pragma unroll
            for (int ai = 0; ai < 2; ++ai)
#pragma unroll
                for (int m = 0; m < 4; ++m) { const int row = row0 + ai * HALF + m * 16;
#pragma unroll
                    for (int bj = 0; bj < 2; ++bj) { const int col = 256 * (pn - 14) + 128 * bj + 32 * wc + 8 * fq; f32x4 v0 = acc[ai][bj][m][0], v1 = acc[ai][bj][m][1];
#pragma unroll
                        for (int i = 0; i < 4; ++i) { v0[i] = __builtin_amdgcn_rcpf(1.0f + __expf(-v0[i])); v1[i] = __builtin_amdgcn_rcpf(1.0f + __expf(-v1[i])); }
                        *(u32x4*)(GT + (size_t)row * 2048 + col) = pack8(v0, v1); } }
        } else {
            if (wc == 0 && fq < 2) {
#pragma unroll
                for (int ai = 0; ai < 2; ++ai)
#pragma unroll
                    for (int m = 0; m < 4; ++m) { const int row = row0 + ai * HALF + m * 16; const f32x4 a0 = acc[ai][0][m][0], a1 = acc[ai][0][m][1];
                        if (fq == 0) { f32x4 l0, l1;
#pragma unroll
                            for (int i = 0; i < 4; ++i) { l0[i] = log_sigmoidf_(a0[i] + par[128 + i]); l1[i] = log_sigmoidf_(a1[i] + par[132 + i]); }
                            *(f32x4*)(LGF + (size_t)row * 8) = l0; *(f32x4*)(LGF + (size_t)row * 8 + 4) = l1;
                            float* orow = out_row(out, OFF_LFP, OFF_LFS, row, 8); if (orow) { *(f32x4*)orow = l0; *(f32x4*)(orow + 4) = l1; }
                        } else { f32x4 ld, be;
#pragma unroll
                            for (int i = 0; i < 4; ++i) { ld[i] = par[136 + i] * softplusf_(a0[i] + par[140 + i]); be[i] = __builtin_amdgcn_rcpf(1.0f + __expf(-a1[i])); }
                            *(f32x4*)(GAB + (size_t)row * 8) = ld; *(f32x4*)(GAB + (size_t)row * 8 + 4) = be; } }
            }
        }
    }
};
template <int ACT> struct EpiBf {
    static constexpr bool PERM = true, AFTER_DRAIN = false, MIDK = false;
    bf16_t* O; int ldc; const float* ss;
    __device__ __forceinline__ void operator()(const f32x4 (&acc)[2][2][4][2], const Unit& u, int, int, int, int) const {
        EPI_GEOM
        const int row0 = u.pm * BM + wr * 64 + fr, col0 = u.pn * BM + wc * 32 + 8 * fq;
        float rsv[8];
        if (ACT == 1) {
#pragma unroll
            for (int g = 0; g < 8; ++g) rsv[g] = ss[row0 + (g >> 2) * HALF + (g & 3) * 16];
#pragma unroll
            for (int g = 0; g < 8; ++g) rsv[g] = __builtin_amdgcn_rsqf(rsv[g] * (1.0f / D) + EPS);
        }
#pragma unroll
        for (int ai = 0; ai < 2; ++ai)
#pragma unroll
            for (int m = 0; m < 4; ++m) { const int row = row0 + ai * HALF + m * 16; const float rs = (ACT == 1) ? rsv[ai * 4 + m] : 1.f;
#pragma unroll
                for (int bj = 0; bj < 2; ++bj) { f32x4 v0 = acc[ai][bj][m][0], v1 = acc[ai][bj][m][1];
                    if (ACT == 1 || ACT == 2) {
#pragma unroll
                        for (int i = 0; i < 4; ++i) { float a = fmaxf(v0[i] * rs, 0.f), b = fmaxf(v1[i] * rs, 0.f); v0[i] = a * a; v1[i] = b * b; } }
                    *(u32x4*)(O + (size_t)row * ldc + col0 + bj * HALF) = pack8(v0, v1); } }
    }
};
struct EpiMerge {
    static constexpr bool PERM = true, AFTER_DRAIN = false, MIDK = true;
    bf16_t* O; const bf16_t* GT;
    __device__ __forceinline__ void mid(f32x4 (&acc)[2][2][4][2], const Unit& u, int, int, int, int) const {
        int t_ = threadIdx.x; asm volatile("" : "+v"(t_));
        const int wid_ = t_ >> 6, wr = wid_ >> 2, wc = wid_ & 3, fr = t_ & 15, fq = (t_ & 63) >> 4;
        const int row0 = u.pm * BM + wr * 64 + fr, col0 = u.pn * BM + wc * 32 + 8 * fq;
        u32x4 ga[2], gb[2], na[2], nb[2];
        { const bf16_t* gp = GT + (size_t)row0 * 2048 + col0; ga[0] = *(const u32x4*)gp; ga[1] = *(const u32x4*)(gp + HALF); gb[0] = *(const u32x4*)(gp + 1024); gb[1] = *(const u32x4*)(gp + 1024 + HALF); }
#pragma unroll
        for (int g = 0; g < 8; ++g) { const int ai = g >> 2, m = g & 3;
            if (g < 7) { const bf16_t* gp = GT + (size_t)(row0 + ((g + 1) >> 2) * HALF + ((g + 1) & 3) * 16) * 2048 + col0; na[0] = *(const u32x4*)gp; na[1] = *(const u32x4*)(gp + HALF); nb[0] = *(const u32x4*)(gp + 1024); nb[1] = *(const u32x4*)(gp + 1024 + HALF); }
#pragma unroll
            for (int bj = 0; bj < 2; ++bj)
#pragma unroll
                for (int w = 0; w < 4; ++w) { const float a0 = bflo(ga[bj][w]), a1 = bfhi(ga[bj][w]), b0 = fmaxf(bflo(gb[bj][w]), 1e-30f), b1 = fmaxf(bfhi(gb[bj][w]), 1e-30f);
                    acc[ai][bj][m][w >> 1][(w & 1) * 2] *= a0 * __builtin_amdgcn_rcpf(b0); acc[ai][bj][m][w >> 1][(w & 1) * 2 + 1] *= a1 * __builtin_amdgcn_rcpf(b1); }
            asm volatile("" : "+v"(acc[ai][0][m][0]), "+v"(acc[ai][0][m][1]), "+v"(acc[ai][1][m][0]), "+v"(acc[ai][1][m][1]) :: "memory");
            ga[0] = na[0]; ga[1] = na[1]; gb[0] = nb[0]; gb[1] = nb[1]; }
    }
    __device__ __forceinline__ void operator()(const f32x4 (&acc)[2][2][4][2], const Unit& u, int, int, int, int) const {
        EPI_GEOM
        const int row0 = u.pm * BM + wr * 64 + fr, col0 = u.pn * BM + wc * 32 + 8 * fq;
        u32x4 gb[2], nb[2];
        { const bf16_t* gp = GT + (size_t)row0 * 2048 + 1024 + col0; gb[0] = *(const u32x4*)gp; gb[1] = *(const u32x4*)(gp + HALF); }
#pragma unroll
        for (int g = 0; g < 8; ++g) { const int ai = g >> 2, m = g & 3; const int row = row0 + ai * HALF + m * 16;
            if (g < 7) { const bf16_t* gp = GT + (size_t)(row0 + ((g + 1) >> 2) * HALF + ((g + 1) & 3) * 16) * 2048 + 1024 + col0; nb[0] = *(const u32x4*)gp; nb[1] = *(const u32x4*)(gp + HALF); }
#pragma unroll
            for (int bj = 0; bj < 2; ++bj) { f32x4 v0 = acc[ai][bj][m][0], v1 = acc[ai][bj][m][1]; const u32x4 q = gb[bj];
                v0[0] *= fmaxf(bflo(q[0]), 1e-30f); v0[1] *= fmaxf(bfhi(q[0]), 1e-30f); v0[2] *= fmaxf(bflo(q[1]), 1e-30f); v0[3] *= fmaxf(bfhi(q[1]), 1e-30f);
                v1[0] *= fmaxf(bflo(q[2]), 1e-30f); v1[1] *= fmaxf(bfhi(q[2]), 1e-30f); v1[2] *= fmaxf(bflo(q[3]), 1e-30f); v1[3] *= fmaxf(bfhi(q[3]), 1e-30f);
                *(u32x4*)(O + (size_t)row * D + col0 + bj * HALF) = pack8(v0, v1); }
            gb[0] = nb[0]; gb[1] = nb[1]; }
    }
};
template <bool BASE16, bool SCALE> struct EpiRes {
    static constexpr bool PERM = false, AFTER_DRAIN = false, MIDK = false;
    const void* base; bf16_t* XB; float* ss; const float* ss_in;
    __device__ __forceinline__ void operator()(const f32x4 (&acc)[2][2][4][2], const Unit& u, int, int, int, int) const {
        EPI_GEOM
        const int row0 = u.pm * BM + wr * 64 + fr, col0 = u.pn * BM + wc * 32 + 4 * fq;
        f32x4 cur[2][2], nxt[2][2];
        auto ld = [&](int g, f32x4 (&d)[2][2]) { const size_t o = (size_t)(row0 + (g >> 2) * HALF + (g & 3) * 16) * D + col0;
#pragma unroll
            for (int bj = 0; bj < 2; ++bj)
#pragma unroll
                for (int n = 0; n < 2; ++n) {
                    if constexpr (BASE16) { const v2u w = *(const v2u*)((const bf16_t*)base + o + bj * HALF + n * 16); d[bj][n] = (f32x4){bflo(w.x), bfhi(w.x), bflo(w.y), bfhi(w.y)}; }
                    else d[bj][n] = *(const f32x4*)((const float*)base + o + bj * HALF + n * 16); } };
        float r2[8];
        if constexpr (SCALE) {
#pragma unroll
            for (int g = 0; g < 8; ++g) r2[g] = ss_in[row0 + (g >> 2) * HALF + (g & 3) * 16];
        }
        ld(0, cur);
#pragma unroll
        for (int g = 0; g < 8; ++g) { const int ai = g >> 2, m = g & 3; const int row = row0 + ai * HALF + m * 16;
            if (g < 7) ld(g + 1, nxt);
            float sc = 1.f; if constexpr (SCALE) sc = __builtin_amdgcn_rcpf(r2[g] * (1.0f / D) + EPS);
            float s = 0.f;
#pragma unroll
            for (int bj = 0; bj < 2; ++bj)
#pragma unroll
                for (int n = 0; n < 2; ++n) { const int col = col0 + bj * HALF + n * 16; const f32x4 v = acc[ai][bj][m][n] * sc + cur[bj][n];
                    s += (v[0] * v[0] + v[1] * v[1]) + (v[2] * v[2] + v[3] * v[3]);
                    v2u w; w.x = cvt_pk_bf16(v[0], v[1]); w.y = cvt_pk_bf16(v[2], v[3]); *(v2u*)(XB + (size_t)row * D + col) = w; }
            s += __shfl_xor(s, 16); s += __shfl_xor(s, 32);
            if (fq == 0) atomicAdd(ss + row, s);
#pragma unroll
            for (int bj = 0; bj < 2; ++bj)
#pragma unroll
                for (int n = 0; n < 2; ++n) cur[bj][n] = nxt[bj][n]; }
    }
};
struct EpiFinal {
    static constexpr bool PERM = false, AFTER_DRAIN = false, MIDK = false;
    const bf16_t* X2B; const bf16_t* PL; const float* ss; float* out;
    __device__ __forceinline__ void operator()(const f32x4 (&acc)[2][2][4][2], const Unit& u, int, int, int, int) const {
        EPI_GEOM
        const int row0 = u.pm * BM + wr * 64 + fr, col0 = u.pn * BM + wc * 32 + 4 * fq;
        float rsv[8];
#pragma unroll
        for (int g = 0; g < 8; ++g) rsv[g] = ss[row0 + (g >> 2) * HALF + (g & 3) * 16];
        v2u cx[2][2], nx[2][2], cp[2][2], np[2][2];
        { const size_t o = (size_t)row0 * D + col0;
#pragma unroll
          for (int bj = 0; bj < 2; ++bj)
#pragma unroll
            for (int n = 0; n < 2; ++n) { cx[bj][n] = *(const v2u*)(X2B + o + bj * HALF + n * 16); cp[bj][n] = *(const v2u*)(PL + o + bj * HALF + n * 16); } }
#pragma unroll
        for (int g = 0; g < 8; ++g) { const int ai = g >> 2, m = g & 3; const int row = row0 + ai * HALF + m * 16;
            if (g < 7) { const size_t o = (size_t)(row0 + ((g + 1) >> 2) * HALF + ((g + 1) & 3) * 16) * D + col0;
#pragma unroll
                for (int bj = 0; bj < 2; ++bj)
#pragma unroll
                    for (int n = 0; n < 2; ++n) { nx[bj][n] = *(const v2u*)(X2B + o + bj * HALF + n * 16); np[bj][n] = *(const v2u*)(PL + o + bj * HALF + n * 16); } }
            const float rs = __builtin_amdgcn_rsqf(rsv[g] * (1.0f / D) + EPS);
#pragma unroll
            for (int bj = 0; bj < 2; ++bj)
#pragma unroll
                for (int n = 0; n < 2; ++n) { const int col = col0 + bj * HALF + n * 16; const f32x4 a = acc[ai][bj][m][n]; const v2u x = cx[bj][n]; const v2u p = cp[bj][n]; f32x4 y;
                    y[0] = bflo(x.x) + bflo(p.x) * __builtin_amdgcn_rcpf(1.0f + __expf(-a[0] * rs)); y[1] = bfhi(x.x) + bfhi(p.x) * __builtin_amdgcn_rcpf(1.0f + __expf(-a[1] * rs));
                    y[2] = bflo(x.y) + bflo(p.y) * __builtin_amdgcn_rcpf(1.0f + __expf(-a[2] * rs)); y[3] = bfhi(x.y) + bfhi(p.y) * __builtin_amdgcn_rcpf(1.0f + __expf(-a[3] * rs));
                    *(f32x4*)(out + (size_t)row * D + col) = y; }
#pragma unroll
            for (int bj = 0; bj < 2; ++bj)
#pragma unroll
                for (int n = 0; n < 2; ++n) { cx[bj][n] = nx[bj][n]; cp[bj][n] = np[bj][n]; } }
    }
};
template <class Epi, class Sched, bool ALIGN_EPI = false, bool SP2 = false>
__device__ __forceinline__ void gemm_phase(PG8_LAS unsigned char* lds, const Gemm g, const Sched& S, const Epi& E) {
    int tid_ = threadIdx.x; asm volatile("" : "+v"(tid_));
    const int tid = tid_, wid = __builtin_amdgcn_readfirstlane(tid >> 6), lane = tid & 63, wr = wid >> 2, wc = wid & 3, fr = lane & 15, fq = lane >> 4;
    const int K = g.K, nt = K / BK;
    unsigned voffA[2], voffB[2];
#pragma unroll
    for (int i = 0; i < 2; ++i) { int R, C; stage_rc(tid * 16 + i * 8192, R, C); const int Rb = Epi::PERM ? ((R & ~31) + perm32(R & 31)) : R;
        voffA[i] = (unsigned)(R * K + C) * 2u; voffB[i] = (unsigned)(Rb * K + C) * 2u; }
    const size_t kstep = (size_t)(BK * 2);
    const size_t hstep = (size_t)HALF * K * 2;
    const size_t tstep = 2 * hstep;
    const unsigned ldsw = (unsigned)wid * 1024u;
    const int aoff = lds_byte(wr * 64 + fr, fq * 8), boff = lds_byte(wc * 32 + fr, fq * 8);
#define PG8_SA(b, h) (((b) * 2 + (h)) * HTB)
#define PG8_SB(b, h) ((4 + (b) * 2 + (h)) * HTB)
#define PG8_STAGE(bufoff, gbase, voff) do { _Pragma("unroll") for (int _i = 0; _i < 2; ++_i) \
        __builtin_amdgcn_global_load_lds((const unsigned*)((const char*)(gbase) + (voff)[_i]), (PG8_LAS unsigned*)(lds + (bufoff) + ldsw + _i * 8192), 16, 0, 0); } while (0)
#define PG8_LDA(dst, b, h) do { _Pragma("unroll") for (int m = 0; m < 4; ++m) _Pragma("unroll") for (int k = 0; k < 2; ++k) dst[m][k] = *(const PG8_LAS bf16x8*)(lds + PG8_SA(b, h) + aoff + m * 2048 + k * 1024); } while (0)
#define PG8_LDB(dst, b, h) do { _Pragma("unroll") for (int n = 0; n < 2; ++n) _Pragma("unroll") for (int k = 0; k < 2; ++k) dst[n][k] = *(const PG8_LAS bf16x8*)(lds + PG8_SB(b, h) + boff + n * 2048 + k * 1024); } while (0)
#define PG8_MMA(ai, bj, At, Bt) do { __builtin_amdgcn_s_setprio(1); _Pragma("unroll") for (int m = 0; m < 4; ++m) _Pragma("unroll") for (int n = 0; n < 2; ++n) _Pragma("unroll") for (int k = 0; k < 2; ++k) \
        acc[ai][bj][m][n] = __builtin_amdgcn_mfma_f32_16x16x32_bf16(Bt[n][k], At[m][k], acc[ai][bj][m][n], 0, 0, 0); __builtin_amdgcn_s_setprio(0); } while (0)
#define PG8_WAIT_V(n) asm volatile("s_waitcnt vmcnt(" #n ")" ::: "memory")
#define PG8_WAIT_L(n) asm volatile("s_waitcnt lgkmcnt(" #n ")" ::: "memory")
#define PG8_BAR __builtin_amdgcn_s_barrier()
#define PG8_SCHED __builtin_amdgcn_sched_barrier(0)
    Unit cur, nxt; int ui = 0;
    if (!S.next(0, cur)) return;
    f32x4 acc[2][2][4][2];
#pragma unroll
    for (int a = 0; a < 2; ++a)
#pragma unroll
        for (int b = 0; b < 2; ++b)
#pragma unroll
            for (int m = 0; m < 4; ++m)
#pragma unroll
                for (int n = 0; n < 2; ++n) acc[a][b][m][n] = (f32x4){0.f, 0.f, 0.f, 0.f};
    bf16x8 At[4][2], B0[2][2], B1[2][2];
    const char* cA = (const char*)g.A + (size_t)cur.pm * tstep; const char* cB = (const char*)g.Bt + (size_t)cur.pn * tstep;
    S.a_ready(cur);
    if constexpr (SP2) {
        PG8_STAGE(PG8_SB(0, 0), cB, voffB); PG8_STAGE(PG8_SB(0, 1), cB + hstep, voffB); PG8_STAGE(PG8_SA(0, 0), cA, voffA); PG8_STAGE(PG8_SA(0, 1), cA + hstep, voffA);
        if (wr == 1) PG8_BAR;
        PG8_WAIT_V(2); PG8_BAR;
        PG8_STAGE(PG8_SB(1, 0), cB + kstep, voffB); PG8_STAGE(PG8_SA(1, 0), cA + kstep, voffA); PG8_STAGE(PG8_SB(1, 1), cB + hstep + kstep, voffB);
        PG8_WAIT_V(6); PG8_BAR;
    } else {
        PG8_STAGE(PG8_SB(0, 0), cB, voffB); PG8_STAGE(PG8_SA(0, 0), cA, voffA); PG8_STAGE(PG8_SB(0, 1), cB + hstep, voffB); PG8_STAGE(PG8_SA(0, 1), cA + hstep, voffA);
        if (wr == 1) PG8_BAR;
        PG8_WAIT_V(4); PG8_BAR;
        PG8_STAGE(PG8_SB(1, 0), cB + kstep, voffB); PG8_STAGE(PG8_SA(1, 0), cA + kstep, voffA); PG8_STAGE(PG8_SB(1, 1), cB + hstep + kstep, voffB);
        PG8_WAIT_V(6); PG8_BAR;
    }
    for (;;) {
        S.prefetch(ui + 1);
        bool has_next = false; const char* nA = cA; const char* nB = cB;
#pragma unroll 1
        for (int t = 0; t < nt; t += 2) {
            if (t == ((nt >= 8) ? 4 : 0)) S.commit(ui + 1);
            if constexpr (Epi::MIDK) { if (t == (nt >> 1)) E.mid(acc, cur, wr, wc, fr, fq); }
            const bool last = (t == nt - 2);
            if (last) { has_next = S.next(ui + 1, nxt); if (has_next) { nA = (const char*)g.A + (size_t)nxt.pm * tstep; nB = (const char*)g.Bt + (size_t)nxt.pn * tstep; } }
            const char* a1 = cA + (size_t)(t + 1) * kstep;
            const char* a2 = last ? nA : cA + (size_t)(t + 2) * kstep; const char* b2 = last ? nB : cB + (size_t)(t + 2) * kstep;
            const char* a3 = a2 + kstep; const char* b3 = b2 + kstep;
            if (last && has_next) S.a_ready(nxt);
            if constexpr (SP2) {
            PG8_LDB(B0, 0, 0); PG8_LDB(B1, 0, 1); PG8_SCHED; PG8_LDA(At, 0, 0); PG8_STAGE(PG8_SA(1, 1), a1 + hstep, voffA);
            PG8_WAIT_V(8); PG8_WAIT_L(0); PG8_BAR; PG8_MMA(0, 0, At, B0); PG8_MMA(0, 1, At, B1); PG8_BAR; PG8_SCHED;
            PG8_LDA(At, 0, 1); PG8_STAGE(PG8_SB(0, 0), b2, voffB); PG8_STAGE(PG8_SB(0, 1), b2 + hstep, voffB); PG8_STAGE(PG8_SA(0, 0), a2, voffA);
            PG8_WAIT_V(8); PG8_WAIT_L(0); PG8_BAR; PG8_MMA(1, 0, At, B0); PG8_MMA(1, 1, At, B1); PG8_BAR; PG8_SCHED;
            PG8_LDB(B0, 1, 0); PG8_LDB(B1, 1, 1); PG8_SCHED; PG8_LDA(At, 1, 0); PG8_STAGE(PG8_SA(0, 1), a2 + hstep, voffA);
            PG8_WAIT_V(8); PG8_WAIT_L(0); PG8_BAR; PG8_MMA(0, 0, At, B0); PG8_MMA(0, 1, At, B1); PG8_BAR; PG8_SCHED;
            PG8_LDA(At, 1, 1); PG8_STAGE(PG8_SB(1, 0), b3, voffB); PG8_STAGE(PG8_SB(1, 1), b3 + hstep, voffB); PG8_STAGE(PG8_SA(1, 0), a3, voffA);
            PG8_WAIT_V(8); PG8_WAIT_L(0); PG8_BAR; PG8_MMA(1, 0, At, B0); PG8_MMA(1, 1, At, B1); PG8_BAR; PG8_SCHED;
            } else {
            PG8_LDB(B0, 0, 0); PG8_SCHED; PG8_LDA(At, 0, 0); PG8_STAGE(PG8_SA(1, 1), a1 + hstep, voffA);
            PG8_WAIT_L(8); PG8_BAR; PG8_WAIT_L(0); PG8_MMA(0, 0, At, B0); PG8_BAR; PG8_SCHED;
            PG8_LDB(B1, 0, 1); PG8_STAGE(PG8_SB(0, 0), b2, voffB);
            PG8_BAR; PG8_WAIT_L(0); PG8_MMA(0, 1, At, B1); PG8_BAR;
            PG8_LDA(At, 0, 1); PG8_STAGE(PG8_SA(0, 0), a2, voffA);
            PG8_BAR; PG8_WAIT_L(0); PG8_MMA(1, 0, At, B0); PG8_BAR; PG8_SCHED;
            PG8_STAGE(PG8_SB(0, 1), b2 + hstep, voffB);
            PG8_WAIT_V(6); PG8_BAR; PG8_MMA(1, 1, At, B1); PG8_BAR;
            PG8_LDB(B0, 1, 0); PG8_SCHED; PG8_LDA(At, 1, 0); PG8_STAGE(PG8_SA(0, 1), a2 + hstep, voffA);
            PG8_WAIT_L(8); PG8_BAR; PG8_WAIT_L(0); PG8_MMA(0, 0, At, B0); PG8_BAR; PG8_SCHED;
            PG8_LDB(B1, 1, 1); PG8_STAGE(PG8_SB(1, 0), b3, voffB);
            PG8_BAR; PG8_WAIT_L(0); PG8_MMA(0, 1, At, B1); PG8_BAR;
            PG8_LDA(At, 1, 1); PG8_STAGE(PG8_SA(1, 0), a3, voffA);
            PG8_BAR; PG8_WAIT_L(0); PG8_MMA(1, 0, At, B0); PG8_BAR; PG8_SCHED;
            PG8_STAGE(PG8_SB(1, 1), b3 + hstep, voffB);
            PG8_WAIT_V(6); PG8_BAR; PG8_MMA(1, 1, At, B1); PG8_BAR;
            }
        }
        if constexpr (ALIGN_EPI) { if (wr == 0) PG8_BAR; }
        if constexpr (!Epi::AFTER_DRAIN) { E(acc, cur, wr, wc, fr, fq); S.done(cur); }
        if (!has_next) break;
#pragma unroll
        for (int a = 0; a < 2; ++a)
#pragma unroll
            for (int b = 0; b < 2; ++b)
#pragma unroll
                for (int m = 0; m < 4; ++m)
#pragma unroll
                    for (int n = 0; n < 2; ++n) acc[a][b][m][n] = (f32x4){0.f, 0.f, 0.f, 0.f};
        cur = nxt; cA = nA; cB = nB; ++ui;
        if constexpr (ALIGN_EPI) { if (wr == 1) PG8_BAR; }
    }
    PG8_WAIT_V(0);
    if constexpr (!ALIGN_EPI) { if (wr == 0) PG8_BAR; }
    PG8_BAR;
    if constexpr (Epi::AFTER_DRAIN) { E.fused(acc, cur, wr, wc, fr, fq, lds, wid, lane); S.done(cur); }
#undef PG8_SA
#undef PG8_SB
#undef PG8_STAGE
#undef PG8_LDA
#undef PG8_LDB
#undef PG8_MMA
#undef PG8_WAIT_V
#undef PG8_WAIT_L
#undef PG8_BAR
#undef PG8_SCHED
}
}
#define XB_TMO      128
#define XB_XCNT(j)  (256  + 64 * (j))
#define XB_XSUB(j)  (1280 + 64 * (j))
#define XB_XGEN(j)  (2304 + 64 * (j))
#define XB_TOP      3328
#define XB_TOPGEN   3392
#define XCD_BAR_WORDS 3456
#define XB_SPIN_CAP (1u << 18)

__device__ __forceinline__ unsigned xb_ld(unsigned* p)              { return __hip_atomic_load(p, __ATOMIC_RELAXED, __HIP_MEMORY_SCOPE_AGENT); }
__device__ __forceinline__ unsigned xb_add(unsigned* p, unsigned v) { return __hip_atomic_fetch_add(p, v, __ATOMIC_RELAXED, __HIP_MEMORY_SCOPE_AGENT); }
__device__ __forceinline__ unsigned xb_xcc_id() { return (unsigned)__builtin_amdgcn_s_getreg((3 << 11) | 20) & 0xFu; }
#define XB_SPIN(cond, bar) do { unsigned _sp = 0; while (cond) { __builtin_amdgcn_s_sleep(1); \
    if ((++_sp & 255u) == 0u) { if (xb_ld(&(bar)[XB_TMO])) break; if (_sp > XB_SPIN_CAP) { atomicAdd(&(bar)[XB_TMO], 1u); break; } } } } while (0)

struct XcdBarrier {
    unsigned* bar; unsigned x;
    volatile LAS unsigned* st;
};

__device__ __forceinline__ XcdBarrier xcd_barrier_post(unsigned* bar, volatile LAS unsigned* st) {
    XcdBarrier b; b.bar = bar; b.x = xb_xcc_id(); b.st = st;
    if (threadIdx.x == 0) (void)xb_add(&bar[XB_XCNT(b.x)], 1u);
    return b;
}
__device__ __forceinline__ void xcd_barrier_complete(unsigned* bar, unsigned x, unsigned& nloc, unsigned& nx) {
    const unsigned G = gridDim.x * gridDim.y * gridDim.z;
    unsigned sum, cnt, mine, sp = 0u;
    for (;;) {
        sum = 0u; cnt = 0u; mine = 0u;
#pragma unroll
        for (unsigned j = 0; j < 16; ++j) { const unsigned c = xb_ld(&bar[XB_XCNT(j)]); sum += c; cnt += (c > 0u) ? 1u : 0u; mine = (j == x) ? c : mine; }
        if (sum == G) break;
        __builtin_amdgcn_s_sleep(1);
        if ((++sp & 255u) == 0u) { if (xb_ld(&bar[XB_TMO])) break; if (sp > XB_SPIN_CAP) { atomicAdd(&bar[XB_TMO], 1u); break; } }
    }
    nloc = mine > 0u ? mine : 1u; nx = cnt > 0u ? cnt : 1u;
}

__device__ __forceinline__ void xcd_barrier(const XcdBarrier& b) {
    asm volatile("s_waitcnt vmcnt(0)" ::: "memory");
    __syncthreads();
    if (threadIdx.x == 0) {
        unsigned* bar = b.bar;
        __builtin_amdgcn_s_waitcnt(0);
        unsigned nloc = b.st[0], nx = b.st[1];
        if (nloc == 0u) { xcd_barrier_complete(bar, b.x, nloc, nx); b.st[0] = nloc; b.st[1] = nx; }
        const unsigned old = xb_add(&bar[XB_XSUB(b.x)], 1u);
        const unsigned gen = old / nloc;
        if (old + 1u == (gen + 1u) * nloc) {
            __builtin_amdgcn_fence(__ATOMIC_RELEASE, "agent");
            asm volatile("s_waitcnt vmcnt(0)" ::: "memory");
            const unsigned og = xb_add(&bar[XB_TOP], 1u);
            const unsigned tg = og / nx;
            if (og + 1u == (tg + 1u) * nx) xb_add(&bar[XB_TOPGEN], 1u);
            else XB_SPIN(xb_ld(&bar[XB_TOPGEN]) == tg, bar);
            __builtin_amdgcn_fence(__ATOMIC_ACQUIRE, "agent");
            xb_add(&bar[XB_XGEN(b.x)], 1u);
            asm volatile("s_waitcnt vmcnt(0)" ::: "memory");
        } else {
            XB_SPIN(xb_ld(&bar[XB_XGEN(b.x)]) == gen, bar);
            __builtin_amdgcn_fence(__ATOMIC_ACQUIRE, "agent");
            asm volatile("s_waitcnt vmcnt(0)" ::: "memory");
        }
    }
    __syncthreads();
}
struct Frame {
    LAS unsigned char* lds;
    volatile LAS unsigned* MISC;
    gu32* ctl;
    int tid, lane, wave;
    int vcu, G;
    unsigned char* ws; float* out;
    const float* in[28]; const int* page_table;
};
struct Args { const void* in[28]; float* out; unsigned char* ws; int ph_lo, ph_hi, li, pad; };

__device__ __forceinline__ int in_srccol(int n0) {
    if (n0 < 1024) { const int t = n0 >> 8, w = n0 & 255, bj = w >> 7, wc = (w & 127) >> 5; return 256 * t + 64 * wc + 32 * bj; }
    if (n0 < 1536) return n0;
    if (n0 < 3072) return n0 + 8;
    return n0 + 16;
}
__device__ __forceinline__ void p0_transpose_item(const float* W, int ldw, bf16* WT, int ldk, int koff, int k0, int n0dst, int n0src, const float* gain, LAS float* scr, int lane) {
    { float v[32];
#pragma unroll
      for (int i = 0; i < 32; ++i) v[i] = W[(size_t)(k0 + 2 * i + (lane >> 5)) * ldw + n0src + (lane & 31)];
      if (gain) {
#pragma unroll
          for (int i = 0; i < 32; ++i) v[i] *= gain[k0 + 2 * i + (lane >> 5)]; }
#pragma unroll
      for (int i = 0; i < 32; ++i) scr[(2 * i + (lane >> 5)) * 33 + (lane & 31)] = v[i]; }
    LDS_WAIT(); asm volatile("" ::: "memory");
    const int c = lane & 7;
#pragma unroll
    for (int j = 0; j < 4; ++j) { const int n = (lane >> 3) + 8 * j; const LAS float* s = scr + (8 * c) * 33 + n;
        v4u o; o.x = pk2(s[0 * 33], s[1 * 33]); o.y = pk2(s[2 * 33], s[3 * 33]); o.z = pk2(s[4 * 33], s[5 * 33]); o.w = pk2(s[6 * 33], s[7 * 33]);
        *(GAS v4u*)(WT + (size_t)(n0dst + n) * ldk + koff + k0 + 8 * c) = o; }
    LDS_WAIT(); asm volatile("" ::: "memory");
}
__device__ __forceinline__ void p0_prologue(Frame& F) {
    LAS float* scr = (LAS float*)(F.lds + RING_OFF + F.wave * 16384);
    const int gw = F.vcu * NWAVES + F.wave, NGW = F.G * NWAVES;
    bf16* WIN = (bf16*)(F.ws + WS_WIN); bf16* WAB = (bf16*)(F.ws + WS_WAB); bf16* WOUT = (bf16*)(F.ws + WS_WOUT); bf16* WUP = (bf16*)(F.ws + WS_WUP);
    bf16* WDN = (bf16*)(F.ws + WS_WDN); bf16* WGT = (bf16*)(F.ws + WS_WGT); bf16* WPL = (bf16*)(F.ws + WS_WPL);
    constexpr int I_IN = 16 * 176, I_A = 8 * 32, I_B = 8 * 32, I_O = 16 * 32, I_UP = 16 * 128, I_DN = 64 * 32, I_G = 16 * 32, I_P = 4 * 32;
    constexpr int NITEMS = I_IN + I_A + I_B + I_O + I_UP + I_DN + I_G + I_P;
    for (int it = gw; it < NITEMS; it += NGW) {
        int r = it;
        if (r < I_IN) { const int kb = r / 176, nb = r % 176; p0_transpose_item(F.in[11], DIN, WIN, D, 0, 64 * kb, 32 * nb, in_srccol(32 * nb), nullptr, scr, F.lane); continue; } r -= I_IN;
        if (r < I_A) { const int kb = r / 32, nb = r % 32; p0_transpose_item(F.in[19], D, WAB, D, 0, 64 * kb, 32 * nb, 32 * nb, nullptr, scr, F.lane); continue; } r -= I_A;
        if (r < I_B) { const int kb = r / 32, nb = r % 32; p0_transpose_item(F.in[20], D, WAB, D, 512, 64 * kb, 32 * nb, 32 * nb, nullptr, scr, F.lane); continue; } r -= I_B;
        if (r < I_O) { const int kb = r / 32, nb = r % 32; p0_transpose_item(F.in[21], D, WOUT, D, 0, 64 * kb, 32 * nb, 32 * nb, nullptr, scr, F.lane); continue; } r -= I_O;
        if (r < I_UP) { const int kb = r / 128, nb = r % 128; p0_transpose_item(F.in[23], DFF, WUP, D, 0, 64 * kb, 32 * nb, 32 * nb, F.in[22], scr, F.lane); continue; } r -= I_UP;
        if (r < I_DN) { const int kb = r / 32, nb = r % 32; p0_transpose_item(F.in[24], D, WDN, DFF, 0, 64 * kb, 32 * nb, 32 * nb, nullptr, scr, F.lane); continue; } r -= I_DN;
        if (r < I_G) { const int kb = r / 32, nb = r % 32; p0_transpose_item(F.in[26], D, WGT, D, 0, 64 * kb, 32 * nb, 32 * nb, F.in[25], scr, F.lane); continue; } r -= I_G;
        { const int kb = r / 32, nb = r % 32; p0_transpose_item(F.in[27], D, WPL, PLE, 0, 64 * kb, 32 * nb, 32 * nb, nullptr, scr, F.lane); }
    }
    { const int gt = F.vcu * (NWAVES * 64) + F.tid;
      if (gt < 16 * D) { const int r = gt / D, k = gt % D; const int col = r < 8 ? 1536 + r : (r < 12 ? 3080 + (r - 8) : 3084 + (r - 12));
          WIN[(size_t)(5632 + r) * D + k] = (bf16)f2bf(F.in[11][(size_t)k * DIN + col]); } }
    { bf16* XN = (bf16*)(F.ws + WS_XN); const GAS f32x4* gr = (const GAS f32x4*)F.in[10] + F.lane; f32x4 g[4];
#pragma unroll
      for (int j = 0; j < 4; ++j) g[j] = gr[64 * j];
      for (int m0 = gw; m0 < MT; m0 += 2 * NGW) {
          const int m1 = m0 + NGW; const bool two = m1 < MT;
          const float* x0 = m0 < MP ? F.in[0] + (size_t)m0 * D : F.in[1] + (size_t)(m0 - MP) * D;
          const float* x1 = !two ? x0 : (m1 < MP ? F.in[0] + (size_t)m1 * D : F.in[1] + (size_t)(m1 - MP) * D);
          const GAS f32x4* r0 = (const GAS f32x4*)x0 + F.lane; const GAS f32x4* r1 = (const GAS f32x4*)x1 + F.lane; f32x4 v0[4], v1[4]; float s0 = 0.f, s1 = 0.f;
#pragma unroll
          for (int j = 0; j < 4; ++j) { v0[j] = r0[64 * j]; v1[j] = r1[64 * j]; }
#pragma unroll
          for (int j = 0; j < 4; ++j) { s0 += (v0[j].x * v0[j].x + v0[j].y * v0[j].y) + (v0[j].z * v0[j].z + v0[j].w * v0[j].w); s1 += (v1[j].x * v1[j].x + v1[j].y * v1[j].y) + (v1[j].z * v1[j].z + v1[j].w * v1[j].w); }
          const float rs0 = __builtin_amdgcn_rsqf(wave_sum(s0) * (1.f / D) + EPS), rs1 = __builtin_amdgcn_rsqf(wave_sum(s1) * (1.f / D) + EPS);
          GAS unsigned long long* o0 = (GAS unsigned long long*)(XN + (size_t)m0 * D) + F.lane;
#pragma unroll
          for (int j = 0; j < 4; ++j) { const f32x4 y = v0[j] * rs0 * g[j]; o0[64 * j] = (unsigned long long)pk2(y.x, y.y) | ((unsigned long long)pk2(y.z, y.w) << 32); }
          if (two) { GAS unsigned long long* o1 = (GAS unsigned long long*)(XN + (size_t)m1 * D) + F.lane;
#pragma unroll
              for (int j = 0; j < 4; ++j) { const f32x4 y = v1[j] * rs1 * g[j]; o1[64 * j] = (unsigned long long)pk2(y.x, y.y) | ((unsigned long long)pk2(y.z, y.w) << 32); } }
      } }
    { bf16* PLB = (bf16*)(F.ws + WS_PLB);
      for (int m0 = gw; m0 < MT; m0 += 4 * NGW) { f32x4 v[4];
#pragma unroll
          for (int k = 0; k < 4; ++k) { const int m = m0 + k * NGW; if (m < MT) { const float* pr = m < MP ? F.in[2] + (size_t)m * PLE : F.in[3] + (size_t)(m - MP) * PLE; v[k] = *((const GAS f32x4*)pr + F.lane); } }
#pragma unroll
          for (int k = 0; k < 4; ++k) { const int m = m0 + k * NGW; if (m < MT) *((GAS unsigned long long*)(PLB + (size_t)m * PLE) + F.lane) = (unsigned long long)pk2(v[k].x, v[k].y) | ((unsigned long long)pk2(v[k].z, v[k].w) << 32); } } }
    { float* PT = (float*)(F.ws + WS_SFX);
      for (int u = gw; u < DB * NPAGES; u += NGW) { const int page = F.page_table[u]; const f32x4* src = (const f32x4*)(F.in[6] + (size_t)page * PAGE * FH) + F.lane * 4;
          const f32x4 a = src[0], b2 = src[1], c = src[2], d = src[3];
          f32x4 lo = a + c, hi = b2 + d;
#pragma unroll
          for (int o = 1; o < 64; o <<= 1) {
#pragma unroll
              for (int i = 0; i < 4; ++i) { lo[i] += __shfl_xor(lo[i], o); hi[i] += __shfl_xor(hi[i], o); } }
          if (F.lane == 0) { *(f32x4*)(PT + (size_t)u * FH) = lo; *(f32x4*)(PT + (size_t)u * FH + 4) = hi; } } }
}

constexpr float DC_T2 = 48.f;
constexpr int DP_STRIDE = 68;
#define DPPF(v, ctrl) __builtin_bit_cast(float, __builtin_amdgcn_update_dpp(0, __builtin_bit_cast(int, (v)), (ctrl), 0xf, 0xf, true))
__device__ __forceinline__ float red16(float v) { v += DPPF(v, 0xB1); v += DPPF(v, 0x4E); v += DPPF(v, 0x141); v += DPPF(v, 0x140); return v; }
__device__ __forceinline__ int wave_fetch(Frame& F, int qi, int lane) { unsigned v = 0; if (lane == 0) v = __hip_atomic_fetch_add((unsigned*)(F.ctl + CW_Q + 64 * qi), 1u, __ATOMIC_RELAXED, __HIP_MEMORY_SCOPE_AGENT); return (int)__builtin_amdgcn_readfirstlane(v); }
constexpr int DEC_XL_OFF = 110592, DEC_XL_WAVE = 640;
template <bool PF>
__device__ __forceinline__ void decode_unit(Frame& F, int unit, int h) {
    int tid_o = threadIdx.x; asm volatile("" : "+v"(tid_o));
    const int s = unit >> 6, pg = unit & 63, wv = __builtin_amdgcn_readfirstlane(tid_o >> 6), lane = tid_o & 63, dc = lane & 15, sub = lane >> 4;
    const bf16* QB = (const bf16*)(F.ws + WS_QB); const bf16* KB = (const bf16*)(F.ws + WS_KB); const float* LGF = (const float*)(F.ws + WS_LGF);
    const float* PT = (const float*)(F.ws + WS_SFX);
    const int page = F.page_table[s * NPAGES + pg];
    const float* kp = F.in[4] + (size_t)page * PAGE * FW + h * 64 + dc * 4; const float* vp = F.in[5] + (size_t)page * PAGE * FW + h * 64 + dc * 4;
    v2u qw[4], kw[4]; float lg[4];
#pragma unroll
    for (int j = 0; j < 4; ++j) { const size_t row = MP + s * 4 + j; qw[j] = *(const v2u*)(QB + row * FW + h * 64 + dc * 4); kw[j] = *(const v2u*)(KB + row * FW + h * 64 + dc * 4); lg[j] = LGF[row * 8 + h]; }
    const float pt = (lane > pg) ? PT[((size_t)s * NPAGES + lane) * FH + h] : 0.f;
    const float* lp = F.in[6] + (size_t)page * PAGE * FH + h; const float l0 = lp[(size_t)lane * FH], l1 = lp[(size_t)(64 + lane) * FH];
    f32x4 kx[32];
#pragma unroll
    for (int i = 0; i < 32; ++i) kx[i] = __builtin_nontemporal_load((const f32x4*)(kp + (size_t)(4 * i + sub) * FW));
    float tch[4] = {0.f, 0.f, 0.f, 0.f};
    if (PF) { const int pageN = F.page_table[s * NPAGES + pg + 1]; const float* kn = F.in[4] + (size_t)pageN * PAGE * FW + h * 64 + (lane & 3) * 16;
#pragma unroll
        for (int c = 0; c < 4; ++c) tch[c] = kn[(size_t)(16 * c + (lane >> 2)) * FW]; }
    float q[4][4], xself[4], cnew[4];
    { float run = 0.f;
#pragma unroll
      for (int j = 0; j < 4; ++j) {
          q[j][0] = bflo(qw[j].x); q[j][1] = bfhi(qw[j].x); q[j][2] = bflo(qw[j].y); q[j][3] = bfhi(qw[j].y);
          xself[j] = red16(q[j][0] * bflo(kw[j].x) + q[j][1] * bfhi(kw[j].x) + q[j][2] * bflo(kw[j].y) + q[j][3] * bfhi(kw[j].y));
          run += lg[j]; cnew[j] = run * LOG2E; } }
    LAS float* xl = (LAS float*)(F.lds + DEC_XL_OFF) + wv * DEC_XL_WAVE; LAS float* sfl = xl + 512;
    float pm[4] = {-INFINITY, -INFINITY, -INFINITY, -INFINITY};
    { const float off = wave_sum(pt);
      float s0 = l0, s1 = l1;
#pragma unroll
      for (int o = 1; o < 64; o <<= 1) { const float t0 = __shfl_down(s0, o), t1 = __shfl_down(s1, o); if (lane + o < 64) { s0 += t0; s1 += t1; } }
      const float tot1 = __shfl(s1, 0);
      sfl[64 + lane] = (off + s1 - l1) * LOG2E; sfl[lane] = (off + tot1 + s0 - l0) * LOG2E; }
    LDS_WAIT();
#pragma unroll
    for (int i = 0; i < 32; ++i) { float d[4]; const float sf = sfl[4 * i + sub];
#pragma unroll
        for (int j = 0; j < 4; ++j) { d[j] = red16(q[j][0] * kx[i][0] + q[j][1] * kx[i][1] + q[j][2] * kx[i][2] + q[j][3] * kx[i][3]) + sf + cnew[j]; pm[j] = fmaxf(pm[j], d[j]); }
        if (dc == 0) *(LAS f32x4*)(xl + (4 * i + sub) * 4) = (f32x4){d[0], d[1], d[2], d[3]}; }
    bool need = false;
#pragma unroll
    for (int j = 0; j < 4; ++j) { pm[j] = fmaxf(pm[j], __shfl_xor(pm[j], 16)); pm[j] = fmaxf(pm[j], __shfl_xor(pm[j], 32)); need = need || (pm[j] >= xself[j] - DC_T2); }
    float* dp = (float*)(F.ws + WS_DPART) + ((size_t)((s * FH + h) * NPAGES + pg) * 4) * DP_STRIDE;
    if (PF) asm volatile("" :: "v"(tch[0]), "v"(tch[1]), "v"(tch[2]), "v"(tch[3]));
    if (!need) { if (lane < 4) { dp[lane * DP_STRIDE] = -INFINITY; dp[lane * DP_STRIDE + 1] = 0.f; } return; }
    float o[4][4] = {}, l[4] = {0.f, 0.f, 0.f, 0.f};
    LDS_WAIT();
#pragma unroll 1
    for (int qt = 0; qt < 4; ++qt) {
        f32x4 vx[8];
#pragma unroll
        for (int i = 0; i < 8; ++i) { const int pos = 4 * (8 * qt + i) + sub; vx[i] = __builtin_nontemporal_load((const f32x4*)(vp + (size_t)pos * FW)); }
#pragma unroll
        for (int i = 0; i < 8; ++i) { const f32x4 xv = *(const LAS f32x4*)(xl + (4 * (8 * qt + i) + sub) * 4);
#pragma unroll
            for (int j = 0; j < 4; ++j) { const float p = __builtin_amdgcn_exp2f(xv[j] - pm[j]); l[j] += p;
                o[j][0] += p * vx[i][0]; o[j][1] += p * vx[i][1]; o[j][2] += p * vx[i][2]; o[j][3] += p * vx[i][3]; } }
    }
#pragma unroll
    for (int j = 0; j < 4; ++j) { l[j] += __shfl_xor(l[j], 16); l[j] += __shfl_xor(l[j], 32);
#pragma unroll
        for (int d = 0; d < 4; ++d) { o[j][d] += __shfl_xor(o[j][d], 16); o[j][d] += __shfl_xor(o[j][d], 32); }
        if (sub == 0) *(f32x4*)(dp + j * DP_STRIDE + 4 + dc * 4) = (f32x4){o[j][0], o[j][1], o[j][2], o[j][3]};
        if (lane == 0) { dp[j * DP_STRIDE] = pm[j]; dp[j * DP_STRIDE + 1] = l[j]; } }
}
__device__ __forceinline__ void decode_combine_row(Frame& F, int rowid) {
    const int s = rowid >> 5, h = (rowid >> 2) & 7, j = rowid & 3, lane = F.lane;
    const bf16* QB = (const bf16*)(F.ws + WS_QB); const float* LGF = (const float*)(F.ws + WS_LGF);
    const float* dp = (const float*)(F.ws + WS_DPART) + ((size_t)((s * FH + h) * NPAGES) * 4 + j) * DP_STRIDE;
    const size_t row = MP + s * 4 + j;
    const float qd = bf2f(QB[row * FW + h * 64 + lane]);
    float xn[4], cum[4]; { float run = 0.f;
#pragma unroll
      for (int i = 0; i < 4; ++i) { run += LGF[(MP + s * 4 + i) * 8 + h]; cum[i] = run * LOG2E; } }
    float m = -INFINITY;
#pragma unroll
    for (int i = 0; i < 4; ++i) { const float kd = F.out[OFF_KS + (size_t)(s * 4 + i) * FW + h * 64 + lane]; float d = wave_sum(qd * kd) + cum[j] - cum[i]; xn[i] = (i <= j) ? d : -INFINITY; m = fmaxf(m, xn[i]); }
    const float pmv = dp[(size_t)lane * 4 * DP_STRIDE], plv = dp[(size_t)lane * 4 * DP_STRIDE + 1];
    float mm = (plv > 0.f) ? pmv : -INFINITY;
#pragma unroll
    for (int o = 1; o < 64; o <<= 1) mm = fmaxf(mm, __shfl_xor(mm, o));
    m = fmaxf(m, mm);
    float acc = 0.f, l = 0.f;
#pragma unroll
    for (int i = 0; i < 4; ++i) { const float p = __builtin_amdgcn_exp2f(xn[i] - m); l += p; acc += p * F.out[OFF_VS + (size_t)(s * 4 + i) * FW + h * 64 + lane]; }
    for (int pg = 0; pg < NPAGES; ++pg) { const float pl = __shfl(plv, pg); if (pl > 0.f) { const float f = __builtin_amdgcn_exp2f(__shfl(pmv, pg) - m); l += pl * f; acc += f * dp[(size_t)pg * 4 * DP_STRIDE + 4 + lane]; } }
    ((bf16*)(F.ws + WS_OAB))[row * D + h * 64 + lane] = (bf16)f2bf(acc / l);
}
constexpr size_t GU_WF = 0, GU_QD = 16384, GU_KDT = 32768, GU_QKM = 49152, GU_U = 57344, GU_DEC = 90112, GU_BYTES = 90368;
static_assert(WS_GDN + (size_t)1024 * GU_BYTES <= WS_OG, "gdn ws");
constexpr int G1_QS = 0, G1_KS = 17408, G1_KB = 34816, G1_VB = 55296, G1_A = 75776, G1_T = 93184, G1_QK = 102400, G1_SC = 110592, G1_TF = 111616  , G1_WST = 0  ;
constexpr int G1_PQ = 272, G1_PX = 320, G1_PA = 272, G1_PT = 144;

__device__ __forceinline__ f32x16 mfma32(bf16x8 a, bf16x8 b, f32x16 c) { return __builtin_amdgcn_mfma_f32_32x32x16_bf16(a, b, c, 0, 0, 0); }
__device__ __forceinline__ int crow(int r, int hi) { return (r & 3) + 8 * (r >> 2) + 4 * hi; }
__device__ __forceinline__ s16x4 tr_read(unsigned lds_addr) { s16x4 r; asm volatile("ds_read_b64_tr_b16 %0, %1\n\ts_waitcnt lgkmcnt(0)" : "=&v"(r) : "v"(lds_addr) : "memory"); return r; }

template <int VAR>
__device__ __forceinline__ void gdn_prep_unit(Frame& F, int unit) {
    const int bh = unit >> 7, n = unit & 127, b = bh >> 2, h = bh & 3;
    int tid_o = threadIdx.x; asm volatile("" : "+v"(tid_o));
    const int tid = tid_o, lane = tid & 63, wave = __builtin_amdgcn_readfirstlane(tid >> 6);
    LAS unsigned char* L = F.lds + RING_OFF;
    LAS float* sc = (LAS float*)(L + G1_SC);
    const bf16* GQ = (const bf16*)(F.ws + WS_GQ); const float* GAB = (const float*)(F.ws + WS_GAB);
    const size_t row0 = (size_t)b * SEQ + (size_t)n * 64;
    unsigned char* gu = F.ws + WS_GDN + (size_t)unit * GU_BYTES;
    __syncthreads();
    if (wave == 0) {
        const float g = GAB[(row0 + lane) * 8 + h], be = GAB[(row0 + lane) * 8 + 4 + h];
        float c = g;
#pragma unroll
        for (int o = 1; o < 64; o <<= 1) { const float t = __shfl_up(c, o); if (lane >= o) c += t; }
        const float cl = __shfl(c, 63);
        sc[lane] = c; sc[64 + lane] = be; sc[128 + lane] = __expf(c); sc[192 + lane] = __expf(cl - c);
        if (lane == 0) *(float*)(gu + GU_DEC) = __expf(cl);
    } else if (tid < 64 + 384) {
        const int c = tid - 64, ch = (c >> 7) * 512 + h * 128 + (c & 127); const float* cw = F.in[15];
#pragma unroll
        for (int d = 0; d < 4; ++d) *(LAS float*)(L + G1_TF + (d * 384 + c) * 4) = cw[d * CCH + ch];
    }
    v4u xr[3][4][2];
    { const int i = tid >> 3, sg = tid & 7;
#pragma unroll
      for (int X = 0; X < 3; ++X)
#pragma unroll
        for (int d = 0; d < 4; ++d) { const int tok = n * 64 + i - 3 + d; const int cbase = X * 512 + h * 128 + sg * 16;
            if (tok >= 0) { xr[X][d][0] = *(const v4u*)(GQ + ((size_t)b * SEQ + tok) * CCH + cbase); xr[X][d][1] = *(const v4u*)(GQ + ((size_t)b * SEQ + tok) * CCH + cbase + 8); }
            else { xr[X][d][0] = (v4u){0u, 0u, 0u, 0u}; xr[X][d][1] = (v4u){0u, 0u, 0u, 0u}; } } }
    __syncthreads();
    {
        const int i = tid >> 3, sg = tid & 7;
        const float ecum = sc[128 + i], beta = sc[64 + i];
#pragma unroll
        for (int X = 0; X < 3; ++X) {
            float y[16];
#pragma unroll
            for (int c = 0; c < 16; ++c) y[c] = 0.f;
#pragma unroll
            for (int d = 0; d < 4; ++d) {
                const v4u x0 = xr[X][d][0], x1 = xr[X][d][1]; const LAS float* wl = (const LAS float*)(L + G1_TF) + d * 384 + X * 128 + sg * 16;
                const f32x4 w0 = *(const LAS f32x4*)(wl), w1 = *(const LAS f32x4*)(wl + 4), w2 = *(const LAS f32x4*)(wl + 8), w3 = *(const LAS f32x4*)(wl + 12);
                y[0] += w0[0] * bflo(x0.x); y[1] += w0[1] * bfhi(x0.x); y[2] += w0[2] * bflo(x0.y); y[3] += w0[3] * bfhi(x0.y);
                y[4] += w1[0] * bflo(x0.z); y[5] += w1[1] * bfhi(x0.z); y[6] += w1[2] * bflo(x0.w); y[7] += w1[3] * bfhi(x0.w);
                y[8] += w2[0] * bflo(x1.x); y[9] += w2[1] * bfhi(x1.x); y[10] += w2[2] * bflo(x1.y); y[11] += w2[3] * bfhi(x1.y);
                y[12] += w3[0] * bflo(x1.z); y[13] += w3[1] * bfhi(x1.z); y[14] += w3[2] * bflo(x1.w); y[15] += w3[3] * bfhi(x1.w);
            }
            float ss = 0.f;
#pragma unroll
            for (int c = 0; c < 16; ++c) { y[c] = y[c] * __builtin_amdgcn_rcpf(1.0f + __expf(-y[c])); ss += y[c] * y[c]; }
            if (X < 2) {
                ss += __shfl_xor(ss, 1); ss += __shfl_xor(ss, 2); ss += __shfl_xor(ss, 4);
                float rn = __builtin_amdgcn_rsqf(ss + EPS); if (X == 0) rn *= 0.08838834764831845f;
#pragma unroll
                for (int c = 0; c < 16; ++c) y[c] *= rn;
            }
            if (X == 0) {
                v4u a, c2; a.x = pk2(y[0], y[1]); a.y = pk2(y[2], y[3]); a.z = pk2(y[4], y[5]); a.w = pk2(y[6], y[7]); c2.x = pk2(y[8], y[9]); c2.y = pk2(y[10], y[11]); c2.z = pk2(y[12], y[13]); c2.w = pk2(y[14], y[15]);
                *(LAS v4u*)(L + G1_QS + i * G1_PQ + sg * 32) = a; *(LAS v4u*)(L + G1_QS + i * G1_PQ + sg * 32 + 16) = c2;
                v4u d0, d1; d0.x = pk2(y[0] * ecum, y[1] * ecum); d0.y = pk2(y[2] * ecum, y[3] * ecum); d0.z = pk2(y[4] * ecum, y[5] * ecum); d0.w = pk2(y[6] * ecum, y[7] * ecum);
                d1.x = pk2(y[8] * ecum, y[9] * ecum); d1.y = pk2(y[10] * ecum, y[11] * ecum); d1.z = pk2(y[12] * ecum, y[13] * ecum); d1.w = pk2(y[14] * ecum, y[15] * ecum);
                const int mt = i >> 4, fr = i & 15, s = sg >> 1, fq0 = (sg & 1) * 2;
                *(v4u*)(gu + GU_QD + ((size_t)((mt * 4 + s) * 64 + fq0 * 16 + fr)) * 16) = d0;
                *(v4u*)(gu + GU_QD + ((size_t)((mt * 4 + s) * 64 + (fq0 + 1) * 16 + fr)) * 16) = d1;
            } else if (X == 1) {
                v4u a, c2; a.x = pk2(y[0], y[1]); a.y = pk2(y[2], y[3]); a.z = pk2(y[4], y[5]); a.w = pk2(y[6], y[7]); c2.x = pk2(y[8], y[9]); c2.y = pk2(y[10], y[11]); c2.z = pk2(y[12], y[13]); c2.w = pk2(y[14], y[15]);
                *(LAS v4u*)(L + G1_KS + i * G1_PQ + sg * 32) = a; *(LAS v4u*)(L + G1_KS + i * G1_PQ + sg * 32 + 16) = c2;
                const float f = beta * ecum;
                a.x = pk2(y[0] * f, y[1] * f); a.y = pk2(y[2] * f, y[3] * f); a.z = pk2(y[4] * f, y[5] * f); a.w = pk2(y[6] * f, y[7] * f); c2.x = pk2(y[8] * f, y[9] * f); c2.y = pk2(y[10] * f, y[11] * f); c2.z = pk2(y[12] * f, y[13] * f); c2.w = pk2(y[14] * f, y[15] * f);
                *(LAS v4u*)(L + G1_KB + i * G1_PX + sg * 32) = a; *(LAS v4u*)(L + G1_KB + i * G1_PX + sg * 32 + 16) = c2;
            } else {
                v4u a, c2; a.x = pk2(y[0] * beta, y[1] * beta); a.y = pk2(y[2] * beta, y[3] * beta); a.z = pk2(y[4] * beta, y[5] * beta); a.w = pk2(y[6] * beta, y[7] * beta);
                c2.x = pk2(y[8] * beta, y[9] * beta); c2.y = pk2(y[10] * beta, y[11] * beta); c2.z = pk2(y[12] * beta, y[13] * beta); c2.w = pk2(y[14] * beta, y[15] * beta);
                *(LAS v4u*)(L + G1_VB + i * G1_PX + sg * 32) = a; *(LAS v4u*)(L + G1_VB + i * G1_PX + sg * 32 + 16) = c2;
            }
        }
    }
    __syncthreads();
    if (VAR == 2) return;
    {
        const int which = wave >> 2, ti = (wave >> 1) & 1, tj = wave & 1, r = lane & 31, hh = lane >> 5;
        const LAS unsigned char* Ap = L + (which ? G1_QS : G1_KS) + (32 * ti + r) * G1_PQ + hh * 16;
        const LAS unsigned char* Bp = L + G1_KS + (32 * tj + r) * G1_PQ + hh * 16;
        f32x16 acc = {};
#pragma unroll
        for (int s = 0; s < 8; ++s) acc = mfma32(*(const LAS bf16x8*)(Ap + s * 32), *(const LAS bf16x8*)(Bp + s * 32), acc);
        const int j = 32 * tj + r; const float cj = sc[j];
        if (which == 0) {
#pragma unroll
            for (int reg = 0; reg < 16; ++reg) { const int i = 32 * ti + crow(reg, hh); const float v = (i > j) ? sc[64 + i] * acc[reg] * __expf(sc[i] - cj) : 0.f;
                *(LAS float*)(L + G1_A + i * G1_PA + j * 4) = v; }
        } else {
#pragma unroll
            for (int reg = 0; reg < 16; ++reg) { const int i = 32 * ti + crow(reg, hh); const float v = (i >= j) ? acc[reg] * __expf(sc[i] - cj) : 0.f;
                *(LAS unsigned short*)(L + G1_QK + i * 128 + j * 2) = (unsigned short)f2bf(v); }
        }
    }
    __syncthreads();
    if (wave == 0 && VAR != 1) {
        const int bk = lane >> 4, c = lane & 15; float t[16];
#pragma unroll
        for (int i = 0; i < 16; ++i) {
            float a = (c == i) ? 1.f : 0.f;
#pragma unroll
            for (int j4 = 0; j4 < (i + 3) / 4; ++j4) { const f32x4 av = *(const LAS f32x4*)(L + G1_A + (16 * bk + i) * G1_PA + (16 * bk + 4 * j4) * 4);
#pragma unroll
                for (int q = 0; q < 4; ++q) { const int j = 4 * j4 + q; if (j < i) a -= av[q] * t[j]; } }
            t[i] = a;
            *(LAS float*)(L + G1_TF + (16 * bk + i) * G1_PA + (16 * bk + c) * 4) = a;
        }
    } else if (wave != 0) {
        const int t7 = tid - 64;
        for (int e = t7; e < 6 * 256; e += 448) { const int bq = e >> 8, w = e & 255; const int br = bq < 3 ? 0 : (bq < 5 ? 1 : 2), bc = bq < 3 ? bq + 1 : (bq < 5 ? bq - 1 : 3);
            *(LAS float*)(L + G1_TF + (16 * br + (w >> 4)) * G1_PA + (16 * bc + (w & 15)) * 4) = 0.f; }
        for (int e = t7; e < 512; e += 448) {
            const int i = e >> 3, j0 = (e & 7) * 8; const v4u v = *(const LAS v4u*)(L + G1_QK + i * 128 + j0 * 2);
            const int mt = i >> 4, fr = i & 15, s = j0 >> 5, fq = (j0 & 31) >> 3;
            *(v4u*)(gu + GU_QKM + (size_t)((mt * 2 + s) * 64 + fq * 16 + fr) * 16) = v; }
        for (int e = t7; e < 1024; e += 448) {
            const int dk = e & 127, i0 = (e >> 7) * 8; unsigned short v[8];
#pragma unroll
            for (int q = 0; q < 8; ++q) v[q] = (unsigned short)f2bf(bf2f(*(const LAS unsigned short*)(L + G1_KS + (i0 + q) * G1_PQ + dk * 2)) * sc[192 + i0 + q]);
            v4u o; o.x = v[0] | ((unsigned)v[1] << 16); o.y = v[2] | ((unsigned)v[3] << 16); o.z = v[4] | ((unsigned)v[5] << 16); o.w = v[6] | ((unsigned)v[7] << 16);
            const int mt = dk >> 4, fr = dk & 15, s = i0 >> 5, fq = (i0 & 31) >> 3;
            *(v4u*)(gu + GU_KDT + (size_t)((mt * 2 + s) * 64 + fq * 16 + fr) * 16) = o; }
    }
    __syncthreads();
    if (VAR != 1) {
        const int i16 = lane & 15, kk = lane >> 4;
        if (wave < 2) {
            const int r0 = 32 * wave; f32x4s x = {0.f, 0.f, 0.f, 0.f}, y = {0.f, 0.f, 0.f, 0.f};
#pragma unroll
            for (int s4 = 0; s4 < 4; ++s4) x = __builtin_amdgcn_mfma_f32_16x16x4f32(*(const LAS float*)(L + G1_A + (r0 + 16 + i16) * G1_PA + (r0 + 4 * s4 + kk) * 4),
                                                                                     *(const LAS float*)(L + G1_TF + (r0 + 4 * s4 + kk) * G1_PA + (r0 + i16) * 4), x, 0, 0, 0);
#pragma unroll
            for (int s4 = 0; s4 < 4; ++s4) y = __builtin_amdgcn_mfma_f32_16x16x4f32(*(const LAS float*)(L + G1_TF + (r0 + 16 + i16) * G1_PA + (r0 + 16 + 4 * kk + s4) * 4), x[s4], y, 0, 0, 0);
#pragma unroll
            for (int r = 0; r < 4; ++r) *(LAS float*)(L + G1_TF + (r0 + 16 + 4 * kk + r) * G1_PA + (r0 + i16) * 4) = -y[r];
        }
    }
    __syncthreads();
    if (VAR != 1) {
        const int i16 = lane & 15, kk = lane >> 4;
        if (wave < 4) {
            const int ti = wave >> 1, tj = wave & 1; f32x4s y0 = {0.f, 0.f, 0.f, 0.f}, y1 = {0.f, 0.f, 0.f, 0.f}, z = {0.f, 0.f, 0.f, 0.f};
#pragma unroll
            for (int s8 = 0; s8 < 8; ++s8) { const float bq = *(const LAS float*)(L + G1_TF + (4 * s8 + kk) * G1_PA + (16 * tj + i16) * 4);
                y0 = __builtin_amdgcn_mfma_f32_16x16x4f32(*(const LAS float*)(L + G1_A + (32 + i16) * G1_PA + (4 * s8 + kk) * 4), bq, y0, 0, 0, 0);
                y1 = __builtin_amdgcn_mfma_f32_16x16x4f32(*(const LAS float*)(L + G1_A + (48 + i16) * G1_PA + (4 * s8 + kk) * 4), bq, y1, 0, 0, 0); }
#pragma unroll
            for (int s4 = 0; s4 < 4; ++s4) z = __builtin_amdgcn_mfma_f32_16x16x4f32(*(const LAS float*)(L + G1_TF + (32 + 16 * ti + i16) * G1_PA + (32 + 4 * kk + s4) * 4), y0[s4], z, 0, 0, 0);
#pragma unroll
            for (int s4 = 0; s4 < 4; ++s4) z = __builtin_amdgcn_mfma_f32_16x16x4f32(*(const LAS float*)(L + G1_TF + (32 + 16 * ti + i16) * G1_PA + (48 + 4 * kk + s4) * 4), y1[s4], z, 0, 0, 0);
#pragma unroll
            for (int r = 0; r < 4; ++r) *(LAS float*)(L + G1_TF + (32 + 16 * ti + 4 * kk + r) * G1_PA + (16 * tj + i16) * 4) = -z[r];
        }
    }
    __syncthreads();
    { const int i = tid >> 3, c0 = (tid & 7) * 8;
      const f32x4 a = *(const LAS f32x4*)(L + G1_TF + i * G1_PA + c0 * 4), c = *(const LAS f32x4*)(L + G1_TF + i * G1_PA + c0 * 4 + 16);
      v4u o; o.x = pk2(a[0], a[1]); o.y = pk2(a[2], a[3]); o.z = pk2(c[0], c[1]); o.w = pk2(c[2], c[3]); *(LAS v4u*)(L + G1_T + i * G1_PT + c0 * 2) = o; }
    __syncthreads();
    {
        const int ti = wave >> 2, cb = wave & 3, r = lane & 31, hh = lane >> 5;
        const unsigned lbase = (unsigned)(uintptr_t)L;
        const int q = (lane & 15) >> 2, p = lane & 3, blk = (lane >> 4) & 1;
        f32x16 au = {}, aw = {};
        const unsigned rv = lbase + G1_VB + (unsigned)((8 * hh + q) * G1_PX + (32 * cb + 16 * blk + 4 * p) * 2), rk = rv + (G1_KB - G1_VB);
        s16x4 xv[8], xk[8];
#define G1_TR8(dst, base) asm volatile("ds_read_b64_tr_b16 %0, %8 offset:%c9\n\tds_read_b64_tr_b16 %1, %8 offset:%c10\n\tds_read_b64_tr_b16 %2, %8 offset:%c11\n\tds_read_b64_tr_b16 %3, %8 offset:%c12\n\t" \
            "ds_read_b64_tr_b16 %4, %8 offset:%c13\n\tds_read_b64_tr_b16 %5, %8 offset:%c14\n\tds_read_b64_tr_b16 %6, %8 offset:%c15\n\tds_read_b64_tr_b16 %7, %8 offset:%c16\n\ts_waitcnt lgkmcnt(0)" \
            : "=&v"(dst[0]), "=&v"(dst[1]), "=&v"(dst[2]), "=&v"(dst[3]), "=&v"(dst[4]), "=&v"(dst[5]), "=&v"(dst[6]), "=&v"(dst[7]) \
            : "v"(base), "i"(0), "i"(4 * G1_PX), "i"(16 * G1_PX), "i"(20 * G1_PX), "i"(32 * G1_PX), "i"(36 * G1_PX), "i"(48 * G1_PX), "i"(52 * G1_PX) : "memory")
        G1_TR8(xv, rv); G1_TR8(xk, rk);
#undef G1_TR8
#pragma unroll
        for (int s = 0; s < 4; ++s) {
            const bf16x8 ta = *(const LAS bf16x8*)(L + G1_T + (32 * ti + r) * G1_PT + (16 * s + 8 * hh) * 2);
            au = mfma32(ta, __builtin_shufflevector(xv[2 * s], xv[2 * s + 1], 0, 1, 2, 3, 4, 5, 6, 7), au);
            aw = mfma32(ta, __builtin_shufflevector(xk[2 * s], xk[2 * s + 1], 0, 1, 2, 3, 4, 5, 6, 7), aw);
        }
        const int c = 32 * cb + r, nt = c >> 4, fr = c & 15;
#pragma unroll
        for (int g = 0; g < 4; ++g) { const int rowb = 32 * ti + 8 * g + 4 * hh, mt = rowb >> 4, fq = (rowb & 15) >> 2;
            *(f32x4*)(gu + GU_U + (size_t)(((mt * 8 + nt) * 64) + fq * 16 + fr) * 16) = (f32x4){au[4 * g], au[4 * g + 1], au[4 * g + 2], au[4 * g + 3]}; }
        __syncthreads();
#pragma unroll
        for (int reg = 0; reg < 16; ++reg) { const int i = 32 * ti + crow(reg, hh); *(LAS unsigned short*)(L + G1_WST + i * 256 + c * 2) = (unsigned short)f2bf(aw[reg]); }
    }
    __syncthreads();
    for (int e = tid; e < 1024; e += 512) {
        const int i = e >> 4, dk0 = (e & 15) * 8; const v4u v = *(const LAS v4u*)(L + G1_WST + i * 256 + dk0 * 2);
        const int mt = i >> 4, fr = i & 15, s = dk0 >> 5, fq = (dk0 & 31) >> 3;
        *(v4u*)(gu + GU_WF + (size_t)((mt * 4 + s) * 64 + fq * 16 + fr) * 16) = v; }
}
constexpr int SC_SB = 0, SC_VN = 32 * 272, SC_AO = SC_VN + 32 * 144, SC_PS = 272, SC_PV = 144;
__device__ __forceinline__ f32x4s mfma16(bf16x8 a, bf16x8 b, f32x4s c) { return __builtin_amdgcn_mfma_f32_16x16x32_bf16(a, b, c, 0, 0, 0); }
struct ScanB { bf16x8 wf[4], qd[4]; f32x4s u[2]; };
struct ScanE { bf16x8 qk[2], kd[2][2]; float dec; };
__device__ __forceinline__ void scan_loadB(ScanB& f, const unsigned char* gu, int mp, int cq, int lane) {
#pragma unroll
    for (int s = 0; s < 4; ++s) { f.wf[s] = *(const bf16x8*)(gu + GU_WF + (size_t)((mp * 4 + s) * 64 + lane) * 16); f.qd[s] = *(const bf16x8*)(gu + GU_QD + (size_t)((mp * 4 + s) * 64 + lane) * 16); }
#pragma unroll
    for (int nt = 0; nt < 2; ++nt) f.u[nt] = *(const f32x4s*)(gu + GU_U + (size_t)(((mp * 8 + 2 * cq + nt) * 64) + lane) * 16);
}
__device__ __forceinline__ void scan_loadE(ScanE& f, const unsigned char* gu, int mp, int lane) {
#pragma unroll
    for (int s = 0; s < 2; ++s) { f.qk[s] = *(const bf16x8*)(gu + GU_QKM + (size_t)((mp * 2 + s) * 64 + lane) * 16);
        f.kd[0][s] = *(const bf16x8*)(gu + GU_KDT + (size_t)(((2 * mp) * 2 + s) * 64 + lane) * 16); f.kd[1][s] = *(const bf16x8*)(gu + GU_KDT + (size_t)(((2 * mp + 1) * 2 + s) * 64 + lane) * 16); }
    f.dec = *(const float*)(gu + GU_DEC);
}
__device__ __forceinline__ void scan_stepB(const ScanB& f, LAS unsigned char* L, int mp, int lane, int fr, int fq) {
    f32x4s av[2] = {{0.f, 0.f, 0.f, 0.f}, {0.f, 0.f, 0.f, 0.f}}, ao[2] = {{0.f, 0.f, 0.f, 0.f}, {0.f, 0.f, 0.f, 0.f}};
#pragma unroll
    for (int s = 0; s < 4; ++s)
#pragma unroll
        for (int nt = 0; nt < 2; ++nt) { const bf16x8 sb = *(const LAS bf16x8*)(L + SC_SB + (16 * nt + fr) * SC_PS + (32 * s + 8 * fq) * 2); av[nt] = mfma16(f.wf[s], sb, av[nt]); ao[nt] = mfma16(f.qd[s], sb, ao[nt]); }
#pragma unroll
    for (int nt = 0; nt < 2; ++nt) { const f32x4s vn = f.u[nt] - av[nt]; v2u w; w.x = pk2(vn[0], vn[1]); w.y = pk2(vn[2], vn[3]);
        *(LAS v2u*)(L + SC_VN + (16 * nt + fr) * SC_PV + (16 * mp + 4 * fq) * 2) = w; *(LAS f32x4s*)(L + SC_AO + ((mp * 2 + nt) * 64 + lane) * 16) = ao[nt]; }
    __syncthreads();
    __syncthreads();
}
__device__ __forceinline__ void scan_stepE(const ScanE& f, f32x4s (&S)[2][2], LAS unsigned char* L, float* og, int mp, int lane, int fr, int fq, unsigned* prog, unsigned stepno) {
    __syncthreads();
    bf16x8 vb[2][2];
#pragma unroll
    for (int nt = 0; nt < 2; ++nt)
#pragma unroll
        for (int s = 0; s < 2; ++s) vb[nt][s] = *(const LAS bf16x8*)(L + SC_VN + (16 * nt + fr) * SC_PV + (32 * s + 8 * fq) * 2);
#pragma unroll
    for (int nt = 0; nt < 2; ++nt) { f32x4s o = *(const LAS f32x4s*)(L + SC_AO + ((mp * 2 + nt) * 64 + lane) * 16);
#pragma unroll
        for (int s = 0; s < 2; ++s) o = mfma16(f.qk[s], vb[nt][s], o);
#pragma unroll
        for (int i = 0; i < 4; ++i) og[(size_t)(16 * mp + 4 * fq + i) * 512 + 16 * nt + fr] = o[i]; }
#pragma unroll
    for (int t = 0; t < 2; ++t)
#pragma unroll
        for (int nt = 0; nt < 2; ++nt) { S[t][nt] = S[t][nt] * f.dec;
#pragma unroll
            for (int s = 0; s < 2; ++s) S[t][nt] = mfma16(f.kd[t][s], vb[nt][s], S[t][nt]);
            v2u w; w.x = pk2(S[t][nt][0], S[t][nt][1]); w.y = pk2(S[t][nt][2], S[t][nt][3]); *(LAS v2u*)(L + SC_SB + (16 * nt + fr) * SC_PS + (16 * (2 * mp + t) + 4 * fq) * 2) = w; }
    if (prog && lane == 0) __hip_atomic_store(prog, stepno, __ATOMIC_RELAXED, __HIP_MEMORY_SCOPE_AGENT);
    __syncthreads();
}
template <int VAR>
__device__ __forceinline__ void gdn_scan_unit(Frame& F, int unit) {
    const int bh = unit >> 2, cq = unit & 3, b = bh >> 2, h = bh & 3;
    int tid_o = threadIdx.x; asm volatile("" : "+v"(tid_o));
    const int lane = tid_o & 63, wave = __builtin_amdgcn_readfirstlane(tid_o >> 6), mp = wave & 3, fr = lane & 15, fq = lane >> 4;
    LAS unsigned char* L = F.lds + RING_OFF;
    __syncthreads();
    for (int e = tid_o; e < (32 * 272) / 4; e += NWAVES * 64) ((LAS unsigned*)(L + SC_SB))[e] = 0u;
    __syncthreads();
    const unsigned char* gu0 = F.ws + WS_GDN + (size_t)(bh * 128) * GU_BYTES;
    if (wave < 4) {
        ScanB f0, f1, f2, f3;
        scan_loadB(f0, gu0, mp, cq, lane); scan_loadB(f1, gu0 + GU_BYTES, mp, cq, lane); scan_loadB(f2, gu0 + 2 * GU_BYTES, mp, cq, lane);
        for (int n = 0; n < 128; n += 4) {
            if (VAR != 1) scan_loadB(f3, gu0 + (size_t)(n + 3) * GU_BYTES, mp, cq, lane); if (VAR != 2) scan_stepB(f0, L, mp, lane, fr, fq); else asm volatile("" :: "v"(f0.wf[0]), "v"(f0.qd[3]), "v"(f0.u[1]));
            if (VAR != 1 && n + 4 < 128) scan_loadB(f0, gu0 + (size_t)(n + 4) * GU_BYTES, mp, cq, lane); if (VAR != 2) scan_stepB(VAR == 1 ? f0 : f1, L, mp, lane, fr, fq); else asm volatile("" :: "v"(f1.wf[0]), "v"(f1.qd[3]), "v"(f1.u[1]));
            if (VAR != 1 && n + 5 < 128) scan_loadB(f1, gu0 + (size_t)(n + 5) * GU_BYTES, mp, cq, lane); if (VAR != 2) scan_stepB(VAR == 1 ? f0 : f2, L, mp, lane, fr, fq); else asm volatile("" :: "v"(f2.wf[0]), "v"(f2.qd[3]), "v"(f2.u[1]));
            if (VAR != 1 && n + 6 < 128) scan_loadB(f2, gu0 + (size_t)(n + 6) * GU_BYTES, mp, cq, lane); if (VAR != 2) scan_stepB(VAR == 1 ? f0 : f3, L, mp, lane, fr, fq); else asm volatile("" :: "v"(f3.wf[0]), "v"(f3.qd[3]), "v"(f3.u[1]));
        }
    } else {
        f32x4s S[2][2] = {{{0.f, 0.f, 0.f, 0.f}, {0.f, 0.f, 0.f, 0.f}}, {{0.f, 0.f, 0.f, 0.f}, {0.f, 0.f, 0.f, 0.f}}};
        float* og0 = (float*)(F.ws + WS_OG) + (size_t)b * SEQ * 512 + h * 128 + 32 * cq;
        unsigned* prog = nullptr;
        ScanE f0, f1, f2, f3;
        scan_loadE(f0, gu0, mp, lane); scan_loadE(f1, gu0 + GU_BYTES, mp, lane); scan_loadE(f2, gu0 + 2 * GU_BYTES, mp, lane);
        for (int n = 0; n < 128; n += 4) {
            if (VAR != 1) scan_loadE(f3, gu0 + (size_t)(n + 3) * GU_BYTES, mp, lane); if (VAR != 2) scan_stepE(f0, S, L, og0 + (size_t)n * 64 * 512, mp, lane, fr, fq, prog, (unsigned)(n + 1)); else asm volatile("" :: "v"(f0.qk[0]), "v"(f0.kd[1][1]));
            if (VAR != 1 && n + 4 < 128) scan_loadE(f0, gu0 + (size_t)(n + 4) * GU_BYTES, mp, lane); if (VAR != 2) scan_stepE(VAR == 1 ? f0 : f1, S, L, og0 + (size_t)(n + 1) * 64 * 512, mp, lane, fr, fq, prog, (unsigned)(n + 2)); else asm volatile("" :: "v"(f1.qk[0]), "v"(f1.kd[1][1]));
            if (VAR != 1 && n + 5 < 128) scan_loadE(f1, gu0 + (size_t)(n + 5) * GU_BYTES, mp, lane); if (VAR != 2) scan_stepE(VAR == 1 ? f0 : f2, S, L, og0 + (size_t)(n + 2) * 64 * 512, mp, lane, fr, fq, prog, (unsigned)(n + 3)); else asm volatile("" :: "v"(f2.qk[0]), "v"(f2.kd[1][1]));
            if (VAR != 1 && n + 6 < 128) scan_loadE(f2, gu0 + (size_t)(n + 6) * GU_BYTES, mp, lane); if (VAR != 2) scan_stepE(VAR == 1 ? f0 : f3, S, L, og0 + (size_t)(n + 3) * 64 * 512, mp, lane, fr, fq, prog, (unsigned)(n + 4)); else asm volatile("" :: "v"(f3.qk[0]), "v"(f3.kd[1][1]));
        }
        float* so = F.out + OFF_SSP + ((size_t)bh * 128) * 128 + 32 * cq + fr;
#pragma unroll
        for (int t = 0; t < 2; ++t)
#pragma unroll
            for (int nt = 0; nt < 2; ++nt)
#pragma unroll
                for (int i = 0; i < 4; ++i) so[(size_t)(16 * (2 * mp + t) + 4 * fq + i) * 128 + 16 * nt] = S[t][nt][i];
    }
}

constexpr int AT_KP = 144, AT_VP = 192;
constexpr int AT_K0 = 0, AT_V0 = 2 * 64 * AT_KP, AT_CS = AT_V0 + 2 * 64 * AT_VP, AT_WS = AT_CS + 2 * 256, AT_RED = AT_WS + 8 * 256, AT_TOT = AT_RED + 32, AT_CQ = AT_RED + 64;
constexpr float AT_T2 = 48.f, AT_THR = 8.f;
__device__ __forceinline__ float rowmax32(const f32x16& p0, const f32x16& p1) {
    float a = fmaxf(fmaxf(p0[0], p0[1]), p1[0]), b2 = fmaxf(fmaxf(p0[2], p0[3]), p1[1]); a = fmaxf(fmaxf(a, p1[2]), p1[3]);
#pragma unroll
    for (int r = 4; r < 16; r += 4) { a = fmaxf(fmaxf(a, p0[r]), p0[r + 1]); b2 = fmaxf(fmaxf(b2, p0[r + 2]), p0[r + 3]); a = fmaxf(fmaxf(a, p1[r]), p1[r + 1]); b2 = fmaxf(fmaxf(b2, p1[r + 2]), p1[r + 3]); }
    const float m = fmaxf(a, b2);
    return fmaxf(m, __shfl_xor(m, 32));
}
__device__ __forceinline__ bf16x8 pack_frag(const f32x16& x, int s) {
    v4u p; p.x = pk2(x[8 * s], x[8 * s + 1]); p.y = pk2(x[8 * s + 2], x[8 * s + 3]); p.z = pk2(x[8 * s + 4], x[8 * s + 5]); p.w = pk2(x[8 * s + 6], x[8 * s + 7]);
    return __builtin_bit_cast(bf16x8, p);
}
__device__ __forceinline__ void attn_unit(Frame& F, int unit, float qkb) {
    const int b = unit >> 8, h = (unit >> 5) & 7, qb = unit & 31;
    int tid_o = threadIdx.x; asm volatile("" : "+v"(tid_o));
    const int tid = tid_o, lane = tid & 63, wave = __builtin_amdgcn_readfirstlane(tid >> 6), r = lane & 31, hh = lane >> 5;
    LAS unsigned char* L = F.lds + RING_OFF;
    const bf16* QB = (const bf16*)(F.ws + WS_QB); const bf16* KB = (const bf16*)(F.ws + WS_KB); const bf16* VB = (const bf16*)(F.ws + WS_VB);
    const float* CUM = (const float*)(F.ws + WS_CUM);
    bf16* OAB = (bf16*)(F.ws + WS_OAB);
    const size_t rowb = (size_t)b * SEQ; const int q0 = qb * 256, qrow = q0 + 32 * wave + r;
    LAS float* wsf = (LAS float*)(L + AT_WS) + wave * 64; LAS float* red = (LAS float*)(L + AT_RED);
    bf16x8 qr[4];
#pragma unroll
    for (int s = 0; s < 4; ++s) qr[s] = *(const bf16x8*)(QB + (rowb + qrow) * FW + h * 64 + 16 * s + 8 * hh);
    const float cq = CUM[(rowb + qrow) * 8 + h];
    float aq = cq;
    float l_run = 0.f; f32x16 o0 = {}, o1 = {};
    const int tdiag = (q0 + 255) >> 6;
    const int srow = tid >> 3, sch = tid & 7;
    __syncthreads();
    v4u kreg = *(const v4u*)(KB + (rowb + 64 * tdiag + srow) * FW + h * 64 + sch * 8), vreg = *(const v4u*)(VB + (rowb + 64 * tdiag + srow) * FW + h * 64 + sch * 8);
    float creg = (tid < 64) ? CUM[(rowb + 64 * tdiag + tid) * 8 + h] : 0.f;
    *(LAS v4u*)(L + AT_K0 + srow * AT_KP + sch * 16) = kreg; *(LAS v4u*)(L + AT_V0 + srow * AT_VP + sch * 16) = vreg; if (tid < 64) *(LAS float*)(L + AT_CS + tid * 4) = creg;
    __syncthreads();
    const unsigned lbase = (unsigned)(uintptr_t)L;
    const int tq = (lane & 15) >> 2, tp = lane & 3, tblk = (lane >> 4) & 1;
    float G = 0.f, Gw = 0.f; bool first = true; int buf = 0;
    for (int t = tdiag; t >= 0; --t) {
        if (t == tdiag - 4) {
            float a = aq;
#pragma unroll
            for (int o = 1; o < 64; o <<= 1) a = fmaxf(a, __shfl_xor(a, o));
            Gw = a;
            if (lane == 0) red[wave] = a;
            __syncthreads();
            G = fmaxf(fmaxf(fmaxf(red[0], red[1]), fmaxf(red[2], red[3])), fmaxf(fmaxf(red[4], red[5]), fmaxf(red[6], red[7])));
        }
        bool wskip = false;
        if (t <= tdiag - 4) { const float cl = *(const LAS float*)(L + AT_CS + buf * 256 + 63 * 4); if (qkb + G - cl < -AT_T2) break; wskip = (qkb + Gw - cl < -AT_T2); }
        const bool more = (t > 0);
        if (more) { kreg = *(const v4u*)(KB + (rowb + 64 * (t - 1) + srow) * FW + h * 64 + sch * 8); vreg = *(const v4u*)(VB + (rowb + 64 * (t - 1) + srow) * FW + h * 64 + sch * 8);
            creg = (tid < 64) ? CUM[(rowb + 64 * (t - 1) + tid) * 8 + h] : 0.f; }
        const LAS unsigned char* Kt = L + AT_K0 + buf * (64 * AT_KP); const unsigned Vt = lbase + AT_V0 + buf * (64 * AT_VP); const LAS float* cs = (const LAS float*)(L + AT_CS + buf * 256);
        if (!wskip && 64 * t <= q0 + 32 * wave + 31) {
            f32x16 p0, p1;
#pragma unroll
            for (int g = 0; g < 4; ++g) { const f32x4 c0 = *(const LAS f32x4*)(cs + 8 * g + 4 * hh), c1 = *(const LAS f32x4*)(cs + 32 + 8 * g + 4 * hh);
#pragma unroll
                for (int i = 0; i < 4; ++i) { p0[4 * g + i] = aq - c0[i]; p1[4 * g + i] = aq - c1[i]; } }
#pragma unroll
            for (int s = 0; s < 4; ++s) { const bf16x8 k0 = *(const LAS bf16x8*)(Kt + r * AT_KP + (16 * s + 8 * hh) * 2), k1 = *(const LAS bf16x8*)(Kt + (32 + r) * AT_KP + (16 * s + 8 * hh) * 2);
                p0 = mfma32(k0, qr[s], p0); p1 = mfma32(k1, qr[s], p1); }
            if (64 * t + 63 > q0 + 32 * wave) {
#pragma unroll
                for (int reg = 0; reg < 16; ++reg) { const int kv = 64 * t + crow(reg, hh); if (kv > qrow) p0[reg] = -INFINITY; if (kv + 32 > qrow) p1[reg] = -INFINITY; }
            }
            const float rm = rowmax32(p0, p1);
            if (first) {
                aq -= rm;
#pragma unroll
                for (int reg = 0; reg < 16; ++reg) { p0[reg] -= rm; p1[reg] -= rm; }
                first = false;
            } else if (__any(rm > AT_THR)) {
                const float dl = fmaxf(rm, 0.f); aq -= dl; const float f = __builtin_amdgcn_exp2f(-dl); l_run *= f;
#pragma unroll
                for (int reg = 0; reg < 16; ++reg) { p0[reg] -= dl; p1[reg] -= dl; }
                if (hh == 0) wsf[r] = f;
                LDS_WAIT();
#pragma unroll
                for (int g = 0; g < 4; ++g) { const f32x4 fv = *(const LAS f32x4*)(wsf + 8 * g + 4 * hh);
#pragma unroll
                    for (int i = 0; i < 4; ++i) { o0[4 * g + i] *= fv[i]; o1[4 * g + i] *= fv[i]; } }
            }
            float rs = 0.f;
#pragma unroll
            for (int reg = 0; reg < 16; ++reg) { p0[reg] = __builtin_amdgcn_exp2f(p0[reg]); p1[reg] = __builtin_amdgcn_exp2f(p1[reg]); rs += p0[reg] + p1[reg]; }
            l_run += rs;
#pragma unroll
            for (int blk = 0; blk < 2; ++blk) {
                const unsigned ad = Vt + (unsigned)((32 * blk + 4 * hh + tq) * AT_VP + (16 * tblk + 4 * tp) * 2);
                s16x4 v[8];
                asm volatile("ds_read_b64_tr_b16 %0, %8 offset:%c9\n\tds_read_b64_tr_b16 %1, %8 offset:%c10\n\tds_read_b64_tr_b16 %2, %8 offset:%c11\n\tds_read_b64_tr_b16 %3, %8 offset:%c12\n\t"
                             "ds_read_b64_tr_b16 %4, %8 offset:%c13\n\tds_read_b64_tr_b16 %5, %8 offset:%c14\n\tds_read_b64_tr_b16 %6, %8 offset:%c15\n\tds_read_b64_tr_b16 %7, %8 offset:%c16\n\ts_waitcnt lgkmcnt(0)"
                             : "=&v"(v[0]), "=&v"(v[1]), "=&v"(v[2]), "=&v"(v[3]), "=&v"(v[4]), "=&v"(v[5]), "=&v"(v[6]), "=&v"(v[7])
                             : "v"(ad), "i"(0), "i"(8 * AT_VP), "i"(64), "i"(8 * AT_VP + 64), "i"(16 * AT_VP), "i"(24 * AT_VP), "i"(16 * AT_VP + 64), "i"(24 * AT_VP + 64) : "memory");
                const bf16x8 pa0 = pack_frag(blk ? p1 : p0, 0), pa1 = pack_frag(blk ? p1 : p0, 1);
                o0 = mfma32(pa0, __builtin_shufflevector(v[0], v[1], 0, 1, 2, 3, 4, 5, 6, 7), o0);
                o1 = mfma32(pa0, __builtin_shufflevector(v[2], v[3], 0, 1, 2, 3, 4, 5, 6, 7), o1);
                o0 = mfma32(pa1, __builtin_shufflevector(v[4], v[5], 0, 1, 2, 3, 4, 5, 6, 7), o0);
                o1 = mfma32(pa1, __builtin_shufflevector(v[6], v[7], 0, 1, 2, 3, 4, 5, 6, 7), o1);
            }
        }
        if (more) { const int nb = buf ^ 1; *(LAS v4u*)(L + AT_K0 + nb * (64 * AT_KP) + srow * AT_KP + sch * 16) = kreg; *(LAS v4u*)(L + AT_V0 + nb * (64 * AT_VP) + srow * AT_VP + sch * 16) = vreg;
            if (tid < 64) *(LAS float*)(L + AT_CS + nb * 256 + tid * 4) = creg; }
        __syncthreads();
        buf ^= 1;
    }
    l_run += __shfl_xor(l_run, 32);
    if (hh == 0) wsf[32 + r] = 1.0f / l_run;
    LDS_WAIT();
#pragma unroll
    for (int g = 0; g < 4; ++g) { const f32x4 iv = *(const LAS f32x4*)(wsf + 32 + 8 * g + 4 * hh);
#pragma unroll
        for (int i = 0; i < 4; ++i) { const int q = q0 + 32 * wave + 8 * g + 4 * hh + i; bf16* op = OAB + (rowb + q) * D + h * 64;
            op[r] = (bf16)f2bf(o0[4 * g + i] * iv[i]); op[32 + r] = (bf16)f2bf(o1[4 * g + i] * iv[i]); } }
}

__device__ __forceinline__ void gdn_sample_unit(Frame& F, int unit) {
    int tid_o = threadIdx.x; asm volatile("" : "+v"(tid_o));
    const int s = unit >> 2, h = unit & 3, tid = tid_o;
    LAS float* L = (LAS float*)(F.lds + RING_OFF);
    LAS float* qkv = L; LAS float* red = L + 1536; LAS float* scal = L + 2048 + 64;
    const bf16* GQ = (const bf16*)(F.ws + WS_GQ); const float* GAB = (const float*)(F.ws + WS_GAB); const float* cw = F.in[15];
    __syncthreads();
    if (tid < 384) {
        const int X = tid >> 7, c = tid & 127, ch = X * 512 + h * 128 + c;
        float xp[7];
#pragma unroll
        for (int i = 0; i < 3; ++i) xp[i] = F.in[7][((size_t)s * 3 + i) * CCH + ch];
#pragma unroll
        for (int j = 0; j < 4; ++j) xp[3 + j] = bf2f(GQ[(size_t)(MP + s * 4 + j) * CCH + ch]);
        const float w0 = cw[ch], w1 = cw[CCH + ch], w2 = cw[2 * CCH + ch], w3 = cw[3 * CCH + ch];
#pragma unroll
        for (int j = 0; j < 4; ++j) { const float y = w0 * xp[j] + w1 * xp[j + 1] + w2 * xp[j + 2] + w3 * xp[j + 3]; qkv[(X * 4 + j) * 128 + c] = y * __builtin_amdgcn_rcpf(1.0f + __expf(-y)); }
    }
    if (tid >= 448 && tid < 452) { const int j = tid - 448; scal[j] = __expf(GAB[(size_t)(MP + s * 4 + j) * 8 + h]); scal[4 + j] = GAB[(size_t)(MP + s * 4 + j) * 8 + 4 + h]; }
    __syncthreads();
    { const int w = F.wave, X = w >> 2, j = w & 3; LAS float* v = qkv + (X * 4 + j) * 128; const float a = v[F.lane], b2 = v[64 + F.lane];
      const float ss = wave_sum(a * a + b2 * b2); float rn = __builtin_amdgcn_rsqf(ss + EPS); if (X == 0) rn *= 0.08838834764831845f;
      v[F.lane] = a * rn; v[64 + F.lane] = b2 * rn; }
    __syncthreads();
    const int dv = tid & 127, rg = tid >> 7;
    float S[32];
    const float* sp = F.in[8] + ((size_t)(s * 4 + h) * 128 + rg * 32) * 128 + dv;
#pragma unroll
    for (int i = 0; i < 32; ++i) S[i] = sp[(size_t)i * 128];
    float ov[4];
#pragma unroll
    for (int j = 0; j < 4; ++j) {
        const float a = scal[j], be = scal[4 + j]; const LAS float* qj = qkv + (0 * 4 + j) * 128 + rg * 32; const LAS float* kj = qkv + (1 * 4 + j) * 128 + rg * 32;
        float ks = 0.f;
#pragma unroll
        for (int i = 0; i < 32; ++i) { S[i] *= a; ks += kj[i] * S[i]; }
        red[rg * 128 + dv] = ks; __syncthreads();
        const float kS = red[dv] + red[128 + dv] + red[256 + dv] + red[384 + dv];
        const float vn = be * (qkv[(2 * 4 + j) * 128 + dv] - kS);
        float os = 0.f;
#pragma unroll
        for (int i = 0; i < 32; ++i) { S[i] += kj[i] * vn; os += qj[i] * S[i]; }
        __syncthreads();
        red[rg * 128 + dv] = os; __syncthreads();
        ov[j] = red[dv] + red[128 + dv] + red[256 + dv] + red[384 + dv];
        __syncthreads();
    }
    float* so = F.out + OFF_SSS + ((size_t)(s * 4 + h) * 128 + rg * 32) * 128 + dv;
#pragma unroll
    for (int i = 0; i < 32; ++i) so[(size_t)i * 128] = S[i];
    {
        float ssj[4];
#pragma unroll
        for (int j = 0; j < 4; ++j) { const float v = wave_sum(ov[j] * ov[j]); if (F.lane == 0) red[j * 8 + F.wave] = v; }
        __syncthreads();
#pragma unroll
        for (int j = 0; j < 4; ++j) ssj[j] = red[j * 8] + red[j * 8 + 1];
        if (rg == 0) {
            const bf16* GZ = (const bf16*)(F.ws + WS_GZ); bf16* OAB = (bf16*)(F.ws + WS_OAB); const float gn = F.in[18][dv];
#pragma unroll
            for (int j = 0; j < 4; ++j) { const size_t row = MP + s * 4 + j; const float y = ov[j] * __builtin_amdgcn_rsqf(ssj[j] * (1.0f / 128.0f) + EPS) * gn * bf2f(GZ[row * 512 + h * 128 + dv]);
                OAB[row * D + 512 + h * 128 + dv] = (bf16)f2bf(y); }
        }
    }
    __syncthreads();
}
__device__ __forceinline__ void fox_cumsum_seg(Frame& F, int w) {
    int tid_o = threadIdx.x; asm volatile("" : "+v"(tid_o));
    const int b = w >> 7, seg = w & 127, i = tid_o >> 3, h = tid_o & 7;
    LAS float* part = (LAS float*)(F.lds + RING_OFF);
    const float* src = (const float*)(F.ws + WS_LGF) + (size_t)b * SEQ * 8;
    __syncthreads();
    { const int half = tid_o & 1, r0 = tid_o >> 1, nrows = 64 * seg; const f32x4* s4 = (const f32x4*)src;
      f32x4 acc0 = {0.f, 0.f, 0.f, 0.f}, acc1 = acc0;
      for (int base = 0; base < nrows; base += 16 * 256) { f32x4 v[16];
#pragma unroll
          for (int u = 0; u < 16; ++u) { const int row = base + 256 * u + r0; v[u] = (row < nrows) ? s4[(size_t)row * 2 + half] : (f32x4){0.f, 0.f, 0.f, 0.f}; }
#pragma unroll
          for (int u = 0; u < 16; u += 2) { acc0 += v[u]; acc1 += v[u + 1]; } }
      f32x4 acc = acc0 + acc1;
#pragma unroll
      for (int o = 2; o < 64; o <<= 1) {
#pragma unroll
          for (int c = 0; c < 4; ++c) acc[c] += __shfl_xor(acc[c], o); }
      if ((tid_o & 63) < 2) *(LAS f32x4*)(part + ((tid_o >> 6) * 2 + half) * 4) = acc; }
    const float mine = src[(size_t)(64 * seg + i) * 8 + h];
    part[512 + i * 8 + h] = mine;
    __syncthreads();
    float run = 0.f;
#pragma unroll
    for (int wv = 0; wv < 8; ++wv) run += part[(wv * 2 + (h >> 2)) * 4 + (h & 3)];
    for (int q = 0; q <= i; ++q) run += part[512 + q * 8 + h];
    ((float*)(F.ws + WS_CUM))[((size_t)b * SEQ + 64 * seg + i) * 8 + h] = run * LOG2E;
    __syncthreads();
}
__device__ __forceinline__ void conv_out_job(Frame& F) {
    const bf16* GQ = (const bf16*)(F.ws + WS_GQ);
    for (int e = F.vcu * (NWAVES * 64) + F.tid; e < (NB * 3 + DB * 3) * CCH; e += F.G * NWAVES * 64) {
        const int rr = e / CCH, c = e % CCH;
        if (rr < NB * 3) { const int b = rr / 3, i = rr % 3; F.out[OFF_CVP + (size_t)rr * CCH + c] = bf2f(GQ[((size_t)b * SEQ + SEQ - 3 + i) * CCH + c]); }
        else { const int r2 = rr - NB * 3, s = r2 / 3, i = r2 % 3; F.out[OFF_CVS + (size_t)r2 * CCH + c] = bf2f(GQ[(size_t)(MP + s * 4 + 1 + i) * CCH + c]); }
    }
}
__device__ __forceinline__ void gdn_outnorm_rows(Frame& F) {
    const float* OG = (const float*)(F.ws + WS_OG); const bf16* GZ = (const bf16*)(F.ws + WS_GZ); bf16* OAB = (bf16*)(F.ws + WS_OAB);
    const int gw = F.vcu * NWAVES + F.wave, NGW = F.G * NWAVES, lane = F.lane;
    const f32x4 g0 = *(const f32x4*)(F.in[18] + (lane & 15) * 8), g1 = *(const f32x4*)(F.in[18] + (lane & 15) * 8 + 4);
    for (int m0 = gw; m0 < MP; m0 += 4 * NGW) {
        f32x4 a[4], c[4]; v4u z[4];
#pragma unroll
        for (int k = 0; k < 4; ++k) { const size_t m = (size_t)m0 + (size_t)k * NGW; a[k] = *(const f32x4*)(OG + m * 512 + lane * 8); c[k] = *(const f32x4*)(OG + m * 512 + lane * 8 + 4); z[k] = *(const v4u*)(GZ + m * 512 + lane * 8); }
#pragma unroll
        for (int k = 0; k < 4; ++k) { const size_t m = (size_t)m0 + (size_t)k * NGW;
            float ss = (a[k][0] * a[k][0] + a[k][1] * a[k][1]) + (a[k][2] * a[k][2] + a[k][3] * a[k][3]) + (c[k][0] * c[k][0] + c[k][1] * c[k][1]) + (c[k][2] * c[k][2] + c[k][3] * c[k][3]);
            ss = red16(ss);
            const float rs = __builtin_amdgcn_rsqf(ss * (1.0f / 128.0f) + EPS);
            v4u o; o.x = pk2(a[k][0] * rs * g0[0] * bflo(z[k].x), a[k][1] * rs * g0[1] * bfhi(z[k].x)); o.y = pk2(a[k][2] * rs * g0[2] * bflo(z[k].y), a[k][3] * rs * g0[3] * bfhi(z[k].y));
            o.z = pk2(c[k][0] * rs * g1[0] * bflo(z[k].z), c[k][1] * rs * g1[1] * bfhi(z[k].z)); o.w = pk2(c[k][2] * rs * g1[2] * bflo(z[k].w), c[k][3] * rs * g1[3] * bfhi(z[k].w));
            *(v4u*)(OAB + m * D + 512 + lane * 8) = o; }
    }
}
template <class Mid>
__device__ __forceinline__ void gdn_outnorm_rows_grp(Frame& F, Mid mid) {
    const float* OG = (const float*)(F.ws + WS_OG); const bf16* GZ = (const bf16*)(F.ws + WS_GZ); bf16* OAB = (bf16*)(F.ws + WS_OAB);
    const int gw = F.vcu * NWAVES + F.wave, NGW = F.G * NWAVES, lane = F.lane;
    const f32x4 g0 = *(const f32x4*)(F.in[18] + (lane & 15) * 8), g1 = *(const f32x4*)(F.in[18] + (lane & 15) * 8 + 4);
    const int rbase = (F.vcu >> 5) * 2048 + (F.vcu & 31) * NWAVES + F.wave;
    { const int m0 = rbase;
        f32x4 a[8], c[8]; v4u z[8];
#pragma unroll
        for (int k = 0; k < 8; ++k) { const size_t m = (size_t)m0 + (size_t)k * 256; a[k] = *(const f32x4*)(OG + m * 512 + lane * 8); c[k] = *(const f32x4*)(OG + m * 512 + lane * 8 + 4); z[k] = *(const v4u*)(GZ + m * 512 + lane * 8); }
        mid();
#pragma unroll
        for (int k = 0; k < 8; ++k) { const size_t m = (size_t)m0 + (size_t)k * 256;
            float ss = (a[k][0] * a[k][0] + a[k][1] * a[k][1]) + (a[k][2] * a[k][2] + a[k][3] * a[k][3]) + (c[k][0] * c[k][0] + c[k][1] * c[k][1]) + (c[k][2] * c[k][2] + c[k][3] * c[k][3]);
            ss = red16(ss);
            const float rs = __builtin_amdgcn_rsqf(ss * (1.0f / 128.0f) + EPS);
            v4u o; o.x = pk2(a[k][0] * rs * g0[0] * bflo(z[k].x), a[k][1] * rs * g0[1] * bfhi(z[k].x)); o.y = pk2(a[k][2] * rs * g0[2] * bflo(z[k].y), a[k][3] * rs * g0[3] * bfhi(z[k].y));
            o.z = pk2(c[k][0] * rs * g1[0] * bflo(z[k].z), c[k][1] * rs * g1[1] * bfhi(z[k].z)); o.w = pk2(c[k][2] * rs * g1[2] * bflo(z[k].w), c[k][3] * rs * g1[3] * bfhi(z[k].w));
            *(v4u*)(OAB + m * D + 512 + lane * 8) = o; }
    }
}
template <bool AF32, bool SUMSQ>
__device__ __forceinline__ void skinny_tile(const void* A, int lda, const bf16* Bt, int ldb, int n0, int k0, int k1, int wave, int lane, f32x4s& acc, float& ssq) {
    const int fr = lane & 15, fq = lane >> 4;
    acc = (f32x4s){0.f, 0.f, 0.f, 0.f}; float s = 0.f;
    const bf16* bp = Bt + (size_t)(n0 + fr) * ldb + 8 * fq;
    const float* apf = (const float*)A + (size_t)(16 * wave + fr) * lda + 8 * fq;
    const bf16* aph = (const bf16*)A + (size_t)(16 * wave + fr) * lda + 8 * fq;
#pragma unroll 8
    for (int k = k0; k < k1; k += 32) {
        const bf16x8 b = *(const bf16x8*)(bp + k);
        bf16x8 a;
        if constexpr (AF32) { const f32x4 x0 = *(const f32x4*)(apf + k), x1 = *(const f32x4*)(apf + k + 4);
            if constexpr (SUMSQ) s += (x0[0] * x0[0] + x0[1] * x0[1]) + (x0[2] * x0[2] + x0[3] * x0[3]) + (x1[0] * x1[0] + x1[1] * x1[1]) + (x1[2] * x1[2] + x1[3] * x1[3]);
            v4u p; p.x = pk2(x0[0], x0[1]); p.y = pk2(x0[2], x0[3]); p.z = pk2(x1[0], x1[1]); p.w = pk2(x1[2], x1[3]); a = __builtin_bit_cast(bf16x8, p);
        } else { const v4u p = *(const v4u*)(aph + k); a = __builtin_bit_cast(bf16x8, p);
            if constexpr (SUMSQ) { float t0 = bflo(p.x), t1 = bfhi(p.x), t2 = bflo(p.y), t3 = bfhi(p.y), t4 = bflo(p.z), t5 = bfhi(p.z), t6 = bflo(p.w), t7 = bfhi(p.w);
                s += (t0 * t0 + t1 * t1) + (t2 * t2 + t3 * t3) + (t4 * t4 + t5 * t5) + (t6 * t6 + t7 * t7); } }
        acc = mfma16(a, b, acc);
    }
    if constexpr (SUMSQ) { s += __shfl_xor(s, 16); s += __shfl_xor(s, 32); }
    ssq = s;
}
template <bool AF32, bool SUMSQ>
__device__ __forceinline__ void skinny_half(const void* A, int lda, const bf16* Bt, int ldb, int n0, int k0, int k1, int mh, int wave, int lane, LAS unsigned char* scr, f32x4s& acc, float& ssq) {
    const int mt = wave & 3, kh = wave >> 2, kl = (k1 - k0) >> 1;
    const void* Ah = AF32 ? (const void*)((const float*)A + (size_t)(64 * mh) * lda) : (const void*)((const bf16*)A + (size_t)(64 * mh) * lda);
    skinny_tile<AF32, SUMSQ>(Ah, lda, Bt, ldb, n0, k0 + kh * kl, k0 + kh * kl + kl, mt, lane, acc, ssq);
    __syncthreads();
    if (kh == 1) { *(LAS f32x4s*)(scr + (mt * 64 + lane) * 16) = acc; if (SUMSQ) *(LAS float*)(scr + 4096 + (mt * 64 + lane) * 4) = ssq; }
    __syncthreads();
    if (kh == 0) { acc += *(const LAS f32x4s*)(scr + (mt * 64 + lane) * 16); if (SUMSQ) ssq += *(const LAS float*)(scr + 4096 + (mt * 64 + lane) * 4); }
}
__device__ __forceinline__ void sample_p5(Frame& F, int u) {
    int tid_o = threadIdx.x; asm volatile("" : "+v"(tid_o));
    const int lane = tid_o & 63, wave = __builtin_amdgcn_readfirstlane(tid_o >> 6), fr = lane & 15, fq = lane >> 4;
    LAS unsigned char* scr = F.lds + RING_OFF;
    const bf16* OAB = (const bf16*)(F.ws + WS_OAB) + (size_t)MP * D; const bf16* GT = (const bf16*)(F.ws + WS_GT) + (size_t)MP * 2048;
    if (u < 128) {
        const int cu = u >> 1, mh = u & 1; f32x4s aa, ab; float d;
        skinny_half<false, false>(OAB, D, (const bf16*)(F.ws + WS_WAB), D, 16 * cu, 0, 512, mh, wave, lane, scr, aa, d);
        __syncthreads();
        skinny_half<false, false>(OAB, D, (const bf16*)(F.ws + WS_WAB), D, 16 * cu, 512, 1024, mh, wave, lane, scr, ab, d);
        if (wave < 4) { bf16* MRG = (bf16*)(F.ws + WS_MRG) + (size_t)MP * D;
#pragma unroll
            for (int i = 0; i < 4; ++i) { const int row = 64 * mh + 16 * wave + 4 * fq + i, col = 16 * cu + fr;
                const float ga = bf2f(GT[(size_t)row * 2048 + col]), gb = bf2f(GT[(size_t)row * 2048 + 1024 + col]);
                MRG[(size_t)row * D + col] = (bf16)f2bf(ga * aa[i] + gb * ab[i]); } }
    } else if (u < 256) {
        const int cu = (u - 128) >> 1, mh = u & 1; f32x4s a; float d;
        skinny_half<false, false>((const bf16*)(F.ws + WS_PLB) + (size_t)MP * PLE, PLE, (const bf16*)(F.ws + WS_WPL), PLE, 16 * cu, 0, PLE, mh, wave, lane, scr, a, d);
        if (wave < 4) { bf16* PL = (bf16*)(F.ws + WS_PL) + (size_t)MP * D;
#pragma unroll
            for (int i = 0; i < 4; ++i) PL[(size_t)(64 * mh + 16 * wave + 4 * fq + i) * D + 16 * cu + fr] = (bf16)f2bf(a[i]); }
    }
}
__device__ __forceinline__ void sample_zero_x2(Frame& F, int q) {
    float* X2 = (float*)(F.ws + WS_X2) + (size_t)MP * D + (size_t)q * 32 * D;
    for (int e = F.tid; e < 32 * D / 4; e += NWAVES * 64) ((f32x4*)X2)[e] = (f32x4){0.f, 0.f, 0.f, 0.f};
}
__device__ __forceinline__ void sample_p6(Frame& F, int u) {
    int tid_o = threadIdx.x; asm volatile("" : "+v"(tid_o));
    const int lane = tid_o & 63, wave = __builtin_amdgcn_readfirstlane(tid_o >> 6), fr = lane & 15, fq = lane >> 4;
    if (u >= 128) return;
    const int cu = u >> 1, mh = u & 1; f32x4s a; float d;
    skinny_half<false, false>((const bf16*)(F.ws + WS_MRG) + (size_t)MP * D, D, (const bf16*)(F.ws + WS_WOUT), D, 16 * cu, 0, D, mh, wave, lane, F.lds + RING_OFF, a, d);
    if (wave < 4) { float* X1 = (float*)(F.ws + WS_X1) + (size_t)MP * D; bf16* X1B = (bf16*)(F.ws + WS_X1B) + (size_t)MP * D;
#pragma unroll
        for (int i = 0; i < 4; ++i) { const int row = 64 * mh + 16 * wave + 4 * fq + i, col = 16 * cu + fr; const float v = a[i] + F.in[1][(size_t)row * D + col];
            X1[(size_t)row * D + col] = v; X1B[(size_t)row * D + col] = (bf16)f2bf(v); } }
}
template <bool SUMSQ>
__device__ __forceinline__ void skinny_half2(const bf16* A, int lda, const bf16* Bt, int ldb, int n0, int k0, int k1, int mh, int wave, int lane, LAS unsigned char* scr, f32x4s (&acc)[2], float& ssq) {
    const int mt = wave & 3, kh = wave >> 2, kl = (k1 - k0) >> 1, fr = lane & 15, fq = lane >> 4;
    acc[0] = (f32x4s){0.f, 0.f, 0.f, 0.f}; acc[1] = (f32x4s){0.f, 0.f, 0.f, 0.f}; float s = 0.f;
    const bf16* ap = A + (size_t)(64 * mh + 16 * mt + fr) * lda + 8 * fq; const bf16* bp0 = Bt + (size_t)(n0 + fr) * ldb + 8 * fq; const bf16* bp1 = bp0 + (size_t)16 * ldb;
    const int ka = k0 + kh * kl;
#pragma unroll 8
    for (int ks = 0; ks < 16; ++ks) { const int k = ka + 32 * ks;
        const v4u p = *(const v4u*)(ap + k); const bf16x8 a = __builtin_bit_cast(bf16x8, p); const bf16x8 b0 = *(const bf16x8*)(bp0 + k), b1 = *(const bf16x8*)(bp1 + k);
        if constexpr (SUMSQ) { float t0 = bflo(p.x), t1 = bfhi(p.x), t2 = bflo(p.y), t3 = bfhi(p.y), t4 = bflo(p.z), t5 = bfhi(p.z), t6 = bflo(p.w), t7 = bfhi(p.w);
            s += (t0 * t0 + t1 * t1) + (t2 * t2 + t3 * t3) + (t4 * t4 + t5 * t5) + (t6 * t6 + t7 * t7); }
        acc[0] = mfma16(a, b0, acc[0]); acc[1] = mfma16(a, b1, acc[1]);
    }
    if constexpr (SUMSQ) { s += __shfl_xor(s, 16); s += __shfl_xor(s, 32); }
    __syncthreads();
    if (kh == 1) { *(LAS f32x4s*)(scr + (mt * 64 + lane) * 32) = acc[0]; *(LAS f32x4s*)(scr + (mt * 64 + lane) * 32 + 16) = acc[1]; if (SUMSQ) *(LAS float*)(scr + 8192 + (mt * 64 + lane) * 4) = s; }
    __syncthreads();
    if (kh == 0) { acc[0] += *(const LAS f32x4s*)(scr + (mt * 64 + lane) * 32); acc[1] += *(const LAS f32x4s*)(scr + (mt * 64 + lane) * 32 + 16); if (SUMSQ) s += *(const LAS float*)(scr + 8192 + (mt * 64 + lane) * 4); }
    ssq = s;
}
__device__ __forceinline__ void sample_p7(Frame& F, int u) {
    int tid_o = threadIdx.x; asm volatile("" : "+v"(tid_o));
    const int lane = tid_o & 63, wave = __builtin_amdgcn_readfirstlane(tid_o >> 6), fr = lane & 15, fq = lane >> 4;
    if (u >= 256) return;
    const int cu = u >> 1, mh = u & 1; f32x4s a[2]; float ss;
    skinny_half2<true>((const bf16*)(F.ws + WS_X1B) + (size_t)MP * D, D, (const bf16*)(F.ws + WS_WUP), D, 32 * cu, 0, D, mh, wave, lane, F.lds + RING_OFF, a, ss);
    if (wave < 4) { const float rs = __builtin_amdgcn_rsqf(ss * (1.0f / D) + EPS); bf16* HB = (bf16*)(F.ws + WS_HB) + (size_t)MP * DFF;
#pragma unroll
        for (int i = 0; i < 4; ++i) { const float r = __shfl(rs, 4 * fq + i);
#pragma unroll
            for (int nt = 0; nt < 2; ++nt) { const float v = fmaxf(a[nt][i] * r, 0.f); HB[(size_t)(64 * mh + 16 * wave + 4 * fq + i) * DFF + 32 * cu + 16 * nt + fr] = (bf16)f2bf(v * v); } } }
}
__device__ __forceinline__ void sample_p8(Frame& F, int u) {
    int tid_o = threadIdx.x; asm volatile("" : "+v"(tid_o));
    const int lane = tid_o & 63, wave = __builtin_amdgcn_readfirstlane(tid_o >> 6), fr = lane & 15, fq = lane >> 4;
    if (u >= 256) return;
    const int cu = u & 31, mh = (u >> 5) & 1, kq = u >> 6; f32x4s a[2]; float d;
    skinny_half2<false>((const bf16*)(F.ws + WS_HB) + (size_t)MP * DFF, DFF, (const bf16*)(F.ws + WS_WDN), DFF, 32 * cu, 1024 * kq, 1024 * kq + 1024, mh, wave, lane, F.lds + RING_OFF, a, d);
    if (wave < 4) { float* X2 = (float*)(F.ws + WS_X2) + (size_t)MP * D; const float* X1 = (const float*)(F.ws + WS_X1) + (size_t)MP * D;
#pragma unroll
        for (int i = 0; i < 4; ++i)
#pragma unroll
            for (int nt = 0; nt < 2; ++nt) { const int row = 64 * mh + 16 * wave + 4 * fq + i, col = 32 * cu + 16 * nt + fr; float v = a[nt][i]; if (kq == 0) v += X1[(size_t)row * D + col]; atomicAdd(X2 + (size_t)row * D + col, v); } }
}
__device__ __forceinline__ void sample_p9(Frame& F, int u) {
    int tid_o = threadIdx.x; asm volatile("" : "+v"(tid_o));
    const int lane = tid_o & 63, wave = __builtin_amdgcn_readfirstlane(tid_o >> 6), fr = lane & 15, fq = lane >> 4;
    if (u >= 128) return;
    const int cu = u >> 1, mh = u & 1;
    const float* X2 = (const float*)(F.ws + WS_X2) + (size_t)MP * D; const bf16* PL = (const bf16*)(F.ws + WS_PL) + (size_t)MP * D;
    f32x4s a; float ss;
    skinny_half<true, true>(X2, D, (const bf16*)(F.ws + WS_WGT), D, 16 * cu, 0, D, mh, wave, lane, F.lds + RING_OFF, a, ss);
    if (wave < 4) { const float rs = __builtin_amdgcn_rsqf(ss * (1.0f / D) + EPS);
#pragma unroll
        for (int i = 0; i < 4; ++i) { const int row = 64 * mh + 16 * wave + 4 * fq + i, col = 16 * cu + fr; const float r = __shfl(rs, 4 * fq + i);
            F.out[OFF_YS + (size_t)row * D + col] = X2[(size_t)row * D + col] + bf2f(PL[(size_t)row * D + col]) * __builtin_amdgcn_rcpf(1.0f + __expf(-a[i] * r)); } }
}
#ifndef MK_N_LAUNCHES
#define MK_N_LAUNCHES 1
#endif
constexpr int N_PHASES = 10;
__device__ __forceinline__ int q_fetch(Frame& F, int qi) {
    __syncthreads();
    if (F.tid == 0) F.MISC[16] = __hip_atomic_fetch_add((unsigned*)(F.ctl + CW_Q + 64 * qi), 1u, __ATOMIC_RELAXED, __HIP_MEMORY_SCOPE_AGENT);
    __syncthreads();
    return (int)F.MISC[16];
}
__device__ __forceinline__ void p2_publish(Frame& F, const XcdBarrier& xb) {
    asm volatile("s_waitcnt vmcnt(0)" ::: "memory"); __syncthreads();
    if (F.tid == 0) {
        if (MK_N_LAUNCHES == 1) {
            __builtin_amdgcn_s_waitcnt(0);
            const unsigned nloc = xb.st[0];
            const unsigned old = __hip_atomic_fetch_add((unsigned*)(F.ctl + CW_PROG + 64 * (144 + (int)xb.x)), 1u, __ATOMIC_RELAXED, __HIP_MEMORY_SCOPE_AGENT);
            if (old + 1u == nloc) { __builtin_amdgcn_fence(__ATOMIC_RELEASE, "agent"); asm volatile("s_waitcnt vmcnt(0)" ::: "memory");
                (void)__hip_atomic_fetch_add((unsigned*)(F.ctl + CW_PROG + 64 * 16), nloc, __ATOMIC_RELAXED, __HIP_MEMORY_SCOPE_AGENT); }
        } else { __builtin_amdgcn_fence(__ATOMIC_RELEASE, "agent"); asm volatile("s_waitcnt vmcnt(0)" ::: "memory");
            (void)__hip_atomic_fetch_add((unsigned*)(F.ctl + CW_PROG + 64 * 16), 1u, __ATOMIC_RELAXED, __HIP_MEMORY_SCOPE_AGENT); } }
}
__device__ __forceinline__ void p2_wait(Frame& F, unsigned* tmo) {
    if (F.tid == 0) { unsigned sp = 0;
        while (__hip_atomic_load((unsigned*)(F.ctl + CW_PROG + 64 * 16), __ATOMIC_RELAXED, __HIP_MEMORY_SCOPE_AGENT) < (unsigned)F.G) { __builtin_amdgcn_s_sleep(2);
            if ((++sp & 255u) == 0u) { if (__hip_atomic_load(tmo, __ATOMIC_RELAXED, __HIP_MEMORY_SCOPE_AGENT)) break; if (sp > (1u << 20)) { atomicAdd(tmo, 1u); break; } } }
        __builtin_amdgcn_fence(__ATOMIC_ACQUIRE, "agent"); asm volatile("s_waitcnt vmcnt(0)" ::: "memory"); }
    __syncthreads();
}
__device__ __forceinline__ void seam_arrive_wait(Frame& F, int k, unsigned* tmo) {
    asm volatile("s_waitcnt vmcnt(0)" ::: "memory"); __syncthreads();
    if (F.tid == 0) {
        __builtin_amdgcn_s_waitcnt(0);
        const int g = (int)blockIdx.x & 7;
        unsigned* gc = (unsigned*)(F.ctl + CW_PROG + 64 * (32 + 8 * k + g)); unsigned* gg = (unsigned*)(F.ctl + CW_PROG + 64 * (96 + 8 * k + g));
        const unsigned target = (unsigned)F.G >> 3;
        const unsigned old = __hip_atomic_fetch_add(gc, 1u, __ATOMIC_RELAXED, __HIP_MEMORY_SCOPE_AGENT);
        if (old + 1u == target) {
            (void)__hip_atomic_fetch_add(gg, 1u, __ATOMIC_RELAXED, __HIP_MEMORY_SCOPE_AGENT);
            __builtin_amdgcn_fence(__ATOMIC_RELEASE, "agent"); asm volatile("s_waitcnt vmcnt(0)" ::: "memory");
            (void)__hip_atomic_fetch_add((unsigned*)(F.ctl + CW_PROG + 64 * (72 + k)), target, __ATOMIC_RELAXED, __HIP_MEMORY_SCOPE_AGENT);
        } else { unsigned sp = 0;
            while (__hip_atomic_load(gg, __ATOMIC_RELAXED, __HIP_MEMORY_SCOPE_AGENT) == 0u) { __builtin_amdgcn_s_sleep(1);
                if ((++sp & 255u) == 0u) { if (__hip_atomic_load(tmo, __ATOMIC_RELAXED, __HIP_MEMORY_SCOPE_AGENT)) break; if (sp > (1u << 20)) { atomicAdd(tmo, 1u); break; } } } }
        __builtin_amdgcn_fence(__ATOMIC_ACQUIRE, "agent"); asm volatile("s_waitcnt vmcnt(0)" ::: "memory"); }
    __syncthreads();
}
__device__ __forceinline__ void sample_wait(Frame& F, int k, unsigned* tmo) {
    if (F.tid == 0) { unsigned* sc = (unsigned*)(F.ctl + CW_PROG + 64 * (72 + k)); unsigned sp = 0;
        while (__hip_atomic_load(sc, __ATOMIC_RELAXED, __HIP_MEMORY_SCOPE_AGENT) < (unsigned)F.G) { __builtin_amdgcn_s_sleep(2);
            if ((++sp & 255u) == 0u) { if (__hip_atomic_load(tmo, __ATOMIC_RELAXED, __HIP_MEMORY_SCOPE_AGENT)) break; if (sp > (1u << 20)) { atomicAdd(tmo, 1u); break; } } }
        __builtin_amdgcn_fence(__ATOMIC_ACQUIRE, "agent"); asm volatile("s_waitcnt vmcnt(0)" ::: "memory"); }
    __syncthreads();
}
__global__ void __launch_bounds__(NWAVES * 64, 2) mk_fwd(Args args) {
    extern __shared__ __attribute__((aligned(16))) unsigned char lds[];
    Frame F;
    F.lds = (LAS unsigned char*)lds;
    F.MISC = (volatile LAS unsigned*)(F.lds + MISC_OFF);
    F.tid = threadIdx.x; F.lane = F.tid & 63; F.wave = __builtin_amdgcn_readfirstlane(F.tid >> 6);
    F.G = gridDim.x; { const int bx = blockIdx.x; F.vcu = (F.G % 8 == 0) ? (bx % 8) * (F.G / 8) + bx / 8 : bx; }
    F.ws = args.ws; F.out = args.out; F.ctl = (gu32*)(args.ws + WS_CTL);
#pragma unroll
    for (int i = 0; i < 28; ++i) F.in[i] = (const float*)args.in[i];
    F.page_table = (const int*)args.in[9];
    for (int u = F.tid; u < (LDS_BYTES - LDSCTL_OFF) / 4; u += NWAVES * 64) ((LAS unsigned*)(F.lds + LDSCTL_OFF))[u] = 0u;
    __syncthreads();
    XcdBarrier bar; bar.bar = (unsigned*)(F.ctl + CW_BAR); bar.x = 0; bar.st = nullptr;
    if (MK_N_LAUNCHES == 1) { bar = xcd_barrier_post((unsigned*)(F.ctl + CW_BAR), F.MISC + 8);
        if (F.tid == 0) (void)__hip_atomic_fetch_or((unsigned*)(F.ctl + CW_PROG + 64 * (80 + ((int)blockIdx.x & 7))), 1u << bar.x, __ATOMIC_RELAXED, __HIP_MEMORY_SCOPE_AGENT); }
#define GRID_BAR() do { if (MK_N_LAUNCHES == 1) xcd_barrier(bar); } while (0)
    bool grp = false;
    unsigned* const tmo = (unsigned*)(F.ctl + CW_BAR) + XB_TMO;
#define SEAM(k) do { if (grp) seam_arrive_wait(F, (k), tmo); else GRID_BAR(); } while (0)
#define SAMPLE_WAIT(k) do { if (grp) sample_wait(F, (k), tmo); } while (0)
    const int lo = args.ph_lo, hi = args.ph_hi;
#ifndef PH_MASK
#define PH_MASK 0x3ff
#endif
#define IN(k) (((PH_MASK >> (k)) & 1) && lo <= (k) && (k) < hi)
#define BOTH(k) (IN(k) && IN((k) + 1))
    unsigned char* ws = args.ws;
    bf16* XN = (bf16*)(ws + WS_XN); bf16* QB = (bf16*)(ws + WS_QB); bf16* KB = (bf16*)(ws + WS_KB); bf16* VB = (bf16*)(ws + WS_VB);
    bf16* GQ = (bf16*)(ws + WS_GQ); bf16* GZ = (bf16*)(ws + WS_GZ); bf16* GT = (bf16*)(ws + WS_GT);
    float* GAB = (float*)(ws + WS_GAB); float* LGF = (float*)(ws + WS_LGF);
    bf16* OAB = (bf16*)(ws + WS_OAB); bf16* MRG = (bf16*)(ws + WS_MRG); float* X1 = (float*)(ws + WS_X1); bf16* X1B = (bf16*)(ws + WS_X1B);
    bf16* HB = (bf16*)(ws + WS_HB); float* X2 = (float*)(ws + WS_X2); bf16* X2B = (bf16*)(ws + WS_X2B); bf16* PL = (bf16*)(ws + WS_PL);
    float* SS1 = (float*)(F.ctl + CW_SS1); float* SS2 = (float*)(F.ctl + CW_SS2);

    if (IN(0)) { p0_prologue(F); if (BOTH(0)) GRID_BAR(); }
    if (IN(1)) {
        pg8::Gemm g{XN, (const bf16*)(ws + WS_WIN), MPAD, NIN, D}; pg8::QueueOrder S; S.init(MPAD, NIN, (unsigned*)(F.ctl + CW_Q + 64 * 6), F.MISC + 12);
        { LAS float* par = (LAS float*)(F.lds + MISC_OFF + 256);
          if (F.tid < 64) { par[F.tid] = F.in[13][F.tid]; par[64 + F.tid] = F.in[14][F.tid]; }
          if (F.tid < 8) par[128 + F.tid] = F.in[12][F.tid];
          if (F.tid < 4) { par[136 + F.tid] = -__expf(F.in[16][F.tid]); par[140 + F.tid] = F.in[17][F.tid]; }
          __syncthreads(); }
        pg8::EpiIn E{QB, KB, VB, GQ, GZ, GT, GAB, LGF, F.out, (const LAS float*)(F.lds + MISC_OFF + 256)};
        pg8::gemm_phase<pg8::EpiIn, pg8::QueueOrder, true, true>(F.lds + RING_OFF, g, S, E);
        __syncthreads();
        { pg8::Gemm g2{(const bf16*)(ws + WS_PLB), (const bf16*)(ws + WS_WPL), MP, D, PLE}; pg8::QueueOrder S2; S2.init(MP, D, (unsigned*)(F.ctl + CW_Q + 64 * 7), F.MISC + 12);
          pg8::EpiBf<0> E2{PL, D, nullptr};
          pg8::gemm_phase<pg8::EpiBf<0>, pg8::QueueOrder, true, true>(F.lds + RING_OFF, g2, S2, E2); }
        if (BOTH(1)) GRID_BAR();
    }
    if (IN(2)) {
        for (int u = F.vcu; u < 1024; u += F.G) gdn_prep_unit<0>(F, u);
        if (F.vcu < NB * 128) fox_cumsum_seg(F, F.vcu);
        conv_out_job(F);
        if (BOTH(2)) p2_publish(F, bar);
    }
    if (IN(3)) {
        { const int su = (F.G == 256) ? (((F.vcu & 31) < 4) ? (F.vcu >> 5) * 4 + (F.vcu & 31) : -1) : (F.vcu < 32 ? F.vcu : -1);
          if (su >= 0) { if (lo <= 2) p2_wait(F, (unsigned*)(F.ctl + CW_BAR) + XB_TMO); gdn_scan_unit<0>(F, su); } }
        for (;;) { const int u = q_fetch(F, 0); if (u >= DB * GH) break; gdn_sample_unit(F, u); }
        float qkb;
        { const float a = fabsf(F.in[13][F.lane]), c = fabsf(F.in[14][F.lane]); float ma = a, mc = c;
#pragma unroll
          for (int o = 1; o < 64; o <<= 1) { ma = fmaxf(ma, __shfl_xor(ma, o)); mc = fmaxf(mc, __shfl_xor(mc, o)); }
          qkb = 64.0f * ma * mc * C2 * 1.02f; }
        const int attn_first = F.vcu & 1;
#pragma unroll 1
        for (int pass = 0; pass < 2; ++pass) {
            if ((pass ^ attn_first) & 1) {
                if (lo <= 2) p2_wait(F, (unsigned*)(F.ctl + CW_BAR) + XB_TMO);
                for (;;) { const int u = q_fetch(F, 2); if (u >= NB * FH * 32) break; attn_unit(F, ((u & 15) << 5) | (31 - (u >> 4)), qkb); }
            } else {
                for (;;) { const int u2 = q_fetch(F, 1); if (u2 >= DB * NPAGES / 2) break; decode_unit<false>(F, 2 * u2, F.wave); decode_unit<false>(F, 2 * u2 + 1, F.wave); }
            }
        }
        if (BOTH(3)) GRID_BAR();
    }
    if (IN(4)) {
        if (MK_N_LAUNCHES == 1 && gridDim.x == 256) {
            if (F.tid == 0) { unsigned ok = 1u;
                for (int g = 0; g < 8; ++g) { const unsigned w = __hip_atomic_load((unsigned*)(F.ctl + CW_PROG + 64 * (80 + g)), __ATOMIC_RELAXED, __HIP_MEMORY_SCOPE_AGENT); ok &= (__builtin_popcount(w) == 1) ? 1u : 0u; }
                F.MISC[20] = ok; }
            __syncthreads(); grp = __builtin_amdgcn_readfirstlane((int)F.MISC[20]) != 0; }
auto combine = [&]() { for (int r = F.vcu * NWAVES + F.wave; r < DB * FH * DS; r += F.G * NWAVES) decode_combine_row(F, r); };
        if (grp) gdn_outnorm_rows_grp(F, combine); else { combine(); gdn_outnorm_rows(F); }
        if (F.vcu >= F.G - 4) sample_zero_x2(F, F.vcu - (F.G - 4));
        if (BOTH(4)) SEAM(4);
    }
    if (IN(5)) {
        { pg8::Gemm g{OAB, (const bf16*)(ws + WS_WAB), MP, D, D}; pg8::StaticOrder S; S.init(MP, D, F.G, (int)blockIdx.x);
          pg8::EpiMerge E{MRG, GT};
          pg8::gemm_phase<pg8::EpiMerge, pg8::StaticOrder, true, true>(F.lds + RING_OFF, g, S, E); }
        SAMPLE_WAIT(4);
        sample_p5(F, (F.G == 256) ? (F.vcu & 31) * 8 + (F.vcu >> 5) : F.vcu);
        if (BOTH(5)) SEAM(0);
    }
    if (IN(6)) {
        pg8::Gemm g{MRG, (const bf16*)(ws + WS_WOUT), MP, D, D}; pg8::StaticOrder S; S.init(MP, D, F.G, (int)blockIdx.x);
        pg8::EpiRes<false, false> E{F.in[0], X1B, SS1, nullptr};
        pg8::gemm_phase<pg8::EpiRes<false, false>, pg8::StaticOrder, true, true>(F.lds + RING_OFF, g, S, E);
        SAMPLE_WAIT(0);
        sample_p6(F, (F.G == 256) ? (((F.vcu & 31) < 16) ? (F.vcu & 31) * 8 + (F.vcu >> 5) : 1000) : F.vcu);
        if (BOTH(6)) SEAM(1);
    }
    if (IN(7)) {
        pg8::Gemm g{X1B, (const bf16*)(ws + WS_WUP), MP, DFF, D}; pg8::StaticOrder S; S.init(MP, DFF, F.G, (int)blockIdx.x);
        pg8::EpiBf<2> E{HB, DFF, nullptr};
        pg8::gemm_phase<pg8::EpiBf<2>, pg8::StaticOrder, true, true>(F.lds + RING_OFF, g, S, E);
        SAMPLE_WAIT(1);
        sample_p7(F, F.vcu);
        if (BOTH(7)) SEAM(2);
    }
    if (IN(8)) {
        { pg8::Gemm g{HB, (const bf16*)(ws + WS_WDN), MP, D, DFF}; pg8::StaticOrder S; S.init(MP, D, F.G, (int)blockIdx.x);
          pg8::EpiRes<true, true> E{X1B, X2B, SS2, SS1};
          pg8::gemm_phase<pg8::EpiRes<true, true>, pg8::StaticOrder, true, true>(F.lds + RING_OFF, g, S, E); }
        SAMPLE_WAIT(2);
        sample_p8(F, F.vcu);
        if (BOTH(8)) SEAM(3);
    }
    if (IN(9)) {
        pg8::Gemm g{X2B, (const bf16*)(ws + WS_WGT), MP, D, D}; pg8::StaticOrder S; S.init(MP, D, F.G, (int)blockIdx.x);
        pg8::EpiFinal E{X2B, PL, SS2, F.out};
        pg8::gemm_phase<pg8::EpiFinal, pg8::StaticOrder, true, true>(F.lds + RING_OFF, g, S, E);
        SAMPLE_WAIT(3);
        sample_p9(F, (F.G == 256) ? (((F.vcu & 31) < 16) ? (F.vcu & 31) * 8 + (F.vcu >> 5) : 1000) : F.vcu);
    }
#undef IN
#undef BOTH
}

extern "C" void kernel_launch(void* const* d_in, const int* in_sizes, int n_in, void* d_out, int out_size, void* d_ws, size_t ws_size, hipStream_t stream) {
    static int grid = 0;
    if (grid == 0) {
        if (n_in != 28 || out_size != (int)OUT_TOTAL || ws_size < WS_END) { fprintf(stderr, "kernel_launch: unexpected shapes (n_in %d out %d ws %zu)\n", n_in, out_size, ws_size); grid = -1; return; }
        int dev = 0, cus = 0, per_cu = 0;
        if (hipGetDevice(&dev) != hipSuccess || hipDeviceGetAttribute(&cus, hipDeviceAttributeMultiprocessorCount, dev) != hipSuccess) { grid = -1; return; }
        if (hipFuncSetAttribute((const void*)mk_fwd, hipFuncAttributeMaxDynamicSharedMemorySize, LDS_BYTES) != hipSuccess) { fprintf(stderr, "kernel_launch: hipFuncSetAttribute failed\n"); grid = -1; return; }
        if (hipOccupancyMaxActiveBlocksPerMultiprocessor(&per_cu, (const void*)mk_fwd, NWAVES * 64, LDS_BYTES) != hipSuccess || per_cu < 1)
            fprintf(stderr, "kernel_launch: occupancy query reports %d workgroups per CU\n", per_cu);
        (void)hipGetLastError();
        grid = cus;
        if (cus != 256) fprintf(stderr, "kernel_launch: built for a 256-CU device (unit-to-workgroup maps assume 256 workgroups); this one reports %d\n", cus);
    }
    if (grid < 0) return;
    if (hipMemsetAsync((char*)d_ws + WS_CTL, 0, CTL_ZERO_BYTES, stream) != hipSuccess) return;
    Args a{};
    for (int i = 0; i < 28; ++i) a.in[i] = d_in[i];
    a.out = (float*)d_out; a.ws = (unsigned char*)d_ws;
    if (MK_N_LAUNCHES == 1) { a.ph_lo = 0; a.ph_hi = N_PHASES; a.li = 0; hipLaunchKernelGGL(mk_fwd, dim3(grid), dim3(NWAVES * 64), LDS_BYTES, stream, a); }
    else for (int li = 0; li < N_PHASES; ++li) { a.ph_lo = li; a.ph_hi = li + 1; a.li = li; hipLaunchKernelGGL(mk_fwd, dim3(grid), dim3(NWAVES * 64), LDS_BYTES, stream, a); }
}
```
